# Optimizing an MI355X kernel written in HIP

```python
import math
import jax
import jax.numpy as jnp
from jax import lax
import numpy as np

D_MODEL = 1024
BATCH = 2
SEQ = 8192
DEPTH = 2

N_MIXERS = 2
S5_WIDTH = D_MODEL
S5_GROUP = 16
S5_GROUPS = S5_WIDTH // S5_GROUP
S5_STATE = 64
S5_DT_MIN = 1e-3
S5_DT_MAX = 1e-1
N_HEADS = 8
HEAD_DIM = D_MODEL // N_HEADS
MOBA_BLOCK = 256
MOBA_TOPK = 3
Q_CHUNK = 32
ROPE_THETA = 10000.0
N_EXPERTS = 32
TOP_K = 4
D_FF = D_MODEL
SWIGLU_LIMIT = 7.0
SWIGLU_ALPHA = 1.702
EPS = 1e-6

kernel_name = "hybrid_s5_moba_moe_adaln"


def rms_norm(x, g):
    xf = x.astype(jnp.float32)
    y = xf * lax.rsqrt(jnp.mean(xf * xf, axis=-1, keepdims=True) + EPS)
    return y.astype(x.dtype) * g


def modulate(h, shift, scale):
    return h * (1.0 + scale[:, None, :]) + shift[:, None, :]


def rope_tables(positions):
    inv = ROPE_THETA ** (-jnp.arange(0, HEAD_DIM, 2, dtype=jnp.float32) / HEAD_DIM)
    ang = positions.astype(jnp.float32)[..., None] * inv
    ang = jnp.concatenate([ang, ang], axis=-1)
    return jnp.cos(ang), jnp.sin(ang)


def apply_rope(t, cos, sin):
    t1, t2 = jnp.split(t, 2, axis=-1)
    rot = jnp.concatenate([-t2, t1], axis=-1)
    return (t * cos[:, None] + rot * sin[:, None]).astype(t.dtype)


def _ssm_combine(e1, e2):
    a1r, a1i, b1r, b1i = e1
    a2r, a2i, b2r, b2i = e2
    return (a2r * a1r - a2i * a1i,
            a2r * a1i + a2i * a1r,
            a2r * b1r - a2i * b1i + b2r,
            a2r * b1i + a2i * b1r + b2i)


def s5_mixer(h, w_in, b_re, b_im, c_re, c_im, lam_re, lam_im, log_dt, d_skip, w_glu, w_out):
    bsz, seq, _ = h.shape
    u = h @ w_in
    ug = u.reshape(bsz, seq, S5_GROUPS, S5_GROUP)
    dt = jnp.exp(log_dt)[:, None]
    mag = jnp.exp(lam_re * dt)
    a_re = mag * jnp.cos(lam_im * dt)
    a_im = mag * jnp.sin(lam_im * dt)
    den = lam_re * lam_re + lam_im * lam_im
    f_re = ((a_re - 1.0) * lam_re + a_im * lam_im) / den
    f_im = (a_im * lam_re - (a_re - 1.0) * lam_im) / den
    bb_re = f_re[..., None] * b_re - f_im[..., None] * b_im
    bb_im = f_re[..., None] * b_im + f_im[..., None] * b_re
    bu_re = jnp.einsum('bsgc,gpc->bsgp', ug, bb_re)
    bu_im = jnp.einsum('bsgc,gpc->bsgp', ug, bb_im)
    ar = jnp.broadcast_to(a_re.astype(bu_re.dtype), bu_re.shape)
    ai = jnp.broadcast_to(a_im.astype(bu_re.dtype), bu_re.shape)
    _, _, x_re, x_im = lax.associative_scan(_ssm_combine, (ar, ai, bu_re, bu_im), axis=1)
    y = jnp.einsum('bsgp,gcp->bsgc', x_re, c_re) - jnp.einsum('bsgp,gcp->bsgc', x_im, c_im)
    y = y.reshape(bsz, seq, S5_WIDTH) + d_skip * u
    z = jax.nn.gelu(y)
    z = z * jax.nn.sigmoid(z @ w_glu)
    return z @ w_out


def moba_mixer(h, cos, sin, w_qkv, w_o):
    bsz, seq, _ = h.shape
    qkv = (h @ w_qkv).reshape(bsz, seq, 3, N_HEADS, HEAD_DIM)
    q = apply_rope(qkv[:, :, 0].transpose(0, 2, 1, 3), cos, sin)
    k = apply_rope(qkv[:, :, 1].transpose(0, 2, 1, 3), cos, sin)
    v = qkv[:, :, 2].transpose(0, 2, 1, 3)
    scale = HEAD_DIM ** -0.5
    n_blocks = -(-seq // MOBA_BLOCK)
    pad = n_blocks * MOBA_BLOCK - seq
    k_p = jnp.pad(k, ((0, 0), (0, 0), (0, pad), (0, 0)))
    v_p = jnp.pad(v, ((0, 0), (0, 0), (0, pad), (0, 0)))
    k_blocks = k_p.reshape(bsz, N_HEADS, n_blocks, MOBA_BLOCK, HEAD_DIM)
    v_blocks = v_p.reshape(bsz, N_HEADS, n_blocks, MOBA_BLOCK, HEAD_DIM)
    k_mean = jnp.mean(k_blocks, axis=3)
    n_sel = min(MOBA_TOPK, n_blocks)
    bi = jnp.arange(bsz)[:, None, None, None]
    hi = jnp.arange(N_HEADS)[None, :, None, None]
    blk_ids = jnp.arange(n_blocks)
    n_chunks = seq // Q_CHUNK

    def chunk(ci):
        q0 = ci * Q_CHUNK
        qc = lax.dynamic_slice_in_dim(q, q0, Q_CHUNK, axis=2)
        j = q0 // MOBA_BLOCK
        qpos = q0 + jnp.arange(Q_CHUNK)
        gate_s = jnp.einsum('bhqd,bhnd->bhqn', qc, k_mean).astype(jnp.float32)
        gate_s = jnp.where(blk_ids < j, gate_s, -jnp.inf)
        _, idx = lax.top_k(gate_s, n_sel)
        valid = idx < j
        kg = k_blocks[bi, hi, idx]
        vg = v_blocks[bi, hi, idx]
        s_sel = jnp.einsum('bhqd,bhqnkd->bhqnk', qc, kg).astype(jnp.float32) * scale
        s_sel = jnp.where(valid[..., None], s_sel, -jnp.inf)
        s_sel = s_sel.reshape(bsz, N_HEADS, Q_CHUNK, n_sel * MOBA_BLOCK)
        k_own = lax.dynamic_slice_in_dim(k_p, j * MOBA_BLOCK, MOBA_BLOCK, axis=2)
        v_own = lax.dynamic_slice_in_dim(v_p, j * MOBA_BLOCK, MOBA_BLOCK, axis=2)
        s_own = jnp.einsum('bhqd,bhkd->bhqk', qc, k_own).astype(jnp.float32) * scale
        kpos = j * MOBA_BLOCK + jnp.arange(MOBA_BLOCK)
        s_own = jnp.where(kpos[None, :] <= qpos[:, None], s_own, -jnp.inf)
        p = jax.nn.softmax(jnp.concatenate([s_sel, s_own], axis=-1), axis=-1).astype(v.dtype)
        p_sel = p[..., :n_sel * MOBA_BLOCK].reshape(bsz, N_HEADS, Q_CHUNK, n_sel, MOBA_BLOCK)
        p_own = p[..., n_sel * MOBA_BLOCK:]
        return (jnp.einsum('bhqnk,bhqnkd->bhqd', p_sel, vg)
                + jnp.einsum('bhqk,bhkd->bhqd', p_own, v_own))

    o = lax.map(chunk, jnp.arange(n_chunks))
    o = o.transpose(1, 0, 3, 2, 4).reshape(bsz, seq, N_HEADS * HEAD_DIM)
    return o @ w_o


def moe(h, w_router, b_router, w_gate_up, b_gate_up, w_down, b_down):
    bsz, seq, d = h.shape
    xf = h.reshape(-1, d)
    t = xf.shape[0]
    logits = (xf @ w_router + b_router).astype(jnp.float32)
    top_v, top_i = lax.top_k(logits, TOP_K)
    gates = jax.nn.softmax(top_v, axis=-1)
    flat_e = top_i.reshape(-1)
    order = jnp.argsort(flat_e)
    e_sorted = flat_e[order]
    tok = order // TOP_K
    xs = xf[tok]
    sizes = jnp.bincount(flat_e, length=N_EXPERTS).astype(jnp.int32)
    hu = lax.ragged_dot(xs, w_gate_up, sizes) + b_gate_up[e_sorted]
    g = jnp.minimum(hu[:, :D_FF], SWIGLU_LIMIT)
    up = jnp.clip(hu[:, D_FF:], -SWIGLU_LIMIT, SWIGLU_LIMIT)
    act = (up + 1.0) * g * jax.nn.sigmoid(SWIGLU_ALPHA * g)
    out = lax.ragged_dot(act, w_down, sizes) + b_down[e_sorted]
    wts = gates.reshape(-1)[order].astype(out.dtype)
    y = jnp.zeros((t, d), out.dtype).at[tok].add(out * wts[:, None])
    return y.reshape(bsz, seq, d)


def setup_inputs(seed: int = 0) -> dict:
    key = jax.random.key(seed)
    ks = iter(jax.random.split(key, 64))

    def nrm(shape, std):
        return std * jax.random.normal(next(ks), shape, jnp.float32)

    p = {}
    p['x'] = nrm((BATCH, SEQ, D_MODEL), 1.0)
    p['c'] = nrm((BATCH, D_MODEL), 1.0)
    offset = jax.random.randint(next(ks), (BATCH, 1), 0, 4096, dtype=jnp.int32)
    p['positions'] = jnp.arange(SEQ, dtype=jnp.int32)[None, :] + offset
    for i in range(DEPTH):
        pre = 'l%d_' % i
        p[pre + 'norm1_g'] = 1.0 + nrm((D_MODEL,), 0.02)
        p[pre + 'ada_w'] = nrm((D_MODEL, 6 * D_MODEL), 0.02)
        p[pre + 'ada_b'] = nrm((6 * D_MODEL,), 0.01)
        if i % N_MIXERS == 0:
            p[pre + 's5_w_in'] = nrm((D_MODEL, S5_WIDTH), D_MODEL ** -0.5)
            p[pre + 's5_b_re'] = nrm((S5_GROUPS, S5_STATE, S5_GROUP), (2 * S5_GROUP) ** -0.5)
            p[pre + 's5_b_im'] = nrm((S5_GROUPS, S5_STATE, S5_GROUP), (2 * S5_GROUP) ** -0.5)
            p[pre + 's5_c_re'] = nrm((S5_GROUPS, S5_GROUP, S5_STATE), S5_STATE ** -0.5)
            p[pre + 's5_c_im'] = nrm((S5_GROUPS, S5_GROUP, S5_STATE), S5_STATE ** -0.5)
            p[pre + 's5_lam_re'] = -0.5 + nrm((S5_GROUPS, S5_STATE), 0.01)
            p[pre + 's5_lam_im'] = (math.pi * jnp.arange(S5_STATE, dtype=jnp.float32))[None, :] + nrm((S5_GROUPS, S5_STATE), 0.01)
            p[pre + 's5_log_dt'] = jax.random.uniform(next(ks), (S5_GROUPS,), jnp.float32, math.log(S5_DT_MIN), math.log(S5_DT_MAX))
            p[pre + 's5_d'] = nrm((S5_WIDTH,), 1.0)
            p[pre + 's5_w_glu'] = nrm((S5_WIDTH, S5_WIDTH), S5_WIDTH ** -0.5)
            p[pre + 's5_w_out'] = nrm((S5_WIDTH, D_MODEL), S5_WIDTH ** -0.5)
        else:
            p[pre + 'moba_w_qkv'] = nrm((D_MODEL, 3 * N_HEADS * HEAD_DIM), D_MODEL ** -0.5)
            p[pre + 'moba_w_o'] = nrm((N_HEADS * HEAD_DIM, D_MODEL), (N_HEADS * HEAD_DIM) ** -0.5)
        p[pre + 'norm2_g'] = 1.0 + nrm((D_MODEL,), 0.02)
        p[pre + 'moe_w_router'] = nrm((D_MODEL, N_EXPERTS), D_MODEL ** -0.5)
        p[pre + 'moe_b_router'] = nrm((N_EXPERTS,), 0.01)
        p[pre + 'moe_w_gate_up'] = nrm((N_EXPERTS, D_MODEL, 2 * D_FF), D_MODEL ** -0.5)
        p[pre + 'moe_b_gate_up'] = nrm((N_EXPERTS, 2 * D_FF), 0.01)
        p[pre + 'moe_w_down'] = nrm((N_EXPERTS, D_FF, D_MODEL), D_FF ** -0.5)
        p[pre + 'moe_b_down'] = nrm((N_EXPERTS, D_MODEL), 0.01)
    p['final_norm_g'] = 1.0 + nrm((D_MODEL,), 0.02)
    return p


def reference(x, c, positions,
              l0_norm1_g, l0_ada_w, l0_ada_b,
              l0_s5_w_in, l0_s5_b_re, l0_s5_b_im, l0_s5_c_re, l0_s5_c_im,
              l0_s5_lam_re, l0_s5_lam_im, l0_s5_log_dt, l0_s5_d, l0_s5_w_glu, l0_s5_w_out,
              l0_norm2_g, l0_moe_w_router, l0_moe_b_router, l0_moe_w_gate_up, l0_moe_b_gate_up,
              l0_moe_w_down, l0_moe_b_down,
              l1_norm1_g, l1_ada_w, l1_ada_b,
              l1_moba_w_qkv, l1_moba_w_o,
              l1_norm2_g, l1_moe_w_router, l1_moe_b_router, l1_moe_w_gate_up, l1_moe_b_gate_up,
              l1_moe_w_down, l1_moe_b_down,
              final_norm_g):
    cos, sin = rope_tables(positions)
    c_act = jax.nn.silu(c)
    layers = (
        (l0_norm1_g, l0_ada_w, l0_ada_b,
         (l0_s5_w_in, l0_s5_b_re, l0_s5_b_im, l0_s5_c_re, l0_s5_c_im,
          l0_s5_lam_re, l0_s5_lam_im, l0_s5_log_dt, l0_s5_d, l0_s5_w_glu, l0_s5_w_out),
         l0_norm2_g,
         (l0_moe_w_router, l0_moe_b_router, l0_moe_w_gate_up, l0_moe_b_gate_up, l0_moe_w_down, l0_moe_b_down)),
        (l1_norm1_g, l1_ada_w, l1_ada_b,
         (l1_moba_w_qkv, l1_moba_w_o),
         l1_norm2_g,
         (l1_moe_w_router, l1_moe_b_router, l1_moe_w_gate_up, l1_moe_b_gate_up, l1_moe_w_down, l1_moe_b_down)),
    )
    for i in range(DEPTH):
        norm1_g, ada_w, ada_b, mix_p, norm2_g, moe_p = layers[i]
        ada = c_act @ ada_w + ada_b
        sh1, sc1, g1, sh2, sc2, g2 = jnp.split(ada, 6, axis=-1)
        h = modulate(rms_norm(x, norm1_g), sh1, sc1)
        if i % N_MIXERS == 0:
            m = s5_mixer(h, *mix_p)
        else:
            m = moba_mixer(h, cos, sin, *mix_p)
        x = x + g1[:, None, :] * m
        h = modulate(rms_norm(x, norm2_g), sh2, sc2)
        x = x + g2[:, None, :] * moe(h, *moe_p)
    return rms_norm(x, final_norm_g)
```

```cpp
#include <hip/hip_runtime.h>
#include <cstdio>
#include <cstdint>

#ifndef MK_DUP
#define MK_DUP 0u
#endif
#ifndef MK_EMPTY
#define MK_EMPTY 0
#endif
#ifndef MK_KREP
#define MK_KREP 1
#endif
#ifndef MK_CONVPROBE
#define MK_CONVPROBE 0
#endif
#ifndef MK_CV0
#define MK_CV0 1280
#endif
#ifndef MK_CV9
#define MK_CV9 2048
#endif
#ifndef MK_CV10
#define MK_CV10 1152
#endif
#ifndef MK_MULTI
#define MK_MULTI 0
#endif

typedef unsigned short bf16_t;
typedef short bf16x8 __attribute__((ext_vector_type(8)));
typedef short s16x4 __attribute__((ext_vector_type(4)));
typedef float f32x2 __attribute__((ext_vector_type(2)));
typedef float f32x4 __attribute__((ext_vector_type(4)));
typedef float f32x16 __attribute__((ext_vector_type(16)));
typedef unsigned u32x2 __attribute__((ext_vector_type(2)));
typedef unsigned u32x4 __attribute__((ext_vector_type(4)));
typedef int v4i __attribute__((ext_vector_type(4)));
typedef int v8i __attribute__((ext_vector_type(8)));
#define LAS __attribute__((address_space(3)))

constexpr int DM = 1024, NB = 2, SEQ = 8192, T = NB * SEQ;
constexpr int NH = 8, HD = 128, MBLK = 256, NBLK = SEQ / MBLK;
constexpr int NE = 32, TOPK = 4, DFF = 1024;
constexpr int S5G = 64, S5P = 64, S5C = 16;
constexpr int NTHREADS = 512;
constexpr int LDS_BYTES = 147456;
constexpr int LDS_BARW = LDS_BYTES - 16;
constexpr int MOE_CAP = T;
constexpr int MOE_MAXROWS = T * TOPK + NE * 256;
constexpr int MOE_MAXTILES = MOE_MAXROWS / 256;

constexpr size_t al256(size_t x) { return (x + 255) / 256 * 256; }
constexpr size_t WS_ZERO = 0;
constexpr size_t   ZB_BAR = 0;
constexpr size_t   ZB_MOECNT = 16384;
constexpr size_t   ZB_ATTCNT = 20480;
constexpr size_t ZERO_BYTES = 32768;
constexpr size_t WS_ADA = ZERO_BYTES;
constexpr size_t WS_S5A = WS_ADA + al256(2 * 2 * 6 * 1024 * 4);
constexpr size_t WS_BOP = WS_S5A + 4 * 64 * 64 * 4;
constexpr size_t WS_COP = WS_BOP + 64 * 128 * 16 * 2;
constexpr size_t WS_ROPE = WS_COP + 64 * 16 * 128 * 2;
constexpr size_t WS_WRB = WS_ROPE + 2 * (size_t)T * 64 * 4;
constexpr size_t WS_KMEAN = WS_WRB + 2 * 32 * 1024 * 2;
constexpr size_t WS_TOPK = WS_KMEAN + 2 * 8 * 32 * 128 * 4;
constexpr size_t WS_VTOK = WS_TOPK + 2 * (size_t)T * 4 * 4;
constexpr size_t ALIST_PER_BH = 256 * 496;
constexpr size_t WS_ALIST = WS_VTOK + (size_t)NE * MOE_CAP * 4;
constexpr size_t WS_LSE = WS_ALIST + 16 * ALIST_PER_BH * 4;
constexpr size_t WS_CARRY = WS_LSE + (size_t)T * 8 * 4 * 4;
constexpr size_t WS_WIN = WS_CARRY + (size_t)2 * 256 * 64 * 128 * 4;
constexpr size_t WS_WGLU = WS_WIN + 2097152, WS_WOUT = WS_WGLU + 2097152, WS_WQKV = WS_WOUT + 2097152, WS_WO = WS_WQKV + 3 * 2097152;
constexpr size_t WS_WGU0 = WS_WO + 2097152;
constexpr size_t WS_WGU1 = WS_WGU0 + (size_t)NE * 2048 * 1024 * 2;
constexpr size_t WS_WDN0 = WS_WGU1 + (size_t)NE * 2048 * 1024 * 2;
constexpr size_t WS_WDN1 = WS_WDN0 + (size_t)NE * 1024 * 1024 * 2;
constexpr size_t WS_ACTA = WS_WDN1 + (size_t)NE * 1024 * 1024 * 2;
constexpr size_t ACT_BYTES = (size_t)T * DM * 2;
constexpr size_t WS_ACTB = WS_ACTA + ACT_BYTES, WS_ACTC = WS_ACTB + ACT_BYTES, WS_ACTD = WS_ACTC + ACT_BYTES;
constexpr size_t WS_XA = WS_ACTD + ACT_BYTES;
constexpr size_t WS_XB = WS_XA + (size_t)T * DM * 4;
constexpr size_t WS_ACTG = WS_XB + (size_t)T * DM * 4;
constexpr size_t WS_YK = WS_ACTG + (size_t)MOE_MAXROWS * 1024 * 2;
constexpr size_t WS_END = WS_YK + (size_t)MOE_MAXROWS * 1024 * 2;

__device__ __forceinline__ unsigned cvt_pk_bf16(float lo, float hi) { unsigned r; asm volatile("v_cvt_pk_bf16_f32 %0, %1, %2" : "=v"(r) : "v"(lo), "v"(hi)); return r; }
__device__ __forceinline__ float bf_lo(unsigned w) { return __uint_as_float(w << 16); }
__device__ __forceinline__ float bf_hi(unsigned w) { return __uint_as_float(w & 0xffff0000u); }
__device__ __forceinline__ bf16_t f2bf(float f) { return (bf16_t)(cvt_pk_bf16(f, 0.f) & 0xffffu); }
__device__ __forceinline__ unsigned pack_fp8x4(float a, float b, float c, float d) {
    a = fminf(fmaxf(a, -448.f), 448.f); b = fminf(fmaxf(b, -448.f), 448.f); c = fminf(fmaxf(c, -448.f), 448.f); d = fminf(fmaxf(d, -448.f), 448.f);
    int w = 0; w = __builtin_amdgcn_cvt_pk_fp8_f32(a, b, w, false); w = __builtin_amdgcn_cvt_pk_fp8_f32(c, d, w, true); return (unsigned)w;
}
__device__ __forceinline__ unsigned pack_fp8x4_nc(float a, float b, float c, float d) {
    int w = 0; w = __builtin_amdgcn_cvt_pk_fp8_f32(a, b, w, false); w = __builtin_amdgcn_cvt_pk_fp8_f32(c, d, w, true); return (unsigned)w;
}
constexpr float FP8_WSCALE = 64.f, FP8_ASCALE = 4.f, FP8_OSCALE = 64.f, FP8_YSCALE = 8.f;
__device__ __forceinline__ f32x4 load_x4(const float* p) { return *(const f32x4*)p; }
__device__ __forceinline__ f32x4 load_x4(const bf16_t* p) { const u32x2 w = *(const u32x2*)p; return (f32x4){bf_lo(w.x), bf_hi(w.x), bf_lo(w.y), bf_hi(w.y)}; }
template <int CTRL> __device__ __forceinline__ float dpp_f(float v) { return __builtin_bit_cast(float, __builtin_amdgcn_update_dpp(0, __builtin_bit_cast(int, v), CTRL, 0xF, 0xF, false)); }
template <int CTRL> __device__ __forceinline__ int dpp_i(int v) { return __builtin_amdgcn_update_dpp(0, v, CTRL, 0xF, 0xF, false); }
__device__ __forceinline__ float row16_sum(float v) { v += dpp_f<0xB1>(v); v += dpp_f<0x4E>(v); v += dpp_f<0x124>(v); v += dpp_f<0x128>(v); return v; }
__device__ __forceinline__ float row16_max(float v) { v = fmaxf(v, dpp_f<0xB1>(v)); v = fmaxf(v, dpp_f<0x4E>(v)); v = fmaxf(v, dpp_f<0x124>(v)); v = fmaxf(v, dpp_f<0x128>(v)); return v; }
__device__ __forceinline__ int row16_min(int v) { v = min(v, dpp_i<0xB1>(v)); v = min(v, dpp_i<0x4E>(v)); v = min(v, dpp_i<0x124>(v)); v = min(v, dpp_i<0x128>(v)); return v; }
__device__ __forceinline__ float wave_sum(float v) {
    const int r = __builtin_bit_cast(int, row16_sum(v));
    return (__builtin_bit_cast(float, __builtin_amdgcn_readlane(r, 0)) + __builtin_bit_cast(float, __builtin_amdgcn_readlane(r, 16)))
         + (__builtin_bit_cast(float, __builtin_amdgcn_readlane(r, 32)) + __builtin_bit_cast(float, __builtin_amdgcn_readlane(r, 48)));
}
__device__ __forceinline__ float wave_max(float v) {
    const int r = __builtin_bit_cast(int, row16_max(v));
    return fmaxf(fmaxf(__builtin_bit_cast(float, __builtin_amdgcn_readlane(r, 0)), __builtin_bit_cast(float, __builtin_amdgcn_readlane(r, 16))),
                 fmaxf(__builtin_bit_cast(float, __builtin_amdgcn_readlane(r, 32)), __builtin_bit_cast(float, __builtin_amdgcn_readlane(r, 48))));
}
__device__ __forceinline__ float sigmoidf_fast(float x) { return __builtin_amdgcn_rcpf(1.f + __builtin_amdgcn_exp2f(-1.4426950408889634f * x)); }
__device__ __forceinline__ float gelu_tanh(float y) {
    const float u = 1.5957691216057308f * (y + 0.044715f * y * y * y);
    return y * sigmoidf_fast(u);
}

#define XB_TMO      128
#define XB_XCNT(j)  (256  + 64 * (j))
#define XB_XSUB(j)  (1280 + 64 * (j))
#define XB_XGEN(j)  (2304 + 64 * (j))
#define XB_TOP      3328
#define XB_TOPGEN   3392
#define XCD_BAR_WORDS 3456
#define XB_SPIN_CAP (1u << 18)

__device__ __forceinline__ unsigned xb_ld(unsigned* p)              { return __hip_atomic_load(p, __ATOMIC_RELAXED, __HIP_MEMORY_SCOPE_AGENT); }
__device__ __forceinline__ unsigned xb_add(unsigned* p, unsigned v) { return __hip_atomic_fetch_add(p, v, __ATOMIC_RELAXED, __HIP_MEMORY_SCOPE_AGENT); }
__device__ __forceinline__ unsigned xb_xcc_id() { return (unsigned)__builtin_amdgcn_s_getreg((3 << 11) | 20) & 0xFu; }
#define XB_SPIN(cond, bar) do { unsigned _sp = 0; while (cond) { __builtin_amdgcn_s_sleep(1); \
    if ((++_sp & 255u) == 0u) { if (xb_ld(&(bar)[XB_TMO])) break; if (_sp > XB_SPIN_CAP) { atomicAdd(&(bar)[XB_TMO], 1u); break; } } } } while (0)

struct XcdBarrier { unsigned* bar; unsigned x; volatile LAS unsigned* st; };

__device__ __forceinline__ XcdBarrier xcd_barrier_post(unsigned* bar, volatile LAS unsigned* st) {
    XcdBarrier b; b.bar = bar; b.x = xb_xcc_id(); b.st = st;
    if (threadIdx.x == 0) (void)xb_add(&bar[XB_XCNT(b.x)], 1u);
    return b;
}
__device__ __forceinline__ void xcd_barrier_complete(unsigned* bar, unsigned x, unsigned& nloc, unsigned& nx) {
    const unsigned G = gridDim.x * gridDim.y * gridDim.z;
    unsigned sum, cnt, mine, sp = 0u;
    for (;;) {
        sum = 0u; cnt = 0u; mine = 0u;
#pragma unroll
        for (unsigned j = 0; j < 16; ++j) { const unsigned c = xb_ld(&bar[XB_XCNT(j)]); sum += c; cnt += (c > 0u) ? 1u : 0u; mine = (j == x) ? c : mine; }
        if (sum == G) break;
        __builtin_amdgcn_s_sleep(1);
        if ((++sp & 255u) == 0u) { if (xb_ld(&bar[XB_TMO])) break; if (sp > XB_SPIN_CAP) { atomicAdd(&bar[XB_TMO], 1u); break; } }
    }
    nloc = mine > 0u ? mine : 1u; nx = cnt > 0u ? cnt : 1u;
}
__device__ __forceinline__ void xcd_barrier(const XcdBarrier& b) {
    asm volatile("s_waitcnt vmcnt(0)" ::: "memory");
    __syncthreads();
    if (threadIdx.x == 0) {
        unsigned* bar = b.bar;
        __builtin_amdgcn_s_waitcnt(0);
        unsigned nloc = b.st[0], nx = b.st[1];
        if (nloc == 0u) { xcd_barrier_complete(bar, b.x, nloc, nx); b.st[0] = nloc; b.st[1] = nx; }
        const unsigned old = xb_add(&bar[XB_XSUB(b.x)], 1u);
        const unsigned gen = old / nloc;
        if (old + 1u == (gen + 1u) * nloc) {
            __builtin_amdgcn_fence(__ATOMIC_RELEASE, "agent");
            asm volatile("s_waitcnt vmcnt(0)" ::: "memory");
            const unsigned og = xb_add(&bar[XB_TOP], 1u);
            const unsigned tg = og / nx;
            if (og + 1u == (tg + 1u) * nx) xb_add(&bar[XB_TOPGEN], 1u);
            else XB_SPIN(xb_ld(&bar[XB_TOPGEN]) == tg, bar);
            __builtin_amdgcn_fence(__ATOMIC_ACQUIRE, "agent");
            xb_add(&bar[XB_XGEN(b.x)], 1u);
            asm volatile("s_waitcnt vmcnt(0)" ::: "memory");
        } else {
            XB_SPIN(xb_ld(&bar[XB_XGEN(b.x)]) == gen, bar);
            __builtin_amdgcn_fence(__ATOMIC_ACQUIRE, "agent");
            asm volatile("s_waitcnt vmcnt(0)" ::: "memory");
        }
    }
    __syncthreads();
}

struct Args { const float* in[37]; float* out; unsigned char* ws; int ph_lo, ph_hi; };

struct Frame {
    LAS unsigned char* lds;
    int tid, lane, wave, G, c;
    const float* const* in; float* out; unsigned char* ws;
};

enum { IN_X = 0, IN_C = 1, IN_POS = 2,
       L0_NORM1 = 3, L0_ADAW = 4, L0_ADAB = 5, L0_WIN = 6, L0_BRE = 7, L0_BIM = 8, L0_CRE = 9, L0_CIM = 10, L0_LRE = 11, L0_LIM = 12, L0_LOGDT = 13, L0_D = 14, L0_WGLU = 15, L0_WOUT = 16,
       L0_NORM2 = 17, L0_WR = 18, L0_BR = 19, L0_WGU = 20, L0_BGU = 21, L0_WDN = 22, L0_BDN = 23,
       L1_NORM1 = 24, L1_ADAW = 25, L1_ADAB = 26, L1_WQKV = 27, L1_WO = 28, L1_NORM2 = 29, L1_WR = 30, L1_BR = 31, L1_WGU = 32, L1_BGU = 33, L1_WDN = 34, L1_BDN = 35, IN_FNORM = 36 };

__device__ __forceinline__ const float* ada_vec(const Frame& F, int layer, int b, int which) { return (const float*)(F.ws + WS_ADA) + ((layer * 2 + b) * 6 + which) * 1024; }

__device__ __forceinline__ void conv_unit(const Frame& F, const float* __restrict__ src, bf16_t* __restrict__ dst, int N, int kt, int ntile, bool qkperm) {
    LAS unsigned* L = (LAS unsigned*)F.lds;
    const int k0 = kt * 64, n0 = ntile * 256, lane = F.lane, w = F.wave;
#pragma unroll
    for (int j = 0; j < 4; ++j) {
        const float* sp = src + (size_t)(k0 + 2 * w) * N + n0 + lane + 64 * j;
        float a[4], b[4];
#pragma unroll
        for (int i = 0; i < 4; ++i) { a[i] = sp[(size_t)(16 * i) * N]; b[i] = sp[(size_t)(16 * i + 1) * N]; }
#pragma unroll
        for (int i = 0; i < 4; ++i) L[(lane + 64 * j) * 33 + 8 * i + w] = cvt_pk_bf16(a[i], b[i]);
    }
    __syncthreads();
    const int row = F.tid >> 1, half = F.tid & 1;
    int n = n0 + row;
    if (qkperm && n < 2048) { const int d = n & 127; n = (n & ~127) | (d < 64 ? 2 * d : 2 * (d - 64) + 1); }
    bf16_t* dp = dst + (size_t)n * 1024 + k0 + half * 32;
#pragma unroll
    for (int q = 0; q < 4; ++q) {
        u32x4 v; v.x = L[row * 33 + half * 16 + 4 * q + 0]; v.y = L[row * 33 + half * 16 + 4 * q + 1]; v.z = L[row * 33 + half * 16 + 4 * q + 2]; v.w = L[row * 33 + half * 16 + 4 * q + 3];
        *(u32x4*)(dp + 8 * q) = v;
    }
    __syncthreads();
}

__device__ __forceinline__ void conv_unit8(const Frame& F, const float* __restrict__ src, unsigned char* __restrict__ dst, int N, int kt, int ntile, bool qkperm = false) {
    LAS unsigned* L = (LAS unsigned*)F.lds;
    const int k0 = kt * 128, n0 = ntile * 128, lane = F.lane, w = F.wave;
#pragma unroll
    for (int j = 0; j < 2; ++j) {
        const float* sp = src + (size_t)(k0 + 4 * w) * N + n0 + lane + 64 * j;
        float f[4][4];
#pragma unroll
        for (int i = 0; i < 4; ++i)
#pragma unroll
            for (int q = 0; q < 4; ++q) f[i][q] = sp[(size_t)(32 * i + q) * N];
#pragma unroll
        for (int i = 0; i < 4; ++i) L[(lane + 64 * j) * 33 + w + 8 * i] = pack_fp8x4(f[i][0] * FP8_WSCALE, f[i][1] * FP8_WSCALE, f[i][2] * FP8_WSCALE, f[i][3] * FP8_WSCALE);
    }
    __syncthreads();
    const int row = F.tid >> 2, qtr = F.tid & 3;
    int n = n0 + row;
    if (qkperm && n < 2048) { const int d = n & 127; n = (n & ~127) | (d < 64 ? 2 * d : 2 * (d - 64) + 1); }
    unsigned char* dp = dst + (size_t)n * 1024 + k0 + qtr * 32;
#pragma unroll
    for (int q = 0; q < 2; ++q) {
        u32x4 v; v.x = L[row * 33 + qtr * 8 + 4 * q + 0]; v.y = L[row * 33 + qtr * 8 + 4 * q + 1]; v.z = L[row * 33 + qtr * 8 + 4 * q + 2]; v.w = L[row * 33 + qtr * 8 + 4 * q + 3];
        *(u32x4*)(dp + 16 * q) = v;
    }
    __syncthreads();
}

__device__ __forceinline__ void ada_unit(const Frame& F, int layer, int cg) {
    LAS float* ca = (LAS float*)F.lds;
    const float* cin = F.in[IN_C];
    for (int i = F.tid; i < 2048; i += NTHREADS) { const float c = cin[i]; ca[i] = c * sigmoidf_fast(c); }
    __syncthreads();
    const float* w = F.in[layer ? L1_ADAW : L0_ADAW]; const float* bias = F.in[layer ? L1_ADAB : L0_ADAB];
    const int kq = F.wave, col = cg * 64 + F.lane;
    float a0 = 0.f, a1 = 0.f;
#pragma unroll 8
    for (int k = kq * 128; k < kq * 128 + 128; ++k) { const float wv = w[(size_t)k * 6144 + col]; a0 = fmaf(ca[k], wv, a0); a1 = fmaf(ca[1024 + k], wv, a1); }
    LAS float* red = ca + 2048;
    red[(kq * 2 + 0) * 64 + F.lane] = a0; red[(kq * 2 + 1) * 64 + F.lane] = a1;
    __syncthreads();
    if (F.tid < 128) { const int b = F.tid >> 6, l = F.tid & 63; float s = bias[cg * 64 + l];
#pragma unroll
        for (int q = 0; q < 8; ++q) s += red[(q * 2 + b) * 64 + l];
        ((float*)(F.ws + WS_ADA))[(layer * 2 + b) * 6144 + cg * 64 + l] = s; }
    __syncthreads();
}

__device__ __forceinline__ void s5tab_unit(const Frame& F, int unit) {
    const int idx = unit * NTHREADS + F.tid, g = idx >> 6, p = idx & 63;
    const double dt = exp((double)F.in[L0_LOGDT][g]);
    const double lr = (double)F.in[L0_LRE][idx], li = (double)F.in[L0_LIM][idx];
    const double mag = exp(lr * dt), ar = mag * cos(li * dt), ai = mag * sin(li * dt);
    const double den = lr * lr + li * li;
    const double fr = ((ar - 1.0) * lr + ai * li) / den, fi = (ai * lr - (ar - 1.0) * li) / den;
    const double mag32 = exp(32.0 * lr * dt), a32r = mag32 * cos(32.0 * li * dt), a32i = mag32 * sin(32.0 * li * dt);
    float* tab = (float*)(F.ws + WS_S5A);
    tab[idx] = (float)ar; tab[4096 + idx] = (float)ai; tab[8192 + idx] = (float)a32r; tab[12288 + idx] = (float)a32i;
    bf16_t* bop = (bf16_t*)(F.ws + WS_BOP); bf16_t* cop = (bf16_t*)(F.ws + WS_COP);
    const float* bre = F.in[L0_BRE] + (size_t)idx * 16; const float* bim = F.in[L0_BIM] + (size_t)idx * 16;
#pragma unroll
    for (int ch = 0; ch < 16; ++ch) {
        const double br = bre[ch], bi = bim[ch];
        bop[(g * 128 + p) * 16 + ch] = f2bf((float)(fr * br - fi * bi));
        bop[(g * 128 + 64 + p) * 16 + ch] = f2bf((float)(fr * bi + fi * br));
        cop[(g * 16 + ch) * 128 + p] = f2bf(F.in[L0_CRE][(g * 16 + ch) * 64 + p]);
        cop[(g * 16 + ch) * 128 + 64 + p] = f2bf(-F.in[L0_CIM][(g * 16 + ch) * 64 + p]);
    }
}

__device__ __forceinline__ void rope_unit(const Frame& F, int unit) {
    LAS float* invl = (LAS float*)F.lds;
    if (F.tid < 64) invl[F.tid] = (float)exp2(-(double)F.tid * (13.287712379549449 / 64.0));
    __syncthreads();
    const int idx = (unit * NTHREADS + F.tid) * 4, t = idx >> 6, i0 = idx & 63;
    const float pos = (float)((const int*)F.in[IN_POS])[t];
    f32x4 c, s;
#pragma unroll
    for (int e = 0; e < 4; ++e) {
        const float ang = pos * invl[i0 + e];
        const float k = rintf(ang * 0.15915494309189535f);
        float r = fmaf(-k, 6.28125f, ang); r = fmaf(-k, 1.9353071693331003e-3f, r); r = fmaf(-k, 1.0253131677018246e-11f, r);
        c[e] = __cosf(r); s[e] = __sinf(r);
    }
    *(f32x4*)((float*)(F.ws + WS_ROPE) + idx) = c;
    *(f32x4*)((float*)(F.ws + WS_ROPE) + (size_t)T * 64 + idx) = s;
    __syncthreads();
}

constexpr int CONV_L0DN_BEG = 4096, CONV_L1GU_BEG = 6144, CONV_L1DN_BEG = 10240, CONV_END = 12288;
constexpr int CONV_P10_BEG = CONV_L1GU_BEG + MK_CV0, CONV_P15_BEG = CONV_P10_BEG + MK_CV10;
constexpr int P0_CONV0 = 64, P0_CONV1 = 128, P0_CONV2 = 192, P0_CONV3 = 384, P0_CONV4 = 448, P0_CONV5 = 4544, P0_CONV6 = 6592, P0_CONV7 = 10688, P0_CONV8 = 12736;
constexpr int P0_ADA = P0_CONV8 + 192, P0_S5 = P0_ADA + 8, P0_ROPE = P0_S5 + 512, P0_WRB = P0_ROPE + 128, P0_END = P0_WRB + 32;

__device__ __forceinline__ void conv_batched(const Frame& F, int u, const float* src, size_t dst_off, int N) {
    const int per = 16 * (N / 256), e = u / per, r = u % per, kt = r / (N / 256), nt = r % (N / 256);
    conv_unit(F, src + (size_t)e * 1024 * N, (bf16_t*)(F.ws + dst_off) + (size_t)e * N * 1024, N, kt, nt, false);
}

__device__ __forceinline__ void conv_batched8(const Frame& F, int u, const float* src, size_t dst_off, int N) {
    const int per = 8 * (N / 128), e = u / per, r = u % per, kt = r / (N / 128), nt = r % (N / 128);
    conv_unit8(F, src + (size_t)e * 1024 * N, F.ws + dst_off + (size_t)e * N * 1024, N, kt, nt);
}

__device__ __forceinline__ bool moe_conv_decode(const Frame& F, int u, const float*& src, unsigned char*& dst, int& N) {
    if (u >= 12288) return false;
    const int fam = u < 4096 ? 0 : (u < 6144 ? 1 : (u < 10240 ? 2 : 3));
    const int base = fam == 0 ? 0 : (fam == 1 ? 4096 : (fam == 2 ? 6144 : 10240));
    N = (fam & 1) ? 1024 : 2048;
    const float* sp = fam == 0 ? F.in[L0_WGU] : (fam == 1 ? F.in[L0_WDN] : (fam == 2 ? F.in[L1_WGU] : F.in[L1_WDN]));
    const size_t doff = fam == 0 ? WS_WGU0 : (fam == 1 ? WS_WDN0 : (fam == 2 ? WS_WGU1 : WS_WDN1));
    const int r0 = u - base, per = 8 * (N / 128), e = r0 / per, r = r0 % per, kt = r / (N / 128), nt = r % (N / 128);
    src = sp + (size_t)e * 1024 * N + (size_t)(kt * 128 + 16 * F.wave + 8 * (F.lane >> 5)) * N + nt * 128 + 4 * (F.lane & 31);
    dst = F.ws + doff + (size_t)e * N * 1024 + (size_t)(nt * 128 + (F.tid >> 2)) * 1024 + kt * 128 + (F.tid & 3) * 32;
    return true;
}
__device__ __forceinline__ void moe_conv_stream(const Frame& F, int ubeg, int uend, int ci, int cn) {
    LAS unsigned* L = (LAS unsigned*)F.lds;
    const int nq = F.lane & 31, kd0 = 4 * F.wave + 2 * (F.lane >> 5), row = F.tid >> 2, qtr = F.tid & 3;
    const float* src; unsigned char* dst; int N;
    int u = ubeg + ci;
    if (u >= uend || !moe_conv_decode(F, u, src, dst, N)) return;
    f32x4 fa[8], fb[8]; unsigned char* da = dst; unsigned char* db = nullptr;
#define CV_LOAD(f) do { _Pragma("unroll") for (int i = 0; i < 8; ++i) f[i] = __builtin_nontemporal_load((const f32x4*)(src + (size_t)i * N)); } while (0)
#define CV_EMIT(f, d) do { unsigned pk[4][2]; \
        _Pragma("unroll") for (int c = 0; c < 4; ++c) { pk[c][0] = pack_fp8x4(f[0][c] * FP8_WSCALE, f[1][c] * FP8_WSCALE, f[2][c] * FP8_WSCALE, f[3][c] * FP8_WSCALE); \
                                                         pk[c][1] = pack_fp8x4(f[4][c] * FP8_WSCALE, f[5][c] * FP8_WSCALE, f[6][c] * FP8_WSCALE, f[7][c] * FP8_WSCALE); } \
        u += cn; more = u < uend && moe_conv_decode(F, u, src, dst, N); if (more) CV_LOAD(f); \
        _Pragma("unroll") for (int c = 0; c < 4; ++c) { L[(4 * nq + c) * 33 + kd0] = pk[c][0]; L[(4 * nq + c) * 33 + kd0 + 1] = pk[c][1]; } \
        asm volatile("s_waitcnt lgkmcnt(0)" ::: "memory"); __builtin_amdgcn_s_barrier(); asm volatile("" ::: "memory");     \
        _Pragma("unroll") for (int q = 0; q < 2; ++q) { u32x4 v; v.x = L[row * 33 + qtr * 8 + 4 * q + 0]; v.y = L[row * 33 + qtr * 8 + 4 * q + 1]; v.z = L[row * 33 + qtr * 8 + 4 * q + 2]; v.w = L[row * 33 + qtr * 8 + 4 * q + 3]; \
            *(u32x4*)((d) + 16 * q) = v; } \
        asm volatile("s_waitcnt lgkmcnt(0)" ::: "memory"); __builtin_amdgcn_s_barrier(); asm volatile("" ::: "memory"); } while (0)
    bool more;
    CV_LOAD(fa);
    u += cn; bool have_b = u < uend && moe_conv_decode(F, u, src, dst, N);
    if (have_b) { db = dst; CV_LOAD(fb); }
    for (;;) {
        unsigned char* d0 = da;
        CV_EMIT(fa, d0);
        const bool have_a = more; if (have_a) da = dst;
        if (!have_b) break;
        unsigned char* d1 = db;
        CV_EMIT(fb, d1);
        have_b = more; if (have_b) db = dst;
        if (!have_a) break;
    }
#undef CV_LOAD
#undef CV_EMIT
}

__device__ __forceinline__ void phase_prologue(const Frame& F) {
#if MK_CONVPROBE
    if ((F.c >> 3) >= 28) moe_conv_stream(F, 0, 12288, ((F.c >> 3) - 28) * 8 + (F.c & 7), 32);
#else
    moe_conv_stream(F, 0, CONV_L0DN_BEG, F.c, F.G);
    moe_conv_stream(F, CONV_L1GU_BEG, CONV_P10_BEG, F.c, F.G);
#endif
    for (int u = F.c; u < P0_END; u += F.G) {
        if (u >= P0_CONV4 && u < P0_CONV8) continue;
        if (u < P0_CONV0) conv_batched(F, u, F.in[L0_WIN], WS_WIN, 1024);
        else if (u < P0_CONV1) conv_batched8(F, u - P0_CONV0, F.in[L0_WGLU], WS_WGLU, 1024);
        else if (u < P0_CONV2) conv_batched(F, u - P0_CONV1, F.in[L0_WOUT], WS_WOUT, 1024);
        else if (u < P0_CONV3) { const int r = u - P0_CONV2; conv_unit8(F, F.in[L1_WQKV], F.ws + WS_WQKV, 3072, r / 24, r % 24, true); }
        else if (u < P0_CONV4) conv_batched8(F, u - P0_CONV3, F.in[L1_WO], WS_WO, 1024);
        else if (u < P0_CONV5) conv_batched8(F, u - P0_CONV4, F.in[L0_WGU], WS_WGU0, 2048);
        else if (u < P0_CONV6) conv_batched8(F, u - P0_CONV5, F.in[L0_WDN], WS_WDN0, 1024);
        else if (u < P0_CONV7) conv_batched8(F, u - P0_CONV6, F.in[L1_WGU], WS_WGU1, 2048);
        else if (u < P0_CONV8) conv_batched8(F, u - P0_CONV7, F.in[L1_WDN], WS_WDN1, 1024);
        else if (u < P0_ADA) { const int r = u - P0_CONV8; ada_unit(F, r / 96, r % 96); }
        else if (u < P0_S5) s5tab_unit(F, u - P0_ADA);
        else if (u < P0_ROPE) rope_unit(F, u - P0_S5);
        else if (u < P0_WRB) { const int idx = (u - P0_ROPE) * NTHREADS + F.tid, layer = idx >> 15, e = (idx >> 10) & 31, k = idx & 1023;
               ((bf16_t*)(F.ws + WS_WRB))[idx] = f2bf(F.in[layer ? L1_WR : L0_WR][k * 32 + e]); }
        else *(f32x4*)((float*)(F.ws + WS_KMEAN) + ((u - P0_WRB) * NTHREADS + F.tid) * 4) = (f32x4){0.f, 0.f, 0.f, 0.f};
    }
}

__device__ __forceinline__ void norm_mod_row(const float* __restrict__ xr, const float* __restrict__ gamma, const float* __restrict__ sh, const float* __restrict__ sc, bf16_t* __restrict__ hr, int lane) {
    f32x4 v[4]; float ss = 0.f;
#pragma unroll
    for (int i = 0; i < 4; ++i) { v[i] = *(const f32x4*)(xr + 256 * i + 4 * lane); ss += v[i][0] * v[i][0] + v[i][1] * v[i][1] + v[i][2] * v[i][2] + v[i][3] * v[i][3]; }
    ss = wave_sum(ss);
    const float rs = rsqrtf(ss * (1.f / 1024.f) + 1e-6f);
#pragma unroll
    for (int i = 0; i < 4; ++i) {
        const int col = 256 * i + 4 * lane;
        const f32x4 g = *(const f32x4*)(gamma + col), s1 = *(const f32x4*)(sc + col), s0 = *(const f32x4*)(sh + col);
        f32x4 y;
#pragma unroll
        for (int e = 0; e < 4; ++e) y[e] = v[i][e] * rs * g[e] * (1.f + s1[e]) + s0[e];
        u32x2 o; o.x = cvt_pk_bf16(y[0], y[1]); o.y = cvt_pk_bf16(y[2], y[3]);
        *(u32x2*)(hr + col) = o;
    }
}
__device__ __forceinline__ void phase_norm_mod(const Frame& F, const float* xin, const float* gamma, int layer, int which, bf16_t* hout) {
    const int lane = F.lane;
    for (int r = F.c * 8 + F.wave; r < T; r += F.G * 16) {
        const int r2 = r + F.G * 8; const bool two = r2 < T; const int rb = two ? r2 : r;
        f32x4 v[2][4];
#pragma unroll
        for (int i = 0; i < 4; ++i) { v[0][i] = *(const f32x4*)(xin + (size_t)r * DM + 256 * i + 4 * lane); v[1][i] = *(const f32x4*)(xin + (size_t)rb * DM + 256 * i + 4 * lane); }
#pragma unroll
        for (int q = 0; q < 2; ++q) {
            if (q == 1 && !two) break;
            const int rr = q ? rb : r, b = rr >> 13;
            const float* sh = ada_vec(F, layer, b, which); const float* sc = ada_vec(F, layer, b, which + 1);
            float ss = 0.f;
#pragma unroll
            for (int i = 0; i < 4; ++i) ss += v[q][i][0] * v[q][i][0] + v[q][i][1] * v[q][i][1] + v[q][i][2] * v[q][i][2] + v[q][i][3] * v[q][i][3];
            ss = wave_sum(ss);
            const float rs = rsqrtf(ss * (1.f / 1024.f) + 1e-6f);
#pragma unroll
            for (int i = 0; i < 4; ++i) {
                const int col = 256 * i + 4 * lane;
                const f32x4 g = *(const f32x4*)(gamma + col), s1 = *(const f32x4*)(sc + col), s0 = *(const f32x4*)(sh + col);
                f32x4 y;
#pragma unroll
                for (int e = 0; e < 4; ++e) y[e] = v[q][i][e] * rs * g[e] * (1.f + s1[e]) + s0[e];
                u32x2 o; o.x = cvt_pk_bf16(y[0], y[1]); o.y = cvt_pk_bf16(y[2], y[3]);
                *(u32x2*)(hout + (size_t)rr * DM + col) = o;
            }
        }
    }
}

template <class XT>
__device__ __forceinline__ void phase_norm_router(const Frame& F, const XT* xin, const bf16_t* mres, const float* gamma, int layer, unsigned char* hout) {
    const bf16_t* wrb = (const bf16_t*)(F.ws + WS_WRB) + (size_t)layer * 32 * 1024; const float* br = F.in[layer ? L1_BR : L0_BR];
    LAS unsigned char* hb = F.lds + F.wave * 16640;
    LAS int* cntl = (LAS int*)(F.lds + 133120);
    LAS int* basel = cntl + 32; LAS int* entl = cntl + 64;
    unsigned* gcnt = (unsigned*)(F.ws + ZB_MOECNT + layer * 256);
    int* pos = (int*)(F.ws + WS_TOPK); float* gates = (float*)(F.ws + WS_TOPK + (size_t)T * 4 * 4); int* vtok = (int*)(F.ws + WS_VTOK);
    const int lane = F.lane, e16 = lane & 15, kg = lane >> 4;
    for (int r0 = F.c * 64; r0 < T; r0 += F.G * 64) {
        if (F.tid < 32) cntl[F.tid] = 0;
        __syncthreads();
        const int rw = r0 + F.wave * 8;
        const int b = rw >> 13;
        const float* sh = ada_vec(F, layer, b, 3); const float* sc = ada_vec(F, layer, b, 4);
#pragma unroll 1
        for (int half = 0; half < 2; ++half) {
            f32x4 v[4][4]; u32x2 mr[4][4];
#pragma unroll
            for (int q = 0; q < 4; ++q)
#pragma unroll
                for (int i = 0; i < 4; ++i) { v[q][i] = load_x4(xin + (size_t)(rw + half * 4 + q) * DM + 256 * i + 4 * lane);
                                              mr[q][i] = *(const u32x2*)(mres + (size_t)(rw + half * 4 + q) * DM + 256 * i + 4 * lane); }
            { const float* g1 = ada_vec(F, layer, b, 2);
#pragma unroll
              for (int i = 0; i < 4; ++i) { const f32x4 gv = *(const f32x4*)(g1 + 256 * i + 4 * lane);
#pragma unroll
                for (int q = 0; q < 4; ++q) { v[q][i][0] = fmaf(gv[0], bf_lo(mr[q][i].x), v[q][i][0]); v[q][i][1] = fmaf(gv[1], bf_hi(mr[q][i].x), v[q][i][1]);
                                              v[q][i][2] = fmaf(gv[2], bf_lo(mr[q][i].y), v[q][i][2]); v[q][i][3] = fmaf(gv[3], bf_hi(mr[q][i].y), v[q][i][3]); } } }
#pragma unroll
            for (int q = 0; q < 4; ++q) {
                const int r = rw + half * 4 + q;
                float ss = 0.f;
#pragma unroll
                for (int i = 0; i < 4; ++i) ss += v[q][i][0] * v[q][i][0] + v[q][i][1] * v[q][i][1] + v[q][i][2] * v[q][i][2] + v[q][i][3] * v[q][i][3];
                ss = wave_sum(ss);
                const float rs = rsqrtf(ss * (1.f / 1024.f) + 1e-6f);
#pragma unroll
                for (int i = 0; i < 4; ++i) {
                    const int col = 256 * i + 4 * lane;
                    const f32x4 g = *(const f32x4*)(gamma + col), s1 = *(const f32x4*)(sc + col), s0 = *(const f32x4*)(sh + col);
                    f32x4 y;
#pragma unroll
                    for (int k = 0; k < 4; ++k) y[k] = v[q][i][k] * rs * g[k] * (1.f + s1[k]) + s0[k];
                    *(unsigned*)(hout + (size_t)r * DM + col) = pack_fp8x4(y[0], y[1], y[2], y[3]);
                    u32x2 o; o.x = cvt_pk_bf16(y[0], y[1]); o.y = cvt_pk_bf16(y[2], y[3]);
                    *(LAS u32x2*)(hb + (half * 4 + q) * 2080 + col * 2) = o;
                }
            }
        }
        f32x4 acc0 = {0.f, 0.f, 0.f, 0.f}, acc1 = {0.f, 0.f, 0.f, 0.f};
        const LAS unsigned char* ap = hb + (e16 & 7) * 2080 + kg * 16;
        const bf16_t* bp0 = wrb + (size_t)e16 * 1024 + kg * 8; const bf16_t* bp1 = bp0 + 16 * 1024;
#pragma unroll 8
        for (int ks = 0; ks < 32; ++ks) {
            const bf16x8 a = *(const LAS bf16x8*)(ap + ks * 64);
            const bf16x8 w0 = *(const bf16x8*)(bp0 + ks * 32), w1 = *(const bf16x8*)(bp1 + ks * 32);
            acc0 = __builtin_amdgcn_mfma_f32_16x16x32_bf16(a, w0, acc0, 0, 0, 0);
            acc1 = __builtin_amdgcn_mfma_f32_16x16x32_bf16(a, w1, acc1, 0, 0, 0);
        }
        const float bias0 = br[e16], bias1 = br[16 + e16];
#pragma unroll
        for (int reg = 0; reg < 4; ++reg) {
            float v0 = acc0[reg] + bias0, v1 = acc1[reg] + bias1;
            const int r = rw + ((4 * kg + reg) & 7);
            int ek[4]; float vk[4];
#pragma unroll
            for (int k = 0; k < 4; ++k) {
                const float m = row16_max(fmaxf(v0, v1));
                const int cand = row16_min((v0 == m) ? e16 : ((v1 == m) ? 16 + e16 : 99));
                ek[k] = cand; vk[k] = m;
                if (cand == e16) v0 = -INFINITY; else if (cand == 16 + e16) v1 = -INFINITY;
            }
            const float e1 = __expf(vk[1] - vk[0]), e2 = __expf(vk[2] - vk[0]), e3 = __expf(vk[3] - vk[0]);
            const float inv = 1.f / (1.f + e1 + e2 + e3);
            if (kg < 2 && e16 < 4) {
                const int ee = e16 == 0 ? ek[0] : e16 == 1 ? ek[1] : e16 == 2 ? ek[2] : ek[3];
                const float gg = (e16 == 0 ? 1.f : e16 == 1 ? e1 : e16 == 2 ? e2 : e3) * inv;
                const int rank = __hip_atomic_fetch_add(&cntl[ee], 1, __ATOMIC_RELAXED, __HIP_MEMORY_SCOPE_WORKGROUP);
                entl[(r - r0) * 4 + e16] = (ee << 16) | rank;
                gates[(size_t)r * 4 + e16] = gg;
            }
        }
        __syncthreads();
        if (F.tid < 32) basel[F.tid] = (int)atomicAdd(&gcnt[F.tid], (unsigned)cntl[F.tid]);
        __syncthreads();
        if (F.tid < 256) {
            const int en = entl[F.tid], ee = en >> 16, v = basel[ee] + (en & 0xffff), tk = r0 * 4 + F.tid;
            vtok[ee * MOE_CAP + v] = tk; pos[tk] = ee * MOE_CAP + v;
        }
        __syncthreads();
    }
}

namespace pg {
constexpr int BM = 256, BK = 64, HALF = 128, HTB = HALF * BK * 2, STAGE_BYTES = 8 * HTB, NXCD = 8, WGM = 8, KD = 1024, NKT = KD / BK;
__device__ __forceinline__ int lds_byte(int r, int c) { const int st = (r >> 4) * 2 + (c >> 5), rr = r & 15, cc = c & 31, ob = rr * 64 + cc * 2; return st * 1024 + (ob ^ (((ob >> 9) & 1) << 5)); }
__device__ __forceinline__ void stage_rc(int b, int& R, int& C) { const int st = b / 1024, sb = b % 1024, swz = sb ^ (((sb >> 9) & 1) << 5); R = (st >> 1) * 16 + swz / 64; C = (st & 1) * 32 + (swz % 64) / 2; }
__device__ __forceinline__ int perm32(int rho) { const int n = rho >> 4, i = rho & 15; return 8 * (i >> 2) + 4 * n + (i & 3); }

struct Unit { int rt, pn, e, ui; };

template <class P>
__device__ __forceinline__ void gemm_phase(LAS unsigned char* lds, const P& S) {
    const int tid = threadIdx.x, wid = __builtin_amdgcn_readfirstlane(tid >> 6), lane = tid & 63, wr = wid >> 2, wc = wid & 3, fr = lane & 15, fq = lane >> 4;
    int R0, C0; stage_rc(tid * 16, R0, C0);
    constexpr int ROWB = P::FP8 ? 1024 : 2048, NKT_ = ROWB / 128, KREP = P::KREP;
    unsigned voffB[2];
#pragma unroll
    for (int i = 0; i < 2; ++i) { const int R = R0 + 64 * i, Rb = P::PERM ? ((R & ~31) + perm32(R & 31)) : R; voffB[i] = (unsigned)(Rb * ROWB + C0 * 2); }
    const unsigned cofs = (unsigned)C0 * 2u;
    const unsigned ldsw = (unsigned)wid * 1024u;
    const int aoff = lds_byte(wr * 64 + fr, fq * 8), boff = lds_byte(wc * 32 + fr, fq * 8);
#define PG_SA(b, h) (((b) * 2 + (h)) * HTB)
#define PG_SB(b, h) ((4 + (b) * 2 + (h)) * HTB)
#define PG_STA(bufoff, kptr, V0, V1) do { \
        __builtin_amdgcn_global_load_lds((const unsigned*)((kptr) + (V0)), (LAS unsigned*)(lds + (bufoff) + ldsw), 16, 0, 0); \
        __builtin_amdgcn_global_load_lds((const unsigned*)((kptr) + (V1)), (LAS unsigned*)(lds + (bufoff) + ldsw + 8192), 16, 0, 0); } while (0)
#define PG_STB(bufoff, bptr) PG_STA(bufoff, bptr, voffB[0], voffB[1])
#define PG_LDA(dst, b, h) do { _Pragma("unroll") for (int m = 0; m < 4; ++m) dst[m] = __builtin_shufflevector(*(const LAS v4i*)(lds + PG_SA(b, h) + aoff + m * 2048), *(const LAS v4i*)(lds + PG_SA(b, h) + aoff + m * 2048 + 1024), 0, 1, 2, 3, 4, 5, 6, 7); } while (0)
#define PG_LDB(dst, b, h) do { _Pragma("unroll") for (int n = 0; n < 2; ++n) dst[n] = __builtin_shufflevector(*(const LAS v4i*)(lds + PG_SB(b, h) + boff + n * 2048), *(const LAS v4i*)(lds + PG_SB(b, h) + boff + n * 2048 + 1024), 0, 1, 2, 3, 4, 5, 6, 7); } while (0)
#define PG_LO(X) __builtin_bit_cast(bf16x8, __builtin_shufflevector(X, X, 0, 1, 2, 3))
#define PG_HI(X) __builtin_bit_cast(bf16x8, __builtin_shufflevector(X, X, 4, 5, 6, 7))
#define PG_MMA(ai, bj, At, Bt) do { __builtin_amdgcn_s_setprio(1); _Pragma("unroll") for (int m = 0; m < 4; ++m) _Pragma("unroll") for (int n = 0; n < 2; ++n) { \
        if constexpr (P::FP8) asm volatile("v_mfma_scale_f32_16x16x128_f8f6f4 %0, %1, %2, %0, %3, %3 op_sel_hi:[0,0,0]" : "+v"(acc[ai][bj][m][n]) : "v"(Bt[n]), "v"(At[m]), "v"(fp8_one)); \
        else { acc[ai][bj][m][n] = __builtin_amdgcn_mfma_f32_16x16x32_bf16(PG_LO(Bt[n]), PG_LO(At[m]), acc[ai][bj][m][n], 0, 0, 0); \
               acc[ai][bj][m][n] = __builtin_amdgcn_mfma_f32_16x16x32_bf16(PG_HI(Bt[n]), PG_HI(At[m]), acc[ai][bj][m][n], 0, 0, 0); } } \
        __builtin_amdgcn_s_setprio(0); } while (0)
#define PG_WAIT_V(n) asm volatile("s_waitcnt vmcnt(" #n ")" ::: "memory")
#define PG_WAIT_L(n) asm volatile("s_waitcnt lgkmcnt(" #n ")" ::: "memory")
#define PG_BAR __builtin_amdgcn_s_barrier()
#define PG_SCHED __builtin_amdgcn_sched_barrier(0)
    Unit cur, nxt; int ui = 0;
    if (!S.next(0, cur)) return;
    f32x4 acc[2][2][4][2];
    {   f32x4 bi[2][2]; S.binit(cur, wc, fq, bi);
#pragma unroll
        for (int a = 0; a < 2; ++a)
#pragma unroll
            for (int b = 0; b < 2; ++b)
#pragma unroll
                for (int m = 0; m < 4; ++m)
#pragma unroll
                    for (int n = 0; n < 2; ++n) acc[a][b][m][n] = bi[b][n]; }
    v8i At[4], B0[2], B1[2];
    int fp8_one = 0x7F7F7F7F; asm volatile("" : "+v"(fp8_one));
    unsigned va0, va1, va2, va3, vn0, vn1, vn2, vn3;
    S.arows(cur, R0, cofs, va0, va1, va2, va3);
    const char* cb0; const char* cb1; S.bptr(cur, cb0, cb1);
    const char* const A0 = S.abase();
    PG_STB(PG_SB(0, 0), cb0); PG_STA(PG_SA(0, 0), A0, va0, va1); PG_STB(PG_SB(0, 1), cb1); PG_STA(PG_SA(0, 1), A0, va2, va3);
    if (wr == 1) PG_BAR;
    PG_WAIT_V(4); PG_BAR;
    PG_STB(PG_SB(1, 0), cb0 + 128); PG_STA(PG_SA(1, 0), A0 + 128, va0, va1); PG_STB(PG_SB(1, 1), cb1 + 128);
    PG_WAIT_V(6); PG_BAR;
    for (;;) {
        const bool has_next = S.next(ui + 1, nxt);
        const char* nb0 = cb0; const char* nb1 = cb1; vn0 = va0; vn1 = va1; vn2 = va2; vn3 = va3;
        if (has_next) { S.arows(nxt, R0, cofs, vn0, vn1, vn2, vn3); S.bptr(nxt, nb0, nb1); }
#pragma unroll 1
        for (int tt = 0; tt < NKT_ * KREP; tt += 2) {
            const int t = tt % NKT_;
            const bool wrap = (t == NKT_ - 2), last = wrap && (tt == NKT_ * KREP - 2);
            const int kt2 = wrap ? 0 : t + 2;
            const char* a1 = A0 + (size_t)(t + 1) * 128; const char* a2 = A0 + (size_t)kt2 * 128; const char* a3 = a2 + 128;
            const char* b20 = (last ? nb0 : cb0) + (size_t)kt2 * 128; const char* b21 = (last ? nb1 : cb1) + (size_t)kt2 * 128;
            const unsigned w0 = last ? vn0 : va0, w1 = last ? vn1 : va1, w2 = last ? vn2 : va2, w3 = last ? vn3 : va3;
            PG_LDB(B0, 0, 0); PG_SCHED; PG_LDA(At, 0, 0); PG_STA(PG_SA(1, 1), a1, va2, va3);
            PG_WAIT_L(8); PG_BAR; PG_WAIT_L(0); PG_MMA(0, 0, At, B0); PG_BAR; PG_SCHED;
            PG_LDB(B1, 0, 1); PG_STB(PG_SB(0, 0), b20);
            PG_BAR; PG_WAIT_L(0); PG_MMA(0, 1, At, B1); PG_BAR;
            PG_LDA(At, 0, 1); PG_STA(PG_SA(0, 0), a2, w0, w1);
            PG_BAR; PG_WAIT_L(0); PG_MMA(1, 0, At, B0); PG_BAR; PG_SCHED;
            PG_STB(PG_SB(0, 1), b21);
            PG_WAIT_V(6); PG_BAR; PG_MMA(1, 1, At, B1); PG_BAR;
            PG_LDB(B0, 1, 0); PG_SCHED; PG_LDA(At, 1, 0); PG_STA(PG_SA(0, 1), a2, w2, w3);
            PG_WAIT_L(8); PG_BAR; PG_WAIT_L(0); PG_MMA(0, 0, At, B0); PG_BAR; PG_SCHED;
            PG_LDB(B1, 1, 1); PG_STB(PG_SB(1, 0), b20 + 128);
            PG_BAR; PG_WAIT_L(0); PG_MMA(0, 1, At, B1); PG_BAR;
            PG_LDA(At, 1, 1); PG_STA(PG_SA(1, 0), a3, w0, w1);
            PG_BAR; PG_WAIT_L(0); PG_MMA(1, 0, At, B0); PG_BAR; PG_SCHED;
            PG_STB(PG_SB(1, 1), b21 + 128);
            PG_WAIT_V(6); PG_BAR; PG_MMA(1, 1, At, B1); PG_BAR;
        }
        f32x4 bn[2][2];
        if (has_next) S.binit(nxt, wc, fq, bn);
        if constexpr (P::FP8) asm volatile("s_nop 15\n\ts_nop 15" ::: "memory");
        S.epi(acc, cur, wr, wc, fr, fq);
        if (!has_next) break;
#pragma unroll
        for (int a = 0; a < 2; ++a)
#pragma unroll
            for (int b = 0; b < 2; ++b)
#pragma unroll
                for (int m = 0; m < 4; ++m)
#pragma unroll
                    for (int n = 0; n < 2; ++n) acc[a][b][m][n] = bn[b][n];
        cur = nxt; cb0 = nb0; cb1 = nb1; va0 = vn0; va1 = vn1; va2 = vn2; va3 = vn3; ++ui;
    }
    PG_WAIT_V(0);
    if (wr == 0) PG_BAR;
    PG_BAR;
#undef PG_SA
#undef PG_SB
#undef PG_STA
#undef PG_STB
#undef PG_LDA
#undef PG_LDB
#undef PG_MMA
#undef PG_LO
#undef PG_HI
#undef PG_WAIT_V
#undef PG_WAIT_L
#undef PG_BAR
#undef PG_SCHED
}

template <class Epi, bool FP8_ = false> struct Dense {
    static constexpr bool PERM = Epi::PERM, FP8 = FP8_; static constexpr int KREP = 1;
    static constexpr unsigned ROWB = FP8_ ? 1024u : 2048u;
    const void* A; const void* Bt; int nM, nN, G, c; Epi E;
    __device__ __forceinline__ bool next(int i, Unit& u) const {
        const int nwg = nM * nN; const long L = (long)i * G + c; if (L >= nwg) return false;
        int wgid = (int)L; { const int q = nwg / NXCD, r = nwg % NXCD, xcd = wgid % NXCD, off = wgid / NXCD; wgid = (xcd < r ? xcd * (q + 1) : r * (q + 1) + (xcd - r) * q) + off; }
        const int nig = WGM * nN, gid = wgid / nig, fm = gid * WGM, gsz = (nM - fm) < WGM ? (nM - fm) : WGM;
        u.rt = fm + ((wgid % nig) % gsz); u.pn = (wgid % nig) / gsz; u.e = 0; u.ui = i; return true;
    }
    __device__ __forceinline__ void arows(const Unit& u, int R0, unsigned cofs, unsigned& v0, unsigned& v1, unsigned& v2, unsigned& v3) const {
        const unsigned base = (unsigned)(u.rt * 256 + R0) * ROWB + cofs; v0 = base; v1 = base + 64u * ROWB; v2 = base + 128u * ROWB; v3 = base + 192u * ROWB;
    }
    __device__ __forceinline__ const char* abase() const { return (const char*)A; }
    __device__ __forceinline__ void bptr(const Unit& u, const char*& b0, const char*& b1) const { b0 = (const char*)Bt + (size_t)u.pn * 256 * ROWB; b1 = b0 + (size_t)128 * ROWB; }
    __device__ __forceinline__ void epi(const f32x4 (&acc)[2][2][4][2], const Unit& u, int wr, int wc, int fr, int fq) const { E(acc, u, wr, wc, fr, fq); }
    __device__ __forceinline__ void binit(const Unit&, int, int, f32x4 (&bi)[2][2]) const { bi[0][0] = bi[0][1] = bi[1][0] = bi[1][1] = (f32x4){0.f, 0.f, 0.f, 0.f}; }
};

struct EpiBf16 {
    static constexpr bool PERM = true;
    bf16_t* O; float sc;
    __device__ __forceinline__ void operator()(const f32x4 (&acc)[2][2][4][2], const Unit& u, int wr, int wc, int fr, int fq) const {
        const int row0 = u.rt * 256 + wr * 64 + fr, col0 = u.pn * 256 + wc * 32 + 8 * fq;
#pragma unroll
        for (int ai = 0; ai < 2; ++ai)
#pragma unroll
            for (int m = 0; m < 4; ++m) { bf16_t* rowp = O + (size_t)(row0 + ai * 128 + m * 16) * 1024 + col0;
#pragma unroll
                for (int bj = 0; bj < 2; ++bj) { const f32x4 v0 = acc[ai][bj][m][0] * sc, v1 = acc[ai][bj][m][1] * sc;
                    u32x4 w; w.x = cvt_pk_bf16(v0[0], v0[1]); w.y = cvt_pk_bf16(v0[2], v0[3]); w.z = cvt_pk_bf16(v1[0], v1[1]); w.w = cvt_pk_bf16(v1[2], v1[3]);
                    *(u32x4*)(rowp + bj * 128) = w; } }
    }
};
struct EpiGlu {
    static constexpr bool PERM = true;
    const bf16_t* Z; bf16_t* O; float sc;
    __device__ __forceinline__ void operator()(const f32x4 (&acc)[2][2][4][2], const Unit& u, int wr, int wc, int fr, int fq) const {
        const int row0 = u.rt * 256 + wr * 64 + fr, col0 = u.pn * 256 + wc * 32 + 8 * fq;
#pragma unroll
        for (int ai = 0; ai < 2; ++ai)
#pragma unroll
            for (int m = 0; m < 4; ++m) { const size_t ro = (size_t)(row0 + ai * 128 + m * 16) * 1024 + col0;
#pragma unroll
                for (int bj = 0; bj < 2; ++bj) { const f32x4 v0 = acc[ai][bj][m][0] * sc, v1 = acc[ai][bj][m][1] * sc;
                    const u32x4 z = *(const u32x4*)(Z + ro + bj * 128);
                    u32x4 w;
                    w.x = cvt_pk_bf16(bf_lo(z.x) * sigmoidf_fast(v0[0]), bf_hi(z.x) * sigmoidf_fast(v0[1]));
                    w.y = cvt_pk_bf16(bf_lo(z.y) * sigmoidf_fast(v0[2]), bf_hi(z.y) * sigmoidf_fast(v0[3]));
                    w.z = cvt_pk_bf16(bf_lo(z.z) * sigmoidf_fast(v1[0]), bf_hi(z.z) * sigmoidf_fast(v1[1]));
                    w.w = cvt_pk_bf16(bf_lo(z.w) * sigmoidf_fast(v1[2]), bf_hi(z.w) * sigmoidf_fast(v1[3]));
                    *(u32x4*)(O + ro + bj * 128) = w; } }
    }
};
struct EpiResid {
    static constexpr bool PERM = false;
    const float* Xi; float* Xo; const float* gate0; const float* gate1; float sc;
    __device__ __forceinline__ void operator()(const f32x4 (&acc)[2][2][4][2], const Unit& u, int wr, int wc, int fr, int fq) const {
        const int row0 = u.rt * 256 + wr * 64 + fr, col0 = u.pn * 256 + wc * 32 + 4 * fq;
        const float* gate = (u.rt * 256 >= SEQ) ? gate1 : gate0;
        f32x4 gv[2][2];
#pragma unroll
        for (int bj = 0; bj < 2; ++bj)
#pragma unroll
            for (int n = 0; n < 2; ++n) gv[bj][n] = *(const f32x4*)(gate + col0 + bj * 128 + n * 16) * sc;
#pragma unroll
        for (int ai = 0; ai < 2; ++ai)
#pragma unroll
            for (int m = 0; m < 4; ++m) { const size_t ro = (size_t)(row0 + ai * 128 + m * 16) * 1024 + col0;
#pragma unroll
                for (int bj = 0; bj < 2; ++bj)
#pragma unroll
                    for (int n = 0; n < 2; ++n) { const f32x4 xi = *(const f32x4*)(Xi + ro + bj * 128 + n * 16); *(f32x4*)(Xo + ro + bj * 128 + n * 16) = xi + gv[bj][n] * acc[ai][bj][m][n]; } }
    }
};
struct EpiQkv {
    static constexpr bool PERM = true;
    bf16_t* Q; const float* cs; const float* sn; float sc; float* km;
    __device__ __forceinline__ void operator()(const f32x4 (&acc)[2][2][4][2], const Unit& u, int wr, int wc, int fr, int fq) const {
        const int sec = u.pn >> 2, row0 = u.rt * 256 + wr * 64 + fr, col0 = (u.pn & 3) * 256 + wc * 32 + 8 * fq, d0 = 16 * wc + 4 * fq;
        bf16_t* O = Q + (size_t)sec * T * DM;
        float ks[2][8];
#pragma unroll
        for (int bj = 0; bj < 2; ++bj)
#pragma unroll
            for (int j = 0; j < 8; ++j) ks[bj][j] = 0.f;
#pragma unroll
        for (int ai = 0; ai < 2; ++ai)
#pragma unroll
            for (int m = 0; m < 4; ++m) { const int row = row0 + ai * 128 + m * 16; bf16_t* rowp = O + (size_t)row * 1024 + col0;
                f32x4 c = {1.f, 1.f, 1.f, 1.f}, s = {0.f, 0.f, 0.f, 0.f};
                if (sec < 2) { c = *(const f32x4*)(cs + (size_t)row * 64 + d0); s = *(const f32x4*)(sn + (size_t)row * 64 + d0); }
#pragma unroll
                for (int bj = 0; bj < 2; ++bj) { const f32x4 v0 = acc[ai][bj][m][0] * sc, v1 = acc[ai][bj][m][1] * sc;
                    float r[8];
                    if (sec < 2) {
                        r[0] = v0[0] * c[0] - v0[1] * s[0]; r[1] = v0[1] * c[0] + v0[0] * s[0];
                        r[2] = v0[2] * c[1] - v0[3] * s[1]; r[3] = v0[3] * c[1] + v0[2] * s[1];
                        r[4] = v1[0] * c[2] - v1[1] * s[2]; r[5] = v1[1] * c[2] + v1[0] * s[2];
                        r[6] = v1[2] * c[3] - v1[3] * s[3]; r[7] = v1[3] * c[3] + v1[2] * s[3];
                    } else { r[0] = v0[0]; r[1] = v0[1]; r[2] = v0[2]; r[3] = v0[3]; r[4] = v1[0]; r[5] = v1[1]; r[6] = v1[2]; r[7] = v1[3]; }
                    if (sec == 1) {
#pragma unroll
                        for (int j = 0; j < 8; ++j) ks[bj][j] += r[j]; }
                    u32x4 w; w.x = cvt_pk_bf16(r[0], r[1]); w.y = cvt_pk_bf16(r[2], r[3]); w.z = cvt_pk_bf16(r[4], r[5]); w.w = cvt_pk_bf16(r[6], r[7]);
                    *(u32x4*)(rowp + bj * 128) = w; } }
        if (sec == 1) {
            const int b = (u.rt * 256) >> 13, n = (u.rt & 31);
#pragma unroll
            for (int bj = 0; bj < 2; ++bj) {
                const int h = (u.pn & 3) * 2 + bj;
#pragma unroll
                for (int j = 0; j < 8; ++j) ks[bj][j] = row16_sum(ks[bj][j]);
                if (fr == 0) { float* kp = km + ((size_t)(b * 8 + h) * 32 + n) * 128 + wc * 32 + 8 * fq;
#pragma unroll
                    for (int j = 0; j < 8; ++j) atomicAdd(kp + j, ks[bj][j] * (1.f / 256.f)); }
            }
        }
    }
};

constexpr int MOE_LDS_IDX = STAGE_BYTES;
constexpr int MOE_LDS_TILE_E = STAGE_BYTES + 12 * 1024;
constexpr int MOE_LDS_EBASE = MOE_LDS_TILE_E + 1280;
constexpr int MOE_LDS_ECNT = MOE_LDS_EBASE + 256;
struct MoeTabs { LAS int* idx; LAS int* tile_e; LAS int* ebase; LAS int* ecnt; int R; };
struct MoeGeo { int W, x, s, G, c; bool xcd; };
__device__ __forceinline__ MoeGeo moe_geo(int G, int c, int W) { MoeGeo g; g.xcd = (G == 256); g.W = W; g.x = c & 7; g.s = c >> 3; g.G = G; g.c = c; return g; }
template <int NPN>
__device__ __forceinline__ bool moe_unit(int i, const MoeGeo& g, int R, int& rt, int& pn) {
    if (g.xcd) {
        const int total = R * NPN, quota = (total + 7) >> 3, local = i * g.W + g.s, U = g.x * quota + local;
        rt = U / NPN; pn = U % NPN; return local < quota && U < total; }
    const long L = (long)i * g.G + g.c; rt = (int)(L / NPN); pn = (int)(L % NPN); return rt < R;
}
template <int NPN>
__device__ __forceinline__ MoeTabs moe_setup(const Frame& F, int layer, bool want_idx, const MoeGeo& geo) {
    MoeTabs M; M.idx = (LAS int*)(F.lds + MOE_LDS_IDX); M.tile_e = (LAS int*)(F.lds + MOE_LDS_TILE_E); M.ebase = (LAS int*)(F.lds + MOE_LDS_EBASE); M.ecnt = (LAS int*)(F.lds + MOE_LDS_ECNT);
    const unsigned* gcnt = (const unsigned*)(F.ws + ZB_MOECNT + layer * 256);
    if (F.tid < 64) {
        const int cnt = F.tid < 32 ? (int)gcnt[F.tid] : 0, nt = (cnt + 255) >> 8;
        int incl = nt;
#pragma unroll
        for (int o = 1; o < 32; o <<= 1) { const int y = __shfl_up(incl, o, 64); if (F.lane >= o) incl += y; }
        if (F.tid < 32) { M.ecnt[F.tid] = cnt; M.ebase[F.tid] = incl - nt; }
        if (F.tid == 31) M.ebase[32] = incl;
    }
    __syncthreads();
    M.R = M.ebase[32];
    if (F.tid < M.R) { int lo = 0, hi = 31;
        while (lo < hi) { const int mid = (lo + hi + 1) >> 1; if (M.ebase[mid] <= F.tid) lo = mid; else hi = mid - 1; }
        M.tile_e[F.tid] = lo; }
    __syncthreads();
    if (want_idx) {
        const int* vtok = (const int*)(F.ws + WS_VTOK);
        int tk[12];
#pragma unroll
        for (int i = 0; i < 12; ++i) { int rt, pn; tk[i] = 0;
            if (F.tid < 256 && moe_unit<NPN>(i, geo, M.R, rt, pn)) { const int e = M.tile_e[rt], v = (rt - M.ebase[e]) * 256 + F.tid; if (v < M.ecnt[e]) tk[i] = vtok[e * MOE_CAP + v]; } }
        if (F.tid < 256) {
#pragma unroll
            for (int i = 0; i < 12; ++i) M.idx[i * 256 + F.tid] = tk[i] >> 2; }
        __syncthreads();
    }
    return M;
}

__device__ __forceinline__ MoeTabs moe_tabs_reuse(const Frame& F) {
    MoeTabs M; M.idx = (LAS int*)(F.lds + MOE_LDS_IDX); M.tile_e = (LAS int*)(F.lds + MOE_LDS_TILE_E); M.ebase = (LAS int*)(F.lds + MOE_LDS_EBASE); M.ecnt = (LAS int*)(F.lds + MOE_LDS_ECNT);
    M.R = M.ebase[32]; return M;
}
struct MoeGateUp {
    static constexpr bool PERM = true, FP8 = true; static constexpr int KREP = MK_KREP;
    const unsigned char* A; const unsigned char* W; const float* bias; unsigned char* O; MoeTabs M; MoeGeo geo;
    __device__ __forceinline__ bool next(int i, Unit& u) const {
        if (!moe_unit<8>(i, geo, M.R, u.rt, u.pn)) return false;
        u.e = __builtin_amdgcn_readfirstlane(M.tile_e[u.rt]); u.ui = i; return true;
    }
    __device__ __forceinline__ void arows(const Unit& u, int R0, unsigned cofs, unsigned& v0, unsigned& v1, unsigned& v2, unsigned& v3) const {
        const LAS int* ip = M.idx + u.ui * 256 + R0;
        v0 = (unsigned)ip[0] * 1024u + cofs; v1 = (unsigned)ip[64] * 1024u + cofs; v2 = (unsigned)ip[128] * 1024u + cofs; v3 = (unsigned)ip[192] * 1024u + cofs;
    }
    __device__ __forceinline__ const char* abase() const { return (const char*)A; }
    __device__ __forceinline__ void bptr(const Unit& u, const char*& b0, const char*& b1) const {
        const unsigned char* w = W + (size_t)u.e * 2048 * KD; b0 = (const char*)(w + (size_t)(u.pn * 128) * KD); b1 = (const char*)(w + (size_t)(1024 + u.pn * 128) * KD);
    }
    __device__ __forceinline__ void binit(const Unit& u, int wc, int fq, f32x4 (&bi)[2][2]) const {
        const float* bp = bias + (size_t)u.e * 2048 + u.pn * 128 + wc * 32 + 8 * fq; constexpr float IS = FP8_WSCALE * MK_KREP;
        bi[0][0] = *(const f32x4*)bp * IS; bi[0][1] = *(const f32x4*)(bp + 4) * IS; bi[1][0] = *(const f32x4*)(bp + 1024) * IS; bi[1][1] = *(const f32x4*)(bp + 1028) * IS;
    }
    __device__ __forceinline__ void epi(const f32x4 (&acc)[2][2][4][2], const Unit& u, int wr, int wc, int fr, int fq) const {
        const int row0 = u.rt * 256 + wr * 64 + fr, col0 = u.pn * 128 + wc * 32 + 8 * fq;
        constexpr float SC = 1.f / (FP8_WSCALE * MK_KREP);
#pragma unroll
        for (int ai = 0; ai < 2; ++ai)
#pragma unroll
            for (int m = 0; m < 4; ++m) {
                unsigned wq[2];
#pragma unroll
                for (int n = 0; n < 2; ++n) {
                    f32x4 g = acc[ai][0][m][n] * SC, uu = acc[ai][1][m][n] * SC;
#pragma unroll
                    for (int j = 0; j < 4; ++j) { g[j] = fminf(g[j], 7.f); uu[j] = __builtin_amdgcn_fmed3f(uu[j], -7.f, 7.f); }
                    f32x4 t = g * (-1.702f * 1.4426950408889634f);
#pragma unroll
                    for (int j = 0; j < 4; ++j) t[j] = __builtin_amdgcn_exp2f(t[j]);
                    f32x4 d = t * (1.f / FP8_ASCALE) + (1.f / FP8_ASCALE);
#pragma unroll
                    for (int j = 0; j < 4; ++j) d[j] = __builtin_amdgcn_rcpf(d[j]);
                    const f32x4 o = (uu * g + g) * d;
                    wq[n] = pack_fp8x4_nc(o[0], o[1], o[2], o[3]);
                }
                u32x2 w; w.x = wq[0]; w.y = wq[1];
                *(u32x2*)(O + (size_t)(row0 + ai * 128 + m * 16) * 1024 + col0) = w;
            }
    }
};
struct MoeDown {
    static constexpr bool PERM = true, FP8 = true; static constexpr int KREP = MK_KREP;
    const unsigned char* A; const unsigned char* W; const float* bias; unsigned char* O; MoeTabs M; MoeGeo geo;
    __device__ __forceinline__ bool next(int i, Unit& u) const {
        if (!moe_unit<4>(i, geo, M.R, u.rt, u.pn)) return false;
        u.e = __builtin_amdgcn_readfirstlane(M.tile_e[u.rt]); u.ui = i; return true;
    }
    __device__ __forceinline__ void arows(const Unit& u, int R0, unsigned cofs, unsigned& v0, unsigned& v1, unsigned& v2, unsigned& v3) const {
        const unsigned base = (unsigned)(u.rt * 256 + R0) * 1024u + cofs; v0 = base; v1 = base + 64u * 1024u; v2 = base + 128u * 1024u; v3 = base + 192u * 1024u;
    }
    __device__ __forceinline__ const char* abase() const { return (const char*)A; }
    __device__ __forceinline__ void bptr(const Unit& u, const char*& b0, const char*& b1) const { b0 = (const char*)(W + (size_t)u.e * 1024 * KD + (size_t)u.pn * 256 * KD); b1 = b0 + (size_t)128 * KD; }
    __device__ __forceinline__ void binit(const Unit& u, int wc, int fq, f32x4 (&bi)[2][2]) const {
        const float* bp = bias + (size_t)u.e * 1024 + u.pn * 256 + wc * 32 + 8 * fq; constexpr float IS = FP8_WSCALE * FP8_ASCALE * MK_KREP;
#pragma unroll
        for (int bj = 0; bj < 2; ++bj) { bi[bj][0] = *(const f32x4*)(bp + bj * 128) * IS; bi[bj][1] = *(const f32x4*)(bp + bj * 128 + 4) * IS; }
    }
    __device__ __forceinline__ void epi(const f32x4 (&acc)[2][2][4][2], const Unit& u, int wr, int wc, int fr, int fq) const {
        const int row0 = u.rt * 256 + wr * 64 + fr, col0 = u.pn * 256 + wc * 32 + 8 * fq;
        constexpr float SC = FP8_YSCALE / (FP8_WSCALE * FP8_ASCALE * MK_KREP);
#pragma unroll
        for (int ai = 0; ai < 2; ++ai)
#pragma unroll
            for (int m = 0; m < 4; ++m) { unsigned char* rowp = O + (size_t)(row0 + ai * 128 + m * 16) * 1024 + col0;
#pragma unroll
                for (int bj = 0; bj < 2; ++bj) { f32x4 v0 = acc[ai][bj][m][0] * SC, v1 = acc[ai][bj][m][1] * SC;
#pragma unroll
                    for (int j = 0; j < 4; ++j) { v0[j] = __builtin_amdgcn_fmed3f(v0[j], -448.f, 448.f); v1[j] = __builtin_amdgcn_fmed3f(v1[j], -448.f, 448.f); }
                    u32x2 w; w.x = pack_fp8x4_nc(v0[0], v0[1], v0[2], v0[3]); w.y = pack_fp8x4_nc(v1[0], v1[1], v1[2], v1[3]);
                    *(u32x2*)(rowp + bj * 128) = w; } }
    }
};
}

template <int OFF> __device__ __forceinline__ s16x4 ds_tr_read(int vb) {
    s16x4 r; asm volatile("ds_read_b64_tr_b16 %0, %1 offset:%2" : "=&v"(r) : "v"(vb), "i"(OFF) : "memory"); return r;
}
constexpr int S5_PITCH = 136, S5_IMG = 128 * S5_PITCH;

template <bool FULL>
__device__ __forceinline__ void phase_s5(const Frame& F, const bf16_t* __restrict__ U, bf16_t* __restrict__ Z, unsigned char* __restrict__ Z8) {
    const int lane = F.lane, n = lane & 31, h = lane >> 5;
    const float* tab = (const float*)(F.ws + WS_S5A);
    const bf16_t* bop = (const bf16_t*)(F.ws + WS_BOP); const bf16_t* cop = (const bf16_t*)(F.ws + WS_COP);
    float* carry = (float*)(F.ws + WS_CARRY);
    const float* dsk = F.in[L0_D];
    LAS unsigned char* xt = F.lds + F.wave * S5_IMG;
    for (int w = F.c; w < 2048; w += F.G) {
        const int g = (w & 7) * 8 + F.wave, chunk = (w >> 3) & 127, b = w >> 10;
        const int tok0 = b * SEQ + chunk * 64;
        bf16x8 Aop[2], Bop[4];
#pragma unroll
        for (int mt = 0; mt < 2; ++mt) { const int time = 32 * ((n >> 2) & 1) + 16 * mt + 4 * (n >> 3) + (n & 3);
            Aop[mt] = *(const bf16x8*)(U + (size_t)(tok0 + time) * DM + g * 16 + 8 * h); }
#pragma unroll
        for (int nt = 0; nt < 4; ++nt) Bop[nt] = *(const bf16x8*)(bop + (size_t)((g * 128 + nt * 32 + n) * 16 + 8 * h));
        f32x16 acc[2][4];
#pragma unroll
        for (int mt = 0; mt < 2; ++mt)
#pragma unroll
            for (int nt = 0; nt < 4; ++nt) { f32x16 z = {}; acc[mt][nt] = __builtin_amdgcn_mfma_f32_32x32x16_bf16(Aop[mt], Bop[nt], z, 0, 0, 0); }
        const float a0r = tab[g * 64 + n], a0i = tab[4096 + g * 64 + n], a1r = tab[g * 64 + 32 + n], a1i = tab[4096 + g * 64 + 32 + n];
        float* cp = carry + ((size_t)(b * 256 + chunk * 2 + h) * 64 + g) * 128;
        float x0r = 0.f, x0i = 0.f, x1r = 0.f, x1i = 0.f;
        if (FULL) { x0r = cp[n]; x0i = cp[64 + n]; x1r = cp[32 + n]; x1i = cp[96 + n]; }
#pragma unroll
        for (int mt = 0; mt < 2; ++mt)
#pragma unroll
            for (int r = 0; r < 16; ++r) {
                const float n0r = fmaf(a0r, x0r, fmaf(-a0i, x0i, acc[mt][0][r])), n0i = fmaf(a0r, x0i, fmaf(a0i, x0r, acc[mt][2][r]));
                const float n1r = fmaf(a1r, x1r, fmaf(-a1i, x1i, acc[mt][1][r])), n1i = fmaf(a1r, x1i, fmaf(a1i, x1r, acc[mt][3][r]));
                x0r = n0r; x0i = n0i; x1r = n1r; x1i = n1i;
                acc[mt][0][r] = x0r; acc[mt][2][r] = x0i; acc[mt][1][r] = x1r; acc[mt][3][r] = x1i;
            }
        if (!FULL) { cp[n] = x0r; cp[64 + n] = x0i; cp[32 + n] = x1r; cp[96 + n] = x1i; continue; }
#pragma unroll
        for (int mt = 0; mt < 2; ++mt)
#pragma unroll
            for (int nt = 0; nt < 4; ++nt)
#pragma unroll
                for (int q = 0; q < 4; ++q) {
                    u32x2 pk; pk.x = cvt_pk_bf16(acc[mt][nt][4 * q + 0], acc[mt][nt][4 * q + 1]); pk.y = cvt_pk_bf16(acc[mt][nt][4 * q + 2], acc[mt][nt][4 * q + 3]);
                    *(LAS u32x2*)(xt + (nt * 32 + n) * S5_PITCH + (32 * h + 16 * mt + 4 * q) * 2) = pk;
                }
        const int ch = lane & 15, kg = lane >> 4;
        bf16x8 Cf[4];
#pragma unroll
        for (int ks = 0; ks < 4; ++ks) Cf[ks] = *(const bf16x8*)(cop + (size_t)((g * 16 + ch) * 128 + 32 * ks + 8 * kg));
        const int trb = (int)(uintptr_t)xt + (8 * kg + (ch >> 2)) * S5_PITCH + (4 * (ch & 3)) * 2;
        f32x4 y[4];
#pragma unroll
        for (int tb = 0; tb < 4; ++tb) y[tb] = (f32x4){0.f, 0.f, 0.f, 0.f};
        asm volatile("s_waitcnt lgkmcnt(0)" ::: "memory");
#define S5_TR(tb, ks, hi4) ds_tr_read<(32 * (ks) + 4 * (hi4)) * S5_PITCH + 32 * (tb)>(trb)
#define S5_STEP(tb, ks) do { const s16x4 lo = S5_TR(tb, ks, 0), hi = S5_TR(tb, ks, 1); asm volatile("s_waitcnt lgkmcnt(0)" ::: "memory"); __builtin_amdgcn_sched_barrier(0); \
            const bf16x8 bf = (bf16x8){lo[0], lo[1], lo[2], lo[3], hi[0], hi[1], hi[2], hi[3]}; y[tb] = __builtin_amdgcn_mfma_f32_16x16x32_bf16(Cf[ks], bf, y[tb], 0, 0, 0); } while (0)
        S5_STEP(0, 0); S5_STEP(0, 1); S5_STEP(0, 2); S5_STEP(0, 3);
        S5_STEP(1, 0); S5_STEP(1, 1); S5_STEP(1, 2); S5_STEP(1, 3);
        S5_STEP(2, 0); S5_STEP(2, 1); S5_STEP(2, 2); S5_STEP(2, 3);
        S5_STEP(3, 0); S5_STEP(3, 1); S5_STEP(3, 2); S5_STEP(3, 3);
#undef S5_STEP
#undef S5_TR
        const f32x4 dv = *(const f32x4*)(dsk + g * 16 + 4 * kg);
#pragma unroll
        for (int tb = 0; tb < 4; ++tb) {
            const size_t o = (size_t)(tok0 + 16 * tb + ch) * DM + g * 16 + 4 * kg;
            const u32x2 uu = *(const u32x2*)(U + o);
            const float y0 = y[tb][0] + dv[0] * bf_lo(uu.x), y1 = y[tb][1] + dv[1] * bf_hi(uu.x), y2 = y[tb][2] + dv[2] * bf_lo(uu.y), y3 = y[tb][3] + dv[3] * bf_hi(uu.y);
            const float z0 = gelu_tanh(y0), z1 = gelu_tanh(y1), z2 = gelu_tanh(y2), z3 = gelu_tanh(y3);
            u32x2 zz; zz.x = cvt_pk_bf16(z0, z1); zz.y = cvt_pk_bf16(z2, z3);
            *(u32x2*)(Z + o) = zz;
            *(unsigned*)(Z8 + o) = pack_fp8x4(z0, z1, z2, z3);
        }
    }
}

__device__ __forceinline__ void phase_s5_carry(const Frame& F) {
    const float* tab = (const float*)(F.ws + WS_S5A);
    float* carry = (float*)(F.ws + WS_CARRY);
    LAS float* E = (LAS float*)F.lds;
    for (int pair = F.c; pair < 128; pair += F.G) {
        const int b = pair >> 6, g = pair & 63, p = F.lane, w = F.wave;
        const float ar = tab[8192 + g * 64 + p], ai = tab[12288 + g * 64 + p];
        float* ptr = carry + ((size_t)(b * 256 + 32 * w) * 64 + g) * 128 + p;
        float cr[32], ci[32];
#pragma unroll
        for (int j = 0; j < 32; ++j) { cr[j] = ptr[(size_t)j * 8192]; ci[j] = ptr[(size_t)j * 8192 + 64]; }
        float xr = 0.f, xi = 0.f;
#pragma unroll
        for (int j = 0; j < 32; ++j) { const float nr = fmaf(ar, xr, fmaf(-ai, xi, cr[j])), ni = fmaf(ar, xi, fmaf(ai, xr, ci[j])); xr = nr; xi = ni; }
        E[(w * 2 + 0) * 64 + p] = xr; E[(w * 2 + 1) * 64 + p] = xi;
        float sr = ar, si = ai;
#pragma unroll
        for (int q = 0; q < 5; ++q) { const float nr = sr * sr - si * si, ni = 2.f * sr * si; sr = nr; si = ni; }
        __syncthreads();
        xr = 0.f; xi = 0.f;
        for (int v = 0; v < w; ++v) { const float er = E[(v * 2 + 0) * 64 + p], ei = E[(v * 2 + 1) * 64 + p];
            const float nr = fmaf(sr, xr, fmaf(-si, xi, er)), ni = fmaf(sr, xi, fmaf(si, xr, ei)); xr = nr; xi = ni; }
#pragma unroll
        for (int j = 0; j < 32; ++j) {
            ptr[(size_t)j * 8192] = xr; ptr[(size_t)j * 8192 + 64] = xi;
            const float nr = fmaf(ar, xr, fmaf(-ai, xi, cr[j])), ni = fmaf(ar, xi, fmaf(ai, xr, ci[j])); xr = nr; xi = ni;
        }
        __syncthreads();
    }
}

template <bool FINAL, class XT>
__device__ __forceinline__ void phase_moe_combine(const Frame& F, int layer, const XT* xold, const bf16_t* mres, bf16_t* xnew, const float* gamma_next, unsigned char* hnext, float* outp) {
    LAS int* ebase = (LAS int*)F.lds;
    const unsigned* gcnt = (const unsigned*)(F.ws + ZB_MOECNT + layer * 256);
    if (F.tid < 64) {
        const int nt = F.tid < 32 ? (((int)gcnt[F.tid] + 255) >> 8) : 0;
        int incl = nt;
#pragma unroll
        for (int o = 1; o < 32; o <<= 1) { const int y = __shfl_up(incl, o, 64); if (F.lane >= o) incl += y; }
        if (F.tid < 32) ebase[F.tid] = incl - nt;
    }
    __syncthreads();
    const int* pos = (const int*)(F.ws + WS_TOPK); const float* gates = (const float*)(F.ws + WS_TOPK + (size_t)T * 4 * 4);
    const unsigned char* yk = F.ws + WS_YK;
    const int lane = F.lane;
    for (int r0 = F.c * 8 + F.wave; r0 < T; r0 += F.G * 16) {
        const int r1 = (r0 + F.G * 8 < T) ? r0 + F.G * 8 : r0;
        u32x4 pp[2]; f32x4 gg[2];
        pp[0] = *(const u32x4*)(pos + (size_t)r0 * 4); pp[1] = *(const u32x4*)(pos + (size_t)r1 * 4);
        gg[0] = *(const f32x4*)(gates + (size_t)r0 * 4); gg[1] = *(const f32x4*)(gates + (size_t)r1 * 4);
        f32x4 xo[2][4]; u32x2 yv[2][4][2]; u32x4 mv[2][2];
#pragma unroll
        for (int q = 0; q < 2; ++q) { const int r = q ? r1 : r0;
#pragma unroll
            for (int i = 0; i < 2; ++i) { mv[q][i] = *(const u32x4*)(mres + (size_t)r * DM + 512 * i + 8 * lane);
#pragma unroll
                for (int h = 0; h < 2; ++h) xo[q][2 * i + h] = load_x4(xold + (size_t)r * DM + 512 * i + 8 * lane + 4 * h); }
#pragma unroll
            for (int k = 0; k < 4; ++k) { const int pk = (int)pp[q][k], e = pk >> 14, v = pk & 16383; const size_t phys = (size_t)ebase[e] * 256 + v;
#pragma unroll
                for (int i = 0; i < 2; ++i) yv[q][k][i] = *(const u32x2*)(yk + phys * 1024 + 512 * i + 8 * lane); } }
#pragma unroll
        for (int q = 0; q < 2; ++q) {
            const int r = q ? r1 : r0, b = r >> 13;
            const float* g2 = ada_vec(F, layer, b, 5);
            { const float* g1 = ada_vec(F, layer, b, 2);
#pragma unroll
              for (int i = 0; i < 2; ++i) { const f32x4 ga = *(const f32x4*)(g1 + 512 * i + 8 * lane), gb = *(const f32x4*)(g1 + 512 * i + 8 * lane + 4); const u32x4 m = mv[q][i];
                xo[q][2 * i][0] = fmaf(ga[0], bf_lo(m.x), xo[q][2 * i][0]); xo[q][2 * i][1] = fmaf(ga[1], bf_hi(m.x), xo[q][2 * i][1]);
                xo[q][2 * i][2] = fmaf(ga[2], bf_lo(m.y), xo[q][2 * i][2]); xo[q][2 * i][3] = fmaf(ga[3], bf_hi(m.y), xo[q][2 * i][3]);
                xo[q][2 * i + 1][0] = fmaf(gb[0], bf_lo(m.z), xo[q][2 * i + 1][0]); xo[q][2 * i + 1][1] = fmaf(gb[1], bf_hi(m.z), xo[q][2 * i + 1][1]);
                xo[q][2 * i + 1][2] = fmaf(gb[2], bf_lo(m.w), xo[q][2 * i + 1][2]); xo[q][2 * i + 1][3] = fmaf(gb[3], bf_hi(m.w), xo[q][2 * i + 1][3]); } }
            float acc[16];
#pragma unroll
            for (int j = 0; j < 16; ++j) acc[j] = 0.f;
#pragma unroll
            for (int k = 0; k < 4; ++k) { const float gk = gg[q][k] * (1.f / FP8_YSCALE);
#pragma unroll
                for (int i = 0; i < 2; ++i) { const u32x2 w = yv[q][k][i];
                    const f32x2 p0 = __builtin_amdgcn_cvt_pk_f32_fp8((int)w.x, false), p1 = __builtin_amdgcn_cvt_pk_f32_fp8((int)w.x, true);
                    const f32x2 p2 = __builtin_amdgcn_cvt_pk_f32_fp8((int)w.y, false), p3 = __builtin_amdgcn_cvt_pk_f32_fp8((int)w.y, true);
                    acc[8 * i + 0] = fmaf(gk, p0[0], acc[8 * i + 0]); acc[8 * i + 1] = fmaf(gk, p0[1], acc[8 * i + 1]);
                    acc[8 * i + 2] = fmaf(gk, p1[0], acc[8 * i + 2]); acc[8 * i + 3] = fmaf(gk, p1[1], acc[8 * i + 3]);
                    acc[8 * i + 4] = fmaf(gk, p2[0], acc[8 * i + 4]); acc[8 * i + 5] = fmaf(gk, p2[1], acc[8 * i + 5]);
                    acc[8 * i + 6] = fmaf(gk, p3[0], acc[8 * i + 6]); acc[8 * i + 7] = fmaf(gk, p3[1], acc[8 * i + 7]); } }
            float xn[16]; float ss = 0.f;
#pragma unroll
            for (int i = 0; i < 2; ++i)
#pragma unroll
                for (int h = 0; h < 2; ++h) { const int col = 512 * i + 8 * lane + 4 * h;
                    const f32x4 gv = *(const f32x4*)(g2 + col);
                    f32x4 xv;
#pragma unroll
                    for (int j = 0; j < 4; ++j) { xv[j] = xo[q][2 * i + h][j] + gv[j] * acc[8 * i + 4 * h + j]; xn[8 * i + 4 * h + j] = xv[j]; ss += xv[j] * xv[j]; }
                    if (!FINAL) { u32x2 xw; xw.x = cvt_pk_bf16(xv[0], xv[1]); xw.y = cvt_pk_bf16(xv[2], xv[3]); *(u32x2*)(xnew + (size_t)r * DM + col) = xw; } }
            ss = wave_sum(ss);
            const float rs = rsqrtf(ss * (1.f / 1024.f) + 1e-6f);
            if (FINAL) {
#pragma unroll
                for (int i = 0; i < 2; ++i)
#pragma unroll
                    for (int h = 0; h < 2; ++h) { const int col = 512 * i + 8 * lane + 4 * h; const f32x4 g = *(const f32x4*)(gamma_next + col);
                        f32x4 o;
#pragma unroll
                        for (int j = 0; j < 4; ++j) o[j] = xn[8 * i + 4 * h + j] * rs * g[j];
                        *(f32x4*)(outp + (size_t)r * DM + col) = o; }
            } else {
                const float* sh = ada_vec(F, layer + 1, b, 0); const float* sc = ada_vec(F, layer + 1, b, 1);
#pragma unroll
                for (int i = 0; i < 2; ++i) { const int col = 512 * i + 8 * lane;
                    float yv8[8];
#pragma unroll
                    for (int h = 0; h < 2; ++h) { const f32x4 g = *(const f32x4*)(gamma_next + col + 4 * h), s1 = *(const f32x4*)(sc + col + 4 * h), s0 = *(const f32x4*)(sh + col + 4 * h);
#pragma unroll
                        for (int j = 0; j < 4; ++j) yv8[4 * h + j] = xn[8 * i + 4 * h + j] * rs * g[j] * (1.f + s1[j]) + s0[j]; }
                    u32x2 w; w.x = pack_fp8x4(yv8[0], yv8[1], yv8[2], yv8[3]); w.y = pack_fp8x4(yv8[4], yv8[5], yv8[6], yv8[7]);
                    *(u32x2*)(hnext + (size_t)r * DM + col) = w; }
            }
        }
    }
    __syncthreads();
}

__device__ __forceinline__ void phase_kmean(const Frame& F, const bf16_t* __restrict__ K) {
    LAS float* red = (LAS float*)F.lds;
    float* km = (float*)(F.ws + WS_KMEAN);
    for (int u = F.c; u < 512; u += F.G) {
        const int h = u & 7, n = (u >> 3) & 31, b = u >> 8;
        const int colc = F.tid & 15, rg = F.tid >> 4;
        const bf16_t* base = K + ((size_t)(b * SEQ + n * 256 + rg * 8)) * DM + h * 128 + colc * 8;
        float acc[8];
#pragma unroll
        for (int j = 0; j < 8; ++j) acc[j] = 0.f;
#pragma unroll
        for (int r = 0; r < 8; ++r) { const u32x4 w = *(const u32x4*)(base + (size_t)r * DM);
            acc[0] += bf_lo(w.x); acc[1] += bf_hi(w.x); acc[2] += bf_lo(w.y); acc[3] += bf_hi(w.y); acc[4] += bf_lo(w.z); acc[5] += bf_hi(w.z); acc[6] += bf_lo(w.w); acc[7] += bf_hi(w.w); }
#pragma unroll
        for (int j = 0; j < 8; ++j) red[rg * 128 + colc * 8 + j] = acc[j];
        __syncthreads();
        if (F.tid < 128) { float s = 0.f;
#pragma unroll
            for (int q = 0; q < 32; ++q) s += red[q * 128 + F.tid];
            km[((size_t)(b * 8 + h) * 32 + n) * 128 + F.tid] = s * (1.f / 256.f); }
        __syncthreads();
    }
}

__device__ __forceinline__ int alist_base(int n) { return 256 * (31 * n - (n * (n - 1)) / 2); }

__device__ __forceinline__ void phase_gating(const Frame& F, const bf16_t* __restrict__ Q) {
    LAS float* kml = (LAS float*)F.lds;
    LAS int* cntl = (LAS int*)(F.lds + 16384); LAS int* basel = cntl + 32; LAS int* entl = cntl + 64;
    const float* km = (const float*)(F.ws + WS_KMEAN);
    unsigned* gcnt = (unsigned*)(F.ws + ZB_ATTCNT);
    int* alist = (int*)(F.ws + WS_ALIST);
    for (int u = F.c; u < 256; u += F.G) {
        const int jp = u & 15, h = (u >> 4) & 7, b = u >> 7, bh = b * 8 + h;
        for (int i = F.tid; i < 4096; i += NTHREADS) kml[i] = km[(size_t)bh * 4096 + i];
        if (F.tid < 32) cntl[F.tid] = 0;
        __syncthreads();
        const int s = jp * 512 + F.tid, j = __builtin_amdgcn_readfirstlane(s >> 8);
        u32x4 q[16];
        { const bf16_t* qp = Q + (size_t)(b * SEQ + s) * DM + h * 128;
#pragma unroll
          for (int i = 0; i < 16; ++i) q[i] = *(const u32x4*)(qp + 8 * i); }
        float v0 = -INFINITY, v1 = -INFINITY, v2 = -INFINITY; int i0 = 0, i1 = 0, i2 = 0;
#pragma unroll 1
        for (int n = 0; n < j; ++n) {
            float d = 0.f;
#pragma unroll
            for (int i = 0; i < 16; ++i) { const f32x4 ka = *(const LAS f32x4*)(kml + n * 128 + 8 * i), kb = *(const LAS f32x4*)(kml + n * 128 + 8 * i + 4);
                d = fmaf(bf_lo(q[i].x), ka[0], d); d = fmaf(bf_hi(q[i].x), ka[1], d); d = fmaf(bf_lo(q[i].y), ka[2], d); d = fmaf(bf_hi(q[i].y), ka[3], d);
                d = fmaf(bf_lo(q[i].z), kb[0], d); d = fmaf(bf_hi(q[i].z), kb[1], d); d = fmaf(bf_lo(q[i].w), kb[2], d); d = fmaf(bf_hi(q[i].w), kb[3], d); }
            if (d > v0) { v2 = v1; i2 = i1; v1 = v0; i1 = i0; v0 = d; i0 = n; }
            else if (d > v1) { v2 = v1; i2 = i1; v1 = d; i1 = n; }
            else if (d > v2) { v2 = d; i2 = n; }
        }
        const int nsel = j < 3 ? j : 3;
        if (nsel > 0) entl[F.tid * 3 + 0] = (i0 << 16) | __hip_atomic_fetch_add(&cntl[i0], 1, __ATOMIC_RELAXED, __HIP_MEMORY_SCOPE_WORKGROUP);
        if (nsel > 1) entl[F.tid * 3 + 1] = (i1 << 16) | __hip_atomic_fetch_add(&cntl[i1], 1, __ATOMIC_RELAXED, __HIP_MEMORY_SCOPE_WORKGROUP);
        if (nsel > 2) entl[F.tid * 3 + 2] = (i2 << 16) | __hip_atomic_fetch_add(&cntl[i2], 1, __ATOMIC_RELAXED, __HIP_MEMORY_SCOPE_WORKGROUP);
        __syncthreads();
        if (F.tid < 32) basel[F.tid] = cntl[F.tid] ? (int)atomicAdd(&gcnt[bh * 32 + F.tid], (unsigned)cntl[F.tid]) : 0;
        __syncthreads();
#pragma unroll
        for (int k = 0; k < 3; ++k) if (k < nsel) { const int en = entl[F.tid * 3 + k], n = en >> 16, v = basel[n] + (en & 0xffff);
            alist[(size_t)bh * ALIST_PER_BH + alist_base(n) + v] = s | (k << 16); }
        __syncthreads();
    }
}

namespace at {
constexpr int D = 128, NW = 8, QBLK = 32, KVBLK = 64, LDK = 1024, NT = 4;
constexpr float SCALE = 0.088388347648318440f, THR = 8.f, CL2 = SCALE * 1.4426950408889634f;
constexpr int SHM_V = KVBLK * D * 2, SHM_K = KVBLK * D * 2, SHM_WS = NW * 8704  , SHM_ATTN = SHM_WS + NW * 96 * 4;
constexpr int LDS_PRE = 73728;
#define KSWZ(row, colB) ((row) * 256 + ((colB) ^ (((row) & 7) << 4)))
#define SBAR() __builtin_amdgcn_sched_barrier(0)
__device__ __forceinline__ int crow(int r, int hi) { return (r & 3) + 8 * (r >> 2) + 4 * hi; }
__device__ __forceinline__ void partialSM(f32x16& p0, f32x16& p1, float& m_reg, float& mn, float& alpha) {
    float pmax = p0[0];
#pragma unroll
    for (int r = 1; r < 16; ++r) pmax = fmaxf(pmax, p0[r]);
#pragma unroll
    for (int r = 0; r < 16; ++r) pmax = fmaxf(pmax, p1[r]);
    { auto rr = __builtin_amdgcn_permlane32_swap(__float_as_uint(pmax), __float_as_uint(pmax), false, false);
      pmax = fmaxf(__uint_as_float(rr[0]), __uint_as_float(rr[1])); }
    if (__builtin_expect(__all(pmax - m_reg <= THR / SCALE), 1)) { mn = m_reg; alpha = 1.f; }
    else { mn = fmaxf(m_reg, pmax); alpha = __builtin_amdgcn_exp2f((m_reg - mn) * CL2); m_reg = mn; }
    const float mnC = -mn * CL2;
#pragma unroll
    for (int r = 0; r < 16; ++r) p0[r] = fmaf(p0[r], CL2, mnC);
#pragma unroll
    for (int r = 0; r < 16; ++r) p1[r] = fmaf(p1[r], CL2, mnC);
#pragma unroll
    for (int r = 0; r < 16; ++r) p0[r] = __builtin_amdgcn_exp2f(p0[r]);
}
__device__ __forceinline__ void finishSM(f32x16& p0, f32x16& p1, float alpha, float& l_reg, bf16x8& pa0, bf16x8& pa1, bf16x8& pa2, bf16x8& pa3) {
#pragma unroll
    for (int r = 0; r < 16; ++r) p1[r] = __builtin_amdgcn_exp2f(p1[r]);
    float ps = 0;
#pragma unroll
    for (int r = 0; r < 16; ++r) ps += p0[r];
#pragma unroll
    for (int r = 0; r < 16; ++r) ps += p1[r];
    { auto rr = __builtin_amdgcn_permlane32_swap(__float_as_uint(ps), __float_as_uint(ps), false, false);
      ps = __uint_as_float(rr[0]) + __uint_as_float(rr[1]); }
    l_reg = l_reg * alpha + ps;
#define PK4(P, BASE, OUT) do { unsigned a0 = cvt_pk_bf16(P[BASE + 0], P[BASE + 1]), a1 = cvt_pk_bf16(P[BASE + 2], P[BASE + 3]);   \
    unsigned b0 = cvt_pk_bf16(P[BASE + 4], P[BASE + 5]), b1 = cvt_pk_bf16(P[BASE + 6], P[BASE + 7]);                              \
    auto r0 = __builtin_amdgcn_permlane32_swap(a0, b0, false, false); auto r1 = __builtin_amdgcn_permlane32_swap(a1, b1, false, false); \
    u32x4 w = {r0[0], r1[0], r0[1], r1[1]}; OUT = *reinterpret_cast<bf16x8*>(&w); } while (0)
    PK4(p0, 0, pa0); PK4(p0, 8, pa1); PK4(p1, 0, pa2); PK4(p1, 8, pa3);
#undef PK4
}
__device__ __forceinline__ void qkt(f32x16& p0, f32x16& p1, const char* Ks, const bf16x8* qr, int r32, int hi) {
    p0 = f32x16{}; p1 = f32x16{};
#pragma unroll
    for (int d0 = 0; d0 < 8; ++d0) { const int cb = (d0 * 16 + hi * 8) * 2;
        const bf16x8 b0 = *reinterpret_cast<const bf16x8*>(Ks + KSWZ(r32, cb));
        const bf16x8 b1 = *reinterpret_cast<const bf16x8*>(Ks + KSWZ(32 + r32, cb));
        p0 = __builtin_amdgcn_mfma_f32_32x32x16_bf16(b0, qr[d0], p0, 0, 0, 0);
        p1 = __builtin_amdgcn_mfma_f32_32x32x16_bf16(b1, qr[d0], p1, 0, 0, 0); }
}
__device__ __forceinline__ void causal_mask(f32x16& p0, f32x16& p1, int kt, int qrow, int hi) {
#pragma unroll
    for (int r = 0; r < 16; ++r) { const int key = kt * 64 + crow(r, hi); if (key > qrow) p0[r] = -1e30f; if (key + 32 > qrow) p1[r] = -1e30f; }
}
__device__ __forceinline__ int v_st(int k, int c) { const int kk = (k & ~0xC) | ((k & 4) << 1) | ((k & 8) >> 1); return ((kk >> 3) * 4 + (c >> 5)) * 512 + ((kk & 7) * 32 + (c & 31)) * 2; }
__device__ __forceinline__ int v_rd_base(int lane) { return ((lane & 3) << 3) | (((lane >> 2) & 3) << 6) | (((lane >> 4) & 1) << 5) | (((lane >> 5) & 1) << 8); }
constexpr int v_rd_off(int d0, int ks, int half) { return d0 * 512 + ks * 4096 + half * 2048; }
template <int D0> __device__ __forceinline__ void pv_one(f32x16& od, int vb, bf16x8 pa0, bf16x8 pa1, bf16x8 pa2, bf16x8 pa3) {
    const s16x4 l0 = ds_tr_read<v_rd_off(D0, 0, 0)>(vb), h0 = ds_tr_read<v_rd_off(D0, 0, 1)>(vb), l1 = ds_tr_read<v_rd_off(D0, 1, 0)>(vb), h1 = ds_tr_read<v_rd_off(D0, 1, 1)>(vb);
    const s16x4 l2 = ds_tr_read<v_rd_off(D0, 2, 0)>(vb), h2 = ds_tr_read<v_rd_off(D0, 2, 1)>(vb), l3 = ds_tr_read<v_rd_off(D0, 3, 0)>(vb), h3 = ds_tr_read<v_rd_off(D0, 3, 1)>(vb);
    asm volatile("s_waitcnt lgkmcnt(0)" ::: "memory"); SBAR();
#define PK(L, H) (bf16x8){L[0], L[1], L[2], L[3], H[0], H[1], H[2], H[3]}
    od = __builtin_amdgcn_mfma_f32_32x32x16_bf16(pa0, PK(l0, h0), od, 0, 0, 0);
    od = __builtin_amdgcn_mfma_f32_32x32x16_bf16(pa1, PK(l1, h1), od, 0, 0, 0);
    od = __builtin_amdgcn_mfma_f32_32x32x16_bf16(pa2, PK(l2, h2), od, 0, 0, 0);
    od = __builtin_amdgcn_mfma_f32_32x32x16_bf16(pa3, PK(l3, h3), od, 0, 0, 0);
#undef PK
}
__device__ __forceinline__ void pv_d0(f32x16* o, int vb, bf16x8 pa0, bf16x8 pa1, bf16x8 pa2, bf16x8 pa3) {
    pv_one<0>(o[0], vb, pa0, pa1, pa2, pa3); pv_one<1>(o[1], vb, pa0, pa1, pa2, pa3); pv_one<2>(o[2], vb, pa0, pa1, pa2, pa3); pv_one<3>(o[3], vb, pa0, pa1, pa2, pa3);
}

struct AUnit { unsigned qoff; unsigned kv; int dst; bool causal; };
__device__ __forceinline__ bool attn_decode(int u, int total, const bf16_t* Q, const int* alist, const LAS int* pre, const LAS int* cntl, int wid, int r32, AUnit& D) {
    if (u >= total) return false;
    int bh, n;
    if (u < 512) {
        bh = u >> 5; n = u & 31; D.causal = true;
        const int b = bh >> 3, h = bh & 7, s = n * 256 + wid * 32 + r32; const size_t t = (size_t)b * SEQ + s;
        D.qoff = (unsigned)(t * DM + h * 128); D.dst = (int)((t * 8 + h) * 4 + 3);
    } else {
        const int ut = u - 512; int lo = 0, hi_ = 511;
        while (lo < hi_) { const int mid = (lo + hi_ + 1) >> 1; if (pre[mid] <= ut) lo = mid; else hi_ = mid - 1; }
        bh = lo >> 5; n = lo & 31; D.causal = false;
        const int tile = ut - pre[lo], cntv = cntl[lo], idx = tile * 256 + wid * 32 + r32;
        const int b = bh >> 3, h = bh & 7;
        const int en = alist[(size_t)bh * ALIST_PER_BH + alist_base(n) + (idx < cntv ? idx : cntv - 1)];
        const int s = en & 0xffff, k = en >> 16; const size_t t = (size_t)b * SEQ + s;
        D.qoff = (unsigned)(t * DM + h * 128); D.dst = idx < cntv ? (int)((t * 8 + h) * 4 + k) : -1;
    }
    D.kv = (unsigned)(((size_t)(bh >> 3) * SEQ + n * 256) * DM + (bh & 7) * 128);
    return true;
}

__device__ __forceinline__ void attn_stream(const bf16_t* __restrict__ Q, const bf16_t* __restrict__ K, const bf16_t* __restrict__ V, const int* __restrict__ alist,
                                            const LAS int* pre, const LAS int* cntl, int total, int c, int G,
                                            unsigned char* __restrict__ part, float* __restrict__ lse, char* lds) {
    const int tid = threadIdx.x, wid = tid >> 6, lane = tid & 63, r32 = lane & 31, hi = lane >> 5;
    char* V_lds = lds; char* K_lds = lds + 2 * SHM_V;
    float* wsl = (float*)(lds + SHM_WS) + wid * 96; float* li_l = wsl; float* al_l = wsl + 32; int* dst_l = (int*)(wsl + 64);
#define TZ() ({ int _t = threadIdx.x; asm volatile("" : "+v"(_t)); _t; })
#define qrow_i ((TZ() >> 6) * 32 + (TZ() & 31))
#define vb0 ((int)(uintptr_t)V_lds + v_rd_base(TZ() & 63))
    struct { bf16x8 vs0, vs1, ks0, ks1; } sr_[2];
#define SLOAD(i, KP, VP, k0) do { const int _tz = TZ(), sr = _tz >> 4, sc = (_tz & 15) * 8; sr_[i].vs0 = *(const bf16x8*)(&(VP)[(long)((k0) + sr) * LDK + sc]); sr_[i].vs1 = *(const bf16x8*)(&(VP)[(long)((k0) + 32 + sr) * LDK + sc]); \
    sr_[i].ks0 = *(const bf16x8*)(&(KP)[(long)((k0) + sr) * LDK + sc]); sr_[i].ks1 = *(const bf16x8*)(&(KP)[(long)((k0) + 32 + sr) * LDK + sc]); } while (0)
#define SWRITE(b, i) do { const int _tz = TZ(), sr = _tz >> 4, sc = (_tz & 15) * 8, vst0 = v_st(sr, sc), vst1 = v_st(32 + sr, sc); *(bf16x8*)(V_lds + (b) * SHM_V + vst0) = sr_[i].vs0;          \
    *(bf16x8*)(V_lds + (b) * SHM_V + vst1) = sr_[i].vs1; const int kc = sc * 2;          \
    *(bf16x8*)(K_lds + (b) * SHM_K + KSWZ(sr, kc)) = sr_[i].ks0;                          \
    *(bf16x8*)(K_lds + (b) * SHM_K + KSWZ(32 + sr, kc)) = sr_[i].ks1; } while (0)
#define SWAIT() asm volatile("s_waitcnt vmcnt(4)" ::: "memory")
#define RESC(a) do { if (__any((a) < 1.f)) { if (hi == 0) al_l[r32] = (a); asm volatile("s_waitcnt lgkmcnt(0)" ::: "memory"); \
    _Pragma("unroll") for (int d = 0; d < 4; ++d) _Pragma("unroll") for (int r = 0; r < 16; ++r) o[d][r] *= al_l[crow(r, hi)]; } } while (0)
    AUnit cur, nxt;
    int u = c;
    if (!attn_decode(u, total, Q, alist, pre, cntl, wid, r32, cur)) return;
#define stash ((int*)(lds + 81920) + TZ() * 2)
    stash[0] = (int)cur.qoff; stash[1] = cur.dst;
    unsigned ckv = __builtin_amdgcn_readfirstlane(cur.kv); bool ccausal = cur.causal;
    SLOAD(0, K + ckv, V + ckv, 0);
    for (;;) {
        bf16x8 qr[8];
        { const bf16_t* Qw = Q + (unsigned)stash[0] + hi * 8;
#pragma unroll
          for (int d0 = 0; d0 < 8; ++d0) qr[d0] = *reinterpret_cast<const bf16x8*>(Qw + d0 * 16); }
        u += G;
        const bool has_next = attn_decode(u, total, Q, alist, pre, cntl, wid, r32, nxt);
        const int dst0 = stash[1];
        if (hi == 0) dst_l[r32] = dst0;
        asm volatile("s_waitcnt lgkmcnt(0)" ::: "memory");
        if (has_next) { stash[0] = (int)nxt.qoff; stash[1] = nxt.dst; }
        const unsigned nkv = __builtin_amdgcn_readfirstlane(nxt.kv); const bool ncausal = nxt.causal;
        const bf16_t* Kh = K + ckv; const bf16_t* Vh = V + ckv; const bool causal = ccausal;
        float m_reg = -1e30f, l_reg = 0; f32x16 o[4] = {};
        f32x16 pA0, pA1, pB0, pB1; float mnA, mnB, alA, alB; bf16x8 pa0, pa1, pa2, pa3;
        asm volatile("s_waitcnt vmcnt(0)" ::: "memory"); SWRITE(0, 0); __syncthreads();
        qkt(pA0, pA1, K_lds, qr, r32, hi); if (causal) causal_mask(pA0, pA1, 0, qrow_i, hi); partialSM(pA0, pA1, m_reg, mnA, alA);
        SLOAD(1, Kh, Vh, KVBLK); SLOAD(0, Kh, Vh, 2 * KVBLK);
        SWAIT(); SWRITE(1, 1); __syncthreads();
        {
            SBAR(); qkt(pB0, pB1, K_lds + SHM_K, qr, r32, hi); if (causal) causal_mask(pB0, pB1, 1, qrow_i, hi);
            finishSM(pA0, pA1, alA, l_reg, pa0, pa1, pa2, pa3); SBAR();
            SLOAD(1, Kh, Vh, 3 * KVBLK); SBAR();
            pv_d0(o, vb0, pa0, pa1, pa2, pa3); partialSM(pB0, pB1, m_reg, mnB, alB);
            __syncthreads(); SWAIT(); SWRITE(0, 0);
            RESC(alB); __syncthreads();
            SBAR(); qkt(pA0, pA1, K_lds, qr, r32, hi); if (causal) causal_mask(pA0, pA1, 2, qrow_i, hi);
            finishSM(pB0, pB1, alB, l_reg, pa0, pa1, pa2, pa3); SBAR();
            pv_d0(o, vb0 + SHM_V, pa0, pa1, pa2, pa3); partialSM(pA0, pA1, m_reg, mnA, alA);
            __syncthreads(); asm volatile("s_waitcnt vmcnt(0)" ::: "memory"); SWRITE(1, 1);
            RESC(alA); __syncthreads();
        }
        SBAR(); qkt(pB0, pB1, K_lds + SHM_K, qr, r32, hi); if (causal) causal_mask(pB0, pB1, 3, qrow_i, hi);
        finishSM(pA0, pA1, alA, l_reg, pa0, pa1, pa2, pa3); SBAR();
        pv_d0(o, vb0, pa0, pa1, pa2, pa3); partialSM(pB0, pB1, m_reg, mnB, alB);
        __syncthreads(); RESC(alB);
        finishSM(pB0, pB1, alB, l_reg, pa0, pa1, pa2, pa3); SBAR();
        pv_d0(o, vb0 + SHM_V, pa0, pa1, pa2, pa3);
        SBAR();
        if (has_next) {
            SLOAD(0, K + nkv, V + nkv, 0);
        }
        SBAR();
        if (hi == 0) li_l[r32] = l_reg; asm volatile("s_waitcnt lgkmcnt(0)" ::: "memory");
        { const int dst = dst_l[r32]; if (hi == 0 && dst >= 0) lse[dst] = m_reg * CL2 + __builtin_amdgcn_logf(l_reg); }
        __syncthreads();
        char* ost = lds + wid * 8704;
#pragma unroll
        for (int r = 0; r < 16; ++r) { const int orow = crow(r, hi); const float rl = __builtin_amdgcn_rcpf(li_l[orow]);
#pragma unroll
            for (int d0 = 0; d0 < 4; ++d0) *(bf16_t*)(ost + orow * 272 + (d0 * 32 + r32) * 2) = f2bf(o[d0][r] * rl); }
#pragma unroll
        for (int j = 0; j < 8; ++j) { const int cidx = lane + 64 * j, row = cidx >> 4, ch = cidx & 15; const int dd = dst_l[row];
            const u32x4 w = *(const u32x4*)(ost + row * 272 + ch * 16);
            u32x2 f; f.x = pack_fp8x4(bf_lo(w.x) * FP8_OSCALE, bf_hi(w.x) * FP8_OSCALE, bf_lo(w.y) * FP8_OSCALE, bf_hi(w.y) * FP8_OSCALE);
            f.y = pack_fp8x4(bf_lo(w.z) * FP8_OSCALE, bf_hi(w.z) * FP8_OSCALE, bf_lo(w.w) * FP8_OSCALE, bf_hi(w.w) * FP8_OSCALE);
            if (dd >= 0) *(u32x2*)(part + (size_t)dd * 128 + ch * 8) = f; }
        __syncthreads();
        if (!has_next) break;
        ckv = nkv; ccausal = ncausal;
    }
#undef SLOAD
#undef stash
#undef TZ
#undef qrow_i
#undef vb0
#undef SWRITE
#undef SWAIT
#undef RESC
}
#undef KSWZ
#undef SBAR
}

__device__ __forceinline__ void phase_attn(const Frame& F, const bf16_t* Q, const bf16_t* K, const bf16_t* V, unsigned char* part, float* lse, int wi, int wn) {
    LAS int* pre = (LAS int*)(F.lds + at::LDS_PRE);
    LAS int* wtot = pre + 520; LAS int* cntl = pre + 536;
    const unsigned* gcnt = (const unsigned*)(F.ws + ZB_ATTCNT);
    const int* alist = (const int*)(F.ws + WS_ALIST);
    {
        const int cntv = (int)gcnt[F.tid]; const int v = (cntv + 255) >> 8;
        cntl[F.tid] = cntv;
        int incl = v;
#pragma unroll
        for (int o = 1; o < 64; o <<= 1) { const int y = __shfl_up(incl, o, 64); if (F.lane >= o) incl += y; }
        if (F.lane == 63) wtot[F.wave] = incl;
        __syncthreads();
        int off = 0;
        for (int w = 0; w < F.wave; ++w) off += wtot[w];
        pre[F.tid + 1] = off + incl; if (F.tid == 0) pre[0] = 0;
        __syncthreads();
    }
    const int total = 512 + pre[512];
    at::attn_stream(Q, K, V, alist, pre, cntl, total, wi, wn, part, lse, (char*)F.lds);
}

__device__ __forceinline__ void phase_attn_combine(const Frame& F, const unsigned char* part, const float* lse, unsigned char* O) {
    for (size_t idx = (size_t)F.c * NTHREADS + F.tid; idx < (size_t)T * 128; idx += (size_t)F.G * NTHREADS) {
        const int dc = (int)(idx & 15), h = (int)((idx >> 4) & 7); const size_t t = idx >> 7;
        const int s = (int)(t & (SEQ - 1)), j = s >> 8, nsel = j < 3 ? j : 3;
        const size_t base = (t * 8 + h) * 4;
        const f32x4 l4 = *(const f32x4*)(lse + base);
        float lk[4]; lk[0] = nsel > 0 ? l4[0] : -INFINITY; lk[1] = nsel > 1 ? l4[1] : -INFINITY; lk[2] = nsel > 2 ? l4[2] : -INFINITY; lk[3] = l4[3];
        const float mx = fmaxf(fmaxf(lk[0], lk[1]), fmaxf(lk[2], lk[3]));
        float acc[8] = {0.f, 0.f, 0.f, 0.f, 0.f, 0.f, 0.f, 0.f}; float wsum = 0.f;
#pragma unroll
        for (int k = 0; k < 4; ++k) if (k == 3 || k < nsel) {
            const float w = __builtin_amdgcn_exp2f(lk[k] - mx); wsum += w;
            const u32x2 p = *(const u32x2*)(part + (base + k) * 128 + dc * 8);
            const f32x2 p0 = __builtin_amdgcn_cvt_pk_f32_fp8((int)p.x, false), p1 = __builtin_amdgcn_cvt_pk_f32_fp8((int)p.x, true);
            const f32x2 p2 = __builtin_amdgcn_cvt_pk_f32_fp8((int)p.y, false), p3 = __builtin_amdgcn_cvt_pk_f32_fp8((int)p.y, true);
            acc[0] = fmaf(w, p0[0], acc[0]); acc[1] = fmaf(w, p0[1], acc[1]); acc[2] = fmaf(w, p1[0], acc[2]); acc[3] = fmaf(w, p1[1], acc[3]);
            acc[4] = fmaf(w, p2[0], acc[4]); acc[5] = fmaf(w, p2[1], acc[5]); acc[6] = fmaf(w, p3[0], acc[6]); acc[7] = fmaf(w, p3[1], acc[7]); }
        const float inv = 1.f / wsum;
        u32x2 w; w.x = pack_fp8x4(acc[0] * inv, acc[1] * inv, acc[2] * inv, acc[3] * inv); w.y = pack_fp8x4(acc[4] * inv, acc[5] * inv, acc[6] * inv, acc[7] * inv);
        *(u32x2*)(O + t * DM + h * 128 + dc * 8) = w;
    }
}

constexpr int N_PHASES = 22;
__global__ void __launch_bounds__(NTHREADS, 2) mk_fwd(Args a) {
    extern __shared__ __attribute__((aligned(16))) unsigned char lds_raw[];
    Frame F; F.lds = (LAS unsigned char*)lds_raw; F.tid = threadIdx.x; F.lane = F.tid & 63; F.wave = __builtin_amdgcn_readfirstlane(F.tid >> 6);
    F.G = gridDim.x; F.c = blockIdx.x; F.in = a.in; F.out = a.out; F.ws = a.ws;
    const int lo = a.ph_lo, hi = a.ph_hi;
    if (F.tid == 0) *(LAS u32x4*)(F.lds + LDS_BARW) = (u32x4){0u, 0u, 0u, 0u};
    __syncthreads();
    XcdBarrier bar; bar.bar = (unsigned*)(F.ws + ZB_BAR); bar.x = 0; bar.st = (volatile LAS unsigned*)(F.lds + LDS_BARW);
    if (hi - lo > 1) bar = xcd_barrier_post((unsigned*)(F.ws + ZB_BAR), (volatile LAS unsigned*)(F.lds + LDS_BARW));
#ifndef MK_ONLY
#define MK_ONLY -1
#endif
#define IN(k) ((MK_ONLY < 0 || MK_ONLY == (k)) && lo <= (k) && (k) < hi)
#define SEAM(k) do { if ((k) + 1 < hi) xcd_barrier(bar); { int _t = threadIdx.x; asm volatile("" : "+v"(_t)); F.tid = _t; F.lane = _t & 63; } } while (0)
#define PHASE_WS() unsigned char* ws; { unsigned long long w_ = (unsigned long long)a.ws; asm volatile("" : "+s"(w_)); ws = (unsigned char*)w_; F.ws = ws; } \
    bf16_t* actA = (bf16_t*)(ws + WS_ACTA); bf16_t* actB = (bf16_t*)(ws + WS_ACTB); bf16_t* actC = (bf16_t*)(ws + WS_ACTC); bf16_t* actD = (bf16_t*)(ws + WS_ACTD); \
    bf16_t* XB = (bf16_t*)(ws + WS_XB); bf16_t* actg = (bf16_t*)(ws + WS_ACTG); bf16_t* yk = (bf16_t*)(ws + WS_YK); \
    (void)actA; (void)actB; (void)actC; (void)actD; (void)XB; (void)actg; (void)yk;
    if (IN(0)) { PHASE_WS(); phase_prologue(F); SEAM(0); }
    if (IN(1)) { PHASE_WS(); phase_norm_mod(F, F.in[IN_X], F.in[L0_NORM1], 0, 0, actA); SEAM(1); }
    if (IN(2)) { PHASE_WS(); pg::Dense<pg::EpiBf16> S{actA, (const bf16_t*)(ws + WS_WIN), T / 256, 4, F.G, F.c, pg::EpiBf16{actB, 1.f}}; pg::gemm_phase(F.lds, S); SEAM(2); }
    if (IN(3)) { PHASE_WS(); phase_s5<false>(F, actB, actA, nullptr); SEAM(3); }
    if (IN(4)) { PHASE_WS(); phase_s5_carry(F); SEAM(4); }
    if (IN(5)) { PHASE_WS(); phase_s5<true>(F, actB, actA, (unsigned char*)actC); SEAM(5); }
    if (IN(6)) { PHASE_WS(); pg::Dense<pg::EpiGlu, true> S{actC, ws + WS_WGLU, T / 256, 4, F.G, F.c, pg::EpiGlu{actA, actB, 1.f / FP8_WSCALE}}; pg::gemm_phase(F.lds, S); SEAM(6); }
    if (IN(7)) { PHASE_WS(); pg::Dense<pg::EpiBf16> S{actB, (const bf16_t*)(ws + WS_WOUT), T / 256, 4, F.G, F.c, pg::EpiBf16{actC, 1.f}}; pg::gemm_phase(F.lds, S); SEAM(7); }
    if (IN(8)) { PHASE_WS(); phase_norm_router(F, F.in[IN_X], actC, F.in[L0_NORM2], 0, (unsigned char*)actA); SEAM(8); }
    const bool has_cv = (F.G == 256); const bool is_cv = has_cv && (F.c >> 3) >= 28; const int cvi = ((F.c >> 3) - 28) * 8 + (F.c & 7);
    const pg::MoeGeo geo0 = pg::moe_geo(F.G, F.c, has_cv ? 28 : 32), geo1 = pg::moe_geo(F.G, F.c, 32);
    if (IN(9)) { PHASE_WS(); if (is_cv) moe_conv_stream(F, CONV_L0DN_BEG, CONV_L1GU_BEG, cvi, 32);
        else { pg::MoeTabs M = pg::moe_setup<8>(F, 0, true, geo0);
            pg::MoeGateUp S{(const unsigned char*)actA, ws + WS_WGU0, F.in[L0_BGU], (unsigned char*)actg, M, geo0}; pg::gemm_phase(F.lds, S); }
        SEAM(9); }
    if (IN(10)) { PHASE_WS(); if (is_cv) moe_conv_stream(F, CONV_P10_BEG, CONV_P15_BEG, cvi, 32);
        else { pg::MoeTabs M = pg::moe_tabs_reuse(F);
            pg::MoeDown S{(const unsigned char*)actg, ws + WS_WDN0, F.in[L0_BDN], (unsigned char*)yk, M, geo0}; pg::gemm_phase(F.lds, S); }
        SEAM(10); }
    if (IN(11)) { PHASE_WS(); phase_moe_combine<false, float>(F, 0, F.in[IN_X], actC, XB, F.in[L1_NORM1], (unsigned char*)actA, nullptr); SEAM(11); }
    if (IN(12)) { PHASE_WS(); pg::Dense<pg::EpiQkv, true> S{actA, ws + WS_WQKV, T / 256, 12, F.G, F.c,
                    pg::EpiQkv{actB, (const float*)(ws + WS_ROPE), (const float*)(ws + WS_ROPE) + (size_t)T * 64, 1.f / FP8_WSCALE, (float*)(ws + WS_KMEAN)}}; pg::gemm_phase(F.lds, S); SEAM(12); }
    if (IN(14)) { PHASE_WS(); phase_gating(F, actB); SEAM(14); }
    if (IN(15)) { PHASE_WS(); if (is_cv) moe_conv_stream(F, CONV_P15_BEG, CONV_L1DN_BEG, cvi, 32);
        else phase_attn(F, actB, actC, actD, (unsigned char*)actg, (float*)(ws + WS_LSE), has_cv ? (F.c >> 3) * 8 + (F.c & 7) : F.c, has_cv ? 224 : F.G);
        SEAM(15); }
    if (IN(16)) { PHASE_WS(); phase_attn_combine(F, (const unsigned char*)actg, (const float*)(ws + WS_LSE), (unsigned char*)actA); SEAM(16); }
    if (IN(17)) { PHASE_WS(); pg::Dense<pg::EpiBf16, true> S{actA, ws + WS_WO, T / 256, 4, F.G, F.c, pg::EpiBf16{actC, 1.f / (FP8_WSCALE * FP8_OSCALE)}}; pg::gemm_phase(F.lds, S); SEAM(17); }
    if (IN(18)) { PHASE_WS(); phase_norm_router(F, XB, actC, F.in[L1_NORM2], 1, (unsigned char*)actB); SEAM(18); }
    if (IN(19)) { PHASE_WS(); if (is_cv) moe_conv_stream(F, CONV_L1DN_BEG, CONV_END, cvi, 32);
        else { pg::MoeTabs M = pg::moe_setup<8>(F, 1, true, geo0);
            pg::MoeGateUp S{(const unsigned char*)actB, ws + WS_WGU1, F.in[L1_BGU], (unsigned char*)actg, M, geo0}; pg::gemm_phase(F.lds, S); }
        SEAM(19); }
    if (IN(20)) { PHASE_WS(); if (!is_cv) { pg::MoeTabs M = pg::moe_tabs_reuse(F);
            pg::MoeDown S{(const unsigned char*)actg, ws + WS_WDN1, F.in[L1_BDN], (unsigned char*)yk, M, geo0}; pg::gemm_phase(F.lds, S); }
        SEAM(20); }
    if (IN(21)) { PHASE_WS(); phase_moe_combine<true, bf16_t>(F, 1, XB, actC, nullptr, F.in[IN_FNORM], nullptr, F.out); }
#undef IN
#undef SEAM
}

extern "C" void kernel_launch(void* const* d_in, const int* in_sizes, int n_in, void* d_out, int out_size, void* d_ws, size_t ws_size, hipStream_t stream) {
    static int grid = 0;
    if (grid == 0) {
        if (n_in != 37 || in_sizes[0] != T * DM || out_size != T * DM || ws_size < WS_END) {
            fprintf(stderr, "kernel_launch: built for 37 inputs, x/out of %d floats, >= %zu bytes of workspace; got n_in %d, in0 %d, out %d, ws %zu\n", T * DM, (size_t)WS_END, n_in, n_in > 0 ? in_sizes[0] : -1, out_size, ws_size);
            grid = -1; return; }
        int dev = 0, cus = 0, per_cu = 0;
        if (hipGetDevice(&dev) != hipSuccess || hipDeviceGetAttribute(&cus, hipDeviceAttributeMultiprocessorCount, dev) != hipSuccess) { grid = -1; return; }
        if (hipFuncSetAttribute((const void*)mk_fwd, hipFuncAttributeMaxDynamicSharedMemorySize, LDS_BYTES) != hipSuccess) { fprintf(stderr, "kernel_launch: hipFuncSetAttribute failed\n"); grid = -1; return; }
        if (hipOccupancyMaxActiveBlocksPerMultiprocessor(&per_cu, (const void*)mk_fwd, NTHREADS, LDS_BYTES) != hipSuccess || per_cu < 1)
            fprintf(stderr, "kernel_launch: occupancy query reports %d workgroups per CU\n", per_cu);
        (void)hipGetLastError();
        grid = cus;
    }
    if (grid < 0) return;
    if (hipMemsetAsync(d_ws, 0, ZERO_BYTES, stream) != hipSuccess) { fprintf(stderr, "kernel_launch: memset failed\n"); return; }
    Args a{};
    for (int i = 0; i < 37; ++i) a.in[i] = (const float*)d_in[i];
    a.out = (float*)d_out; a.ws = (unsigned char*)d_ws;
#if MK_MULTI
    for (int k = 0; k < MK_EMPTY; ++k) { a.ph_lo = N_PHASES; a.ph_hi = N_PHASES + 1; hipLaunchKernelGGL(mk_fwd, dim3(grid), dim3(NTHREADS), LDS_BYTES, stream, a); }
    for (int k = 0; k < N_PHASES; ++k) { a.ph_lo = k; a.ph_hi = k + 1;
        for (int rep = 0; rep < 1 + (int)((MK_DUP >> k) & 1u); ++rep) {
            if (rep && k == 8) hipMemsetAsync((char*)d_ws + ZB_MOECNT, 0, 256, stream);
            if (rep && k == 18) hipMemsetAsync((char*)d_ws + ZB_MOECNT + 256, 0, 256, stream);
            if (rep && k == 14) hipMemsetAsync((char*)d_ws + ZB_ATTCNT, 0, 2048, stream);
            hipLaunchKernelGGL(mk_fwd, dim3(grid), dim3(NTHREADS), LDS_BYTES, stream, a); } }
#else
    a.ph_lo = 0; a.ph_hi = N_PHASES;
    hipLaunchKernelGGL(mk_fwd, dim3(grid), dim3(NTHREADS), LDS_BYTES, stream, a);
#endif
    const hipError_t le = hipPeekAtLastError();
    if (le != hipSuccess) fprintf(stderr, "kernel_launch: launch failed: %s\n", hipGetErrorName(le));
}
```

```cpp
#include <hip/hip_runtime.h>
#include <cstdio>
#include <cstdint>

#ifndef MK_DUP
#define MK_DUP 0u
#endif
#ifndef MK_EMPTY
#define MK_EMPTY 0
#endif
#ifndef MK_KREP
#define MK_KREP 1
#endif
#ifndef MK_CONVPROBE
#define MK_CONVPROBE 0
#endif
#ifndef MK_CV0
#define MK_CV0 1280
#endif
#ifndef MK_CV9
#define MK_CV9 2048
#endif
#ifndef MK_CV10
#define MK_CV10 1152
#endif
#ifndef MK_MULTI
#define MK_MULTI 0
#endif

typedef unsigned short bf16_t;
typedef short bf16x8 __attribute__((ext_vector_type(8)));
typedef short s16x4 __attribute__((ext_vector_type(4)));
typedef float f32x2 __attribute__((ext_vector_type(2)));
typedef float f32x4 __attribute__((ext_vector_type(4)));
typedef float f32x16 __attribute__((ext_vector_type(16)));
typedef unsigned u32x2 __attribute__((ext_vector_type(2)));
typedef unsigned u32x4 __attribute__((ext_vector_type(4)));
typedef int v4i __attribute__((ext_vector_type(4)));
typedef int v8i __attribute__((ext_vector_type(8)));
#define LAS __attribute__((address_space(3)))

constexpr int DM = 1024, NB = 2, SEQ = 8192, T = NB * SEQ;
constexpr int NH = 8, HD = 128, MBLK = 256, NBLK = SEQ / MBLK;
constexpr int NE = 32, TOPK = 4, DFF = 1024;
constexpr int S5G = 64, S5P = 64, S5C = 16;
constexpr int NTHREADS = 512;
constexpr int LDS_BYTES = 147456;
constexpr int LDS_BARW = LDS_BYTES - 16;
constexpr int MOE_CAP = T;
constexpr int MOE_MAXROWS = T * TOPK + NE * 256;
constexpr int MOE_MAXTILES = MOE_MAXROWS / 256;

constexpr size_t al256(size_t x) { return (x + 255) / 256 * 256; }
constexpr size_t WS_ZERO = 0;
constexpr size_t   ZB_BAR = 0;
constexpr size_t   ZB_MOECNT = 16384;
constexpr size_t   ZB_ATTCNT = 20480;
constexpr size_t ZERO_BYTES = 32768;
constexpr size_t WS_ADA = ZERO_BYTES;
constexpr size_t WS_S5A = WS_ADA + al256(2 * 2 * 6 * 1024 * 4);
constexpr size_t WS_BOP = WS_S5A + 4 * 64 * 64 * 4;
constexpr size_t WS_COP = WS_BOP + 64 * 128 * 16 * 2;
constexpr size_t WS_ROPE = WS_COP + 64 * 16 * 128 * 2;
constexpr size_t WS_WRB = WS_ROPE + 2 * (size_t)T * 64 * 4;
constexpr size_t WS_KMEAN = WS_WRB + 2 * 32 * 1024 * 2;
constexpr size_t WS_TOPK = WS_KMEAN + 2 * 8 * 32 * 128 * 4;
constexpr size_t WS_VTOK = WS_TOPK + 2 * (size_t)T * 4 * 4;
constexpr size_t ALIST_PER_BH = 256 * 496;
constexpr size_t WS_ALIST = WS_VTOK + (size_t)NE * MOE_CAP * 4;
constexpr size_t WS_LSE = WS_ALIST + 16 * ALIST_PER_BH * 4;
constexpr size_t WS_CARRY = WS_LSE + (size_t)T * 8 * 4 * 4;
constexpr size_t WS_WIN = WS_CARRY + (size_t)2 * 256 * 64 * 128 * 4;
constexpr size_t WS_WGLU = WS_WIN + 2097152, WS_WOUT = WS_WGLU + 2097152, WS_WQKV = WS_WOUT + 2097152, WS_WO = WS_WQKV + 3 * 2097152;
constexpr size_t WS_WGU0 = WS_WO + 2097152;
constexpr size_t WS_WGU1 = WS_WGU0 + (size_t)NE * 2048 * 1024 * 2;
constexpr size_t WS_WDN0 = WS_WGU1 + (size_t)NE * 2048 * 1024 * 2;
constexpr size_t WS_WDN1 = WS_WDN0 + (size_t)NE * 1024 * 1024 * 2;
constexpr size_t WS_ACTA = WS_WDN1 + (size_t)NE * 1024 * 1024 * 2;
constexpr size_t ACT_BYTES = (size_t)T * DM * 2;
constexpr size_t WS_ACTB = WS_ACTA + ACT_BYTES, WS_ACTC = WS_ACTB + ACT_BYTES, WS_ACTD = WS_ACTC + ACT_BYTES;
constexpr size_t WS_XA = WS_ACTD + ACT_BYTES;
constexpr size_t WS_XB = WS_XA + (size_t)T * DM * 4;
constexpr size_t WS_ACTG = WS_XB + (size_t)T * DM * 4;
constexpr size_t WS_YK = WS_ACTG + (size_t)MOE_MAXROWS * 1024 * 2;
constexpr size_t WS_END = WS_YK + (size_t)MOE_MAXROWS * 1024 * 2;

__device__ __forceinline__ unsigned cvt_pk_bf16(float lo, float hi) { unsigned r; asm volatile("v_cvt_pk_bf16_f32 %0, %1, %2" : "=v"(r) : "v"(lo), "v"(hi)); return r; }
__device__ __forceinline__ float bf_lo(unsigned w) { return __uint_as_float(w << 16); }
__device__ __forceinline__ float bf_hi(unsigned w) { return __uint_as_float(w & 0xffff0000u); }
__device__ __forceinline__ bf16_t f2bf(float f) { return (bf16_t)(cvt_pk_bf16(f, 0.f) & 0xffffu); }
__device__ __forceinline__ unsigned pack_fp8x4(float a, float b, float c, float d) {
    a = fminf(fmaxf(a, -448.f), 448.f); b = fminf(fmaxf(b, -448.f), 448.f); c = fminf(fmaxf(c, -448.f), 448.f); d = fminf(fmaxf(d, -448.f), 448.f);
    int w = 0; w = __builtin_amdgcn_cvt_pk_fp8_f32(a, b, w, false); w = __builtin_amdgcn_cvt_pk_fp8_f32(c, d, w, true); return (unsigned)w;
}
__device__ __forceinline__ unsigned pack_fp8x4_nc(float a, float b, float c, float d) {
    int w = 0; w = __builtin_amdgcn_cvt_pk_fp8_f32(a, b, w, false); w = __builtin_amdgcn_cvt_pk_fp8_f32(c, d, w, true); return (unsigned)w;
}
constexpr float FP8_WSCALE = 64.f, FP8_ASCALE = 4.f, FP8_OSCALE = 64.f, FP8_YSCALE = 8.f;
__device__ __forceinline__ f32x4 load_x4(const float* p) { return *(const f32x4*)p; }
__device__ __forceinline__ f32x4 load_x4(const bf16_t* p) { const u32x2 w = *(const u32x2*)p; return (f32x4){bf_lo(w.x), bf_hi(w.x), bf_lo(w.y), bf_hi(w.y)}; }
template <int CTRL> __device__ __forceinline__ float dpp_f(float v) { return __builtin_bit_cast(float, __builtin_amdgcn_update_dpp(0, __builtin_bit_cast(int, v), CTRL, 0xF, 0xF, false)); }
template <int CTRL> __device__ __forceinline__ int dpp_i(int v) { return __builtin_amdgcn_update_dpp(0, v, CTRL, 0xF, 0xF, false); }
__device__ __forceinline__ float row16_sum(float v) { v += dpp_f<0xB1>(v); v += dpp_f<0x4E>(v); v += dpp_f<0x124>(v); v += dpp_f<0x128>(v); return v; }
__device__ __forceinline__ float row16_max(float v) { v = fmaxf(v, dpp_f<0xB1>(v)); v = fmaxf(v, dpp_f<0x4E>(v)); v = fmaxf(v, dpp_f<0x124>(v)); v = fmaxf(v, dpp_f<0x128>(v)); return v; }
__device__ __forceinline__ int row16_min(int v) { v = min(v, dpp_i<0xB1>(v)); v = min(v, dpp_i<0x4E>(v)); v = min(v, dpp_i<0x124>(v)); v = min(v, dpp_i<0x128>(v)); return v; }
__device__ __forceinline__ float wave_sum(float v) {
    const int r = __builtin_bit_cast(int, row16_sum(v));
    return (__builtin_bit_cast(float, __builtin_amdgcn_readlane(r, 0)) + __builtin_bit_cast(float, __builtin_amdgcn_readlane(r, 16)))
         + (__builtin_bit_cast(float, __builtin_amdgcn_readlane(r, 32)) + __builtin_bit_cast(float, __builtin_amdgcn_readlane(r, 48)));
}
__device__ __forceinline__ float wave_max(float v) {
    const int r = __builtin_bit_cast(int, row16_max(v));
    return fmaxf(fmaxf(__builtin_bit_cast(float, __builtin_amdgcn_readlane(r, 0)), __builtin_bit_cast(float, __builtin_amdgcn_readlane(r, 16))),
                 fmaxf(__builtin_bit_cast(float, __builtin_amdgcn_readlane(r, 32)), __builtin_bit_cast(float, __builtin_amdgcn_readlane(r, 48))));
}
__device__ __forceinline__ float sigmoidf_fast(float x) { return __builtin_amdgcn_rcpf(1.f + __builtin_amdgcn_exp2f(-1.4426950408889634f * x)); }
__device__ __forceinline__ float gelu_tanh(float y) {
    const float u = 1.5957691216057308f * (y + 0.044715f * y * y * y);
    return y * sigmoidf_fast(u);
}

#define XB_TMO      128
#define XB_XCNT(j)  (256  + 64 * (j))
#define XB_XSUB(j)  (1280 + 64 * (j))
#define XB_XGEN(j)  (2304 + 64 * (j))
#define XB_TOP      3328
#define XB_TOPGEN   3392
#define XCD_BAR_WORDS 3456
#define XB_SPIN_CAP (1u << 18)

__device__ __forceinline__ unsigned xb_ld(unsigned* p)              { return __hip_atomic_load(p, __ATOMIC_RELAXED, __HIP_MEMORY_SCOPE_AGENT); }
__device__ __forceinline__ unsigned xb_add(unsigned* p, unsigned v) { return __hip_atomic_fetch_add(p, v, __ATOMIC_RELAXED, __HIP_MEMORY_SCOPE_AGENT); }
__device__ __forceinline__ unsigned xb_xcc_id() { return (unsigned)__builtin_amdgcn_s_getreg((3 << 11) | 20) & 0xFu; }
#define XB_SPIN(cond, bar) do { unsigned _sp = 0; while (cond) { __builtin_amdgcn_s_sleep(1); \
    if ((++_sp & 255u) == 0u) { if (xb_ld(&(bar)[XB_TMO])) break; if (_sp > XB_SPIN_CAP) { atomicAdd(&(bar)[XB_TMO], 1u); break; } } } } while (0)

struct XcdBarrier { unsigned* bar; unsigned x; volatile LAS unsigned* st; };

__device__ __forceinline__ XcdBarrier xcd_barrier_post(unsigned* bar, volatile LAS unsigned* st) {
    XcdBarrier b; b.bar = bar; b.x = xb_xcc_id(); b.st = st;
    if (threadIdx.x == 0) (void)xb_add(&bar[XB_XCNT(b.x)], 1u);
    return b;
}
__device__ __forceinline__ void xcd_barrier_complete(unsigned* bar, unsigned x, unsigned& nloc, unsigned& nx) {
    const unsigned G = gridDim.x * gridDim.y * gridDim.z;
    unsigned sum, cnt, mine, sp = 0u;
    for (;;) {
        sum = 0u; cnt = 0u; mine = 0u;
#pragma unroll
        for (unsigned j = 0; j < 16; ++j) { const unsigned c = xb_ld(&bar[XB_XCNT(j)]); sum += c; cnt += (c > 0u) ? 1u : 0u; mine = (j == x) ? c : mine; }
        if (sum == G) break;
        __builtin_amdgcn_s_sleep(1);
        if ((++sp & 255u) == 0u) { if (xb_ld(&bar[XB_TMO])) break; if (sp > XB_SPIN_CAP) { atomicAdd(&bar[XB_TMO], 1u); break; } }
    }
    nloc = mine > 0u ? mine : 1u; nx = cnt > 0u ? cnt : 1u;
}
__device__ __forceinline__ void xcd_barrier(const XcdBarrier& b) {
    asm volatile("s_waitcnt vmcnt(0)" ::: "memory");
    __syncthreads();
    if (threadIdx.x == 0) {
        unsigned* bar = b.bar;
        __builtin_amdgcn_s_waitcnt(0);
        unsigned nloc = b.st[0], nx = b.st[1];
        if (nloc == 0u) { xcd_barrier_complete(bar, b.x, nloc, nx); b.st[0] = nloc; b.st[1] = nx; }
        const unsigned old = xb_add(&bar[XB_XSUB(b.x)], 1u);
        const unsigned gen = old / nloc;
        if (old + 1u == (gen + 1u) * nloc) {
            __builtin_amdgcn_fence(__ATOMIC_RELEASE, "agent");
            asm volatile("s_waitcnt vmcnt(0)" ::: "memory");
            const unsigned og = xb_add(&bar[XB_TOP], 1u);
            const unsigned tg = og / nx;
            if (og + 1u == (tg + 1u) * nx) xb_add(&bar[XB_TOPGEN], 1u);
            else XB_SPIN(xb_ld(&bar[XB_TOPGEN]) == tg, bar);
            __builtin_amdgcn_fence(__ATOMIC_ACQUIRE, "agent");
            xb_add(&bar[XB_XGEN(b.x)], 1u);
            asm volatile("s_waitcnt vmcnt(0)" ::: "memory");
        } else {
            XB_SPIN(xb_ld(&bar[XB_XGEN(b.x)]) == gen, bar);
            __builtin_amdgcn_fence(__ATOMIC_ACQUIRE, "agent");
            asm volatile("s_waitcnt vmcnt(0)" ::: "memory");
        }
    }
    __syncthreads();
}

struct Args { const float* in[37]; float* out; unsigned char* ws; int ph_lo, ph_hi; };

struct Frame {
    LAS unsigned char* lds;
    int tid, lane, wave, G, c;
    const float* const* in; float* out; unsigned char* ws;
};

enum { IN_X = 0, IN_C = 1, IN_POS = 2,
       L0_NORM1 = 3, L0_ADAW = 4, L0_ADAB = 5, L0_WIN = 6, L0_BRE = 7, L0_BIM = 8, L0_CRE = 9, L0_CIM = 10, L0_LRE = 11, L0_LIM = 12, L0_LOGDT = 13, L0_D = 14, L0_WGLU = 15, L0_WOUT = 16,
       L0_NORM2 = 17, L0_WR = 18, L0_BR = 19, L0_WGU = 20, L0_BGU = 21, L0_WDN = 22, L0_BDN = 23,
       L1_NORM1 = 24, L1_ADAW = 25, L1_ADAB = 26, L1_WQKV = 27, L1_WO = 28, L1_NORM2 = 29, L1_WR = 30, L1_BR = 31, L1_WGU = 32, L1_BGU = 33, L1_WDN = 34, L1_BDN = 35, IN_FNORM = 36 };

__device__ __forceinline__ const float* ada_vec(const Frame& F, int layer, int b, int which) { return (const float*)(F.ws + WS_ADA) + ((layer * 2 + b) * 6 + which) * 1024; }

__device__ __forceinline__ void conv_unit(const Frame& F, const float* __restrict__ src, bf16_t* __restrict__ dst, int N, int kt, int ntile, bool qkperm) {
    LAS unsigned* L = (LAS unsigned*)F.lds;
    const int k0 = kt * 64, n0 = ntile * 256, lane = F.lane, w = F.wave;
#pragma unroll
    for (int j = 0; j < 4; ++j) {
        const float* sp = src + (size_t)(k0 + 2 * w) * N + n0 + lane + 64 * j;
        float a[4], b[4];
#pragma unroll
        for (int i = 0; i < 4; ++i) { a[i] = sp[(size_t)(16 * i) * N]; b[i] = sp[(size_t)(16 * i + 1) * N]; }
#pragma unroll
        for (int i = 0; i < 4; ++i) L[(lane + 64 * j) * 33 + 8 * i + w] = cvt_pk_bf16(a[i], b[i]);
    }
    __syncthreads();
    const int row = F.tid >> 1, half = F.tid & 1;
    int n = n0 + row;
    if (qkperm && n < 2048) { const int d = n & 127; n = (n & ~127) | (d < 64 ? 2 * d : 2 * (d - 64) + 1); }
    bf16_t* dp = dst + (size_t)n * 1024 + k0 + half * 32;
#pragma unroll
    for (int q = 0; q < 4; ++q) {
        u32x4 v; v.x = L[row * 33 + half * 16 + 4 * q + 0]; v.y = L[row * 33 + half * 16 + 4 * q + 1]; v.z = L[row * 33 + half * 16 + 4 * q + 2]; v.w = L[row * 33 + half * 16 + 4 * q + 3];
        *(u32x4*)(dp + 8 * q) = v;
    }
    __syncthreads();
}

__device__ __forceinline__ void conv_unit8(const Frame& F, const float* __restrict__ src, unsigned char* __restrict__ dst, int N, int kt, int ntile, bool qkperm = false) {
    LAS unsigned* L = (LAS unsigned*)F.lds;
    const int k0 = kt * 128, n0 = ntile * 128, lane = F.lane, w = F.wave;
#pragma unroll
    for (int j = 0; j < 2; ++j) {
        const float* sp = src + (size_t)(k0 + 4 * w) * N + n0 + lane + 64 * j;
        float f[4][4];
#pragma unroll
        for (int i = 0; i < 4; ++i)
#pragma unroll
            for (int q = 0; q < 4; ++q) f[i][q] = sp[(size_t)(32 * i + q) * N];
#pragma unroll
        for (int i = 0; i < 4; ++i) L[(lane + 64 * j) * 33 + w + 8 * i] = pack_fp8x4(f[i][0] * FP8_WSCALE, f[i][1] * FP8_WSCALE, f[i][2] * FP8_WSCALE, f[i][3] * FP8_WSCALE);
    }
    __syncthreads();
    const int row = F.tid >> 2, qtr = F.tid & 3;
    int n = n0 + row;
    if (qkperm && n < 2048) { const int d = n & 127; n = (n & ~127) | (d < 64 ? 2 * d : 2 * (d - 64) + 1); }
    unsigned char* dp = dst + (size_t)n * 1024 + k0 + qtr * 32;
#pragma unroll
    for (int q = 0; q < 2; ++q) {
        u32x4 v; v.x = L[row * 33 + qtr * 8 + 4 * q + 0]; v.y = L[row * 33 + qtr * 8 + 4 * q + 1]; v.z = L[row * 33 + qtr * 8 + 4 * q + 2]; v.w = L[row * 33 + qtr * 8 + 4 * q + 3];
        *(u32x4*)(dp + 16 * q) = v;
    }
    __syncthreads();
}

__device__ __forceinline__ void ada_unit(const Frame& F, int layer, int cg) {
    LAS float* ca = (LAS float*)F.lds;
    const float* cin = F.in[IN_C];
    for (int i = F.tid; i < 2048; i += NTHREADS) { const float c = cin[i]; ca[i] = c * sigmoidf_fast(c); }
    __syncthreads();
    const float* w = F.in[layer ? L1_ADAW : L0_ADAW]; const float* bias = F.in[layer ? L1_ADAB : L0_ADAB];
    const int kq = F.wave, col = cg * 64 + F.lane;
    float a0 = 0.f, a1 = 0.f;
#pragma unroll 8
    for (int k = kq * 128; k < kq * 128 + 128; ++k) { const float wv = w[(size_t)k * 6144 + col]; a0 = fmaf(ca[k], wv, a0); a1 = fmaf(ca[1024 + k], wv, a1); }
    LAS float* red = ca + 2048;
    red[(kq * 2 + 0) * 64 + F.lane] = a0; red[(kq * 2 + 1) * 64 + F.lane] = a1;
    __syncthreads();
    if (F.tid < 128) { const int b = F.tid >> 6, l = F.tid & 63; float s = bias[cg * 64 + l];
#pragma unroll
        for (int q = 0; q < 8; ++q) s += red[(q * 2 + b) * 64 + l];
        ((float*)(F.ws + WS_ADA))[(layer * 2 + b) * 6144 + cg * 64 + l] = s; }
    __syncthreads();
}

__device__ __forceinline__ void s5tab_unit(const Frame& F, int unit) {
    const int idx = unit * NTHREADS + F.tid, g = idx >> 6, p = idx & 63;
    const double dt = exp((double)F.in[L0_LOGDT][g]);
    const double lr = (double)F.in[L0_LRE][idx], li = (double)F.in[L0_LIM][idx];
    const double mag = exp(lr * dt), ar = mag * cos(li * dt), ai = mag * sin(li * dt);
    const double den = lr * lr + li * li;
    const double fr = ((ar - 1.0) * lr + ai * li) / den, fi = (ai * lr - (ar - 1.0) * li) / den;
    const double mag32 = exp(32.0 * lr * dt), a32r = mag32 * cos(32.0 * li * dt), a32i = mag32 * sin(32.0 * li * dt);
    float* tab = (float*)(F.ws + WS_S5A);
    tab[idx] = (float)ar; tab[4096 + idx] = (float)ai; tab[8192 + idx] = (float)a32r; tab[12288 + idx] = (float)a32i;
    bf16_t* bop = (bf16_t*)(F.ws + WS_BOP); bf16_t* cop = (bf16_t*)(F.ws + WS_COP);
    const float* bre = F.in[L0_BRE] + (size_t)idx * 16; const float* bim = F.in[L0_BIM] + (size_t)idx * 16;
#pragma unroll
    for (int ch = 0; ch < 16; ++ch) {
        const double br = bre[ch], bi = bim[ch];
        bop[(g * 128 + p) * 16 + ch] = f2bf((float)(fr * br - fi * bi));
        bop[(g * 128 + 64 + p) * 16 + ch] = f2bf((float)(fr * bi + fi * br));
        cop[(g * 16 + ch) * 128 + p] = f2bf(F.in[L0_CRE][(g * 16 + ch) * 64 + p]);
        cop[(g * 16 + ch) * 128 + 64 + p] = f2bf(-F.in[L0_CIM][(g * 16 + ch) * 64 + p]);
    }
}

__device__ __forceinline__ void rope_unit(const Frame& F, int unit) {
    LAS float* invl = (LAS float*)F.lds;
    if (F.tid < 64) invl[F.tid] = (float)exp2(-(double)F.tid * (13.287712379549449 / 64.0));
    __syncthreads();
    const int idx = (unit * NTHREADS + F.tid) * 4, t = idx >> 6, i0 = idx & 63;
    const float pos = (float)((const int*)F.in[IN_POS])[t];
    f32x4 c, s;
#pragma unroll
    for (int e = 0; e < 4; ++e) {
        const float ang = pos * invl[i0 + e];
        const float k = rintf(ang * 0.15915494309189535f);
        float r = fmaf(-k, 6.28125f, ang); r = fmaf(-k, 1.9353071693331003e-3f, r); r = fmaf(-k, 1.0253131677018246e-11f, r);
        c[e] = __cosf(r); s[e] = __sinf(r);
    }
    *(f32x4*)((float*)(F.ws + WS_ROPE) + idx) = c;
    *(f32x4*)((float*)(F.ws + WS_ROPE) + (size_t)T * 64 + idx) = s;
    __syncthreads();
}

constexpr int CONV_L0DN_BEG = 4096, CONV_L1GU_BEG = 6144, CONV_L1DN_BEG = 10240, CONV_END = 12288;
constexpr int CONV_P10_BEG = CONV_L1GU_BEG + MK_CV0, CONV_P15_BEG = CONV_P10_BEG + MK_CV10;
constexpr int P0_CONV0 = 64, P0_CONV1 = 128, P0_CONV2 = 192, P0_CONV3 = 384, P0_CONV4 = 448, P0_CONV5 = 4544, P0_CONV6 = 6592, P0_CONV7 = 10688, P0_CONV8 = 12736;
constexpr int P0_ADA = P0_CONV8 + 192, P0_S5 = P0_ADA + 8, P0_ROPE = P0_S5 + 512, P0_WRB = P0_ROPE + 128, P0_END = P0_WRB + 32;

__device__ __forceinline__ void conv_batched(const Frame& F, int u, const float* src, size_t dst_off, int N) {
    const int per = 16 * (N / 256), e = u / per, r = u % per, kt = r / (N / 256), nt = r % (N / 256);
    conv_unit(F, src + (size_t)e * 1024 * N, (bf16_t*)(F.ws + dst_off) + (size_t)e * N * 1024, N, kt, nt, false);
}

__device__ __forceinline__ void conv_batched8(const Frame& F, int u, const float* src, size_t dst_off, int N) {
    const int per = 8 * (N / 128), e = u / per, r = u % per, kt = r / (N / 128), nt = r % (N / 128);
    conv_unit8(F, src + (size_t)e * 1024 * N, F.ws + dst_off + (size_t)e * N * 1024, N, kt, nt);
}

__device__ __forceinline__ bool moe_conv_decode(const Frame& F, int u, const float*& src, unsigned char*& dst, int& N) {
    if (u >= 12288) return false;
    const int fam = u < 4096 ? 0 : (u < 6144 ? 1 : (u < 10240 ? 2 : 3));
    const int base = fam == 0 ? 0 : (fam == 1 ? 4096 : (fam == 2 ? 6144 : 10240));
    N = (fam & 1) ? 1024 : 2048;
    const float* sp = fam == 0 ? F.in[L0_WGU] : (fam == 1 ? F.in[L0_WDN] : (fam == 2 ? F.in[L1_WGU] : F.in[L1_WDN]));
    const size_t doff = fam == 0 ? WS_WGU0 : (fam == 1 ? WS_WDN0 : (fam == 2 ? WS_WGU1 : WS_WDN1));
    const int r0 = u - base, per = 8 * (N / 128), e = r0 / per, r = r0 % per, kt = r / (N / 128), nt = r % (N / 128);
    src = sp + (size_t)e * 1024 * N + (size_t)(kt * 128 + 16 * F.wave + 8 * (F.lane >> 5)) * N + nt * 128 + 4 * (F.lane & 31);
    dst = F.ws + doff + (size_t)e * N * 1024 + (size_t)(nt * 128 + (F.tid >> 2)) * 1024 + kt * 128 + (F.tid & 3) * 32;
    return true;
}
__device__ __forceinline__ void moe_conv_stream(const Frame& F, int ubeg, int uend, int ci, int cn) {
    LAS unsigned* L = (LAS unsigned*)F.lds;
    const int nq = F.lane & 31, kd0 = 4 * F.wave + 2 * (F.lane >> 5), row = F.tid >> 2, qtr = F.tid & 3;
    const float* src; unsigned char* dst; int N;
    int u = ubeg + ci;
    if (u >= uend || !moe_conv_decode(F, u, src, dst, N)) return;
    f32x4 fa[8], fb[8]; unsigned char* da = dst; unsigned char* db = nullptr;
#define CV_LOAD(f) do { _Pragma("unroll") for (int i = 0; i < 8; ++i) f[i] = __builtin_nontemporal_load((const f32x4*)(src + (size_t)i * N)); } while (0)
#define CV_EMIT(f, d) do { unsigned pk[4][2]; \
        _Pragma("unroll") for (int c = 0; c < 4; ++c) { pk[c][0] = pack_fp8x4(f[0][c] * FP8_WSCALE, f[1][c] * FP8_WSCALE, f[2][c] * FP8_WSCALE, f[3][c] * FP8_WSCALE); \
                                                         pk[c][1] = pack_fp8x4(f[4][c] * FP8_WSCALE, f[5][c] * FP8_WSCALE, f[6][c] * FP8_WSCALE, f[7][c] * FP8_WSCALE); } \
        u += cn; more = u < uend && moe_conv_decode(F, u, src, dst, N); if (more) CV_LOAD(f); \
        _Pragma("unroll") for (int c = 0; c < 4; ++c) { L[(4 * nq + c) * 33 + kd0] = pk[c][0]; L[(4 * nq + c) * 33 + kd0 + 1] = pk[c][1]; } \
        asm volatile("s_waitcnt lgkmcnt(0)" ::: "memory"); __builtin_amdgcn_s_barrier(); asm volatile("" ::: "memory");     \
        _Pragma("unroll") for (int q = 0; q < 2; ++q) { u32x4 v; v.x = L[row * 33 + qtr * 8 + 4 * q + 0]; v.y = L[row * 33 + qtr * 8 + 4 * q + 1]; v.z = L[row * 33 + qtr * 8 + 4 * q + 2]; v.w = L[row * 33 + qtr * 8 + 4 * q + 3]; \
            *(u32x4*)((d) + 16 * q) = v; } \
        asm volatile("s_waitcnt lgkmcnt(0)" ::: "memory"); __builtin_amdgcn_s_barrier(); asm volatile("" ::: "memory"); } while (0)
    bool more;
    CV_LOAD(fa);
    u += cn; bool have_b = u < uend && moe_conv_decode(F, u, src, dst, N);
    if (have_b) { db = dst; CV_LOAD(fb); }
    for (;;) {
        unsigned char* d0 = da;
        CV_EMIT(fa, d0);
        const bool have_a = more; if (have_a) da = dst;
        if (!have_b) break;
        unsigned char* d1 = db;
        CV_EMIT(fb, d1);
        have_b = more; if (have_b) db = dst;
        if (!have_a) break;
    }
#undef CV_LOAD
#undef CV_EMIT
}

__device__ __forceinline__ void phase_prologue(const Frame& F) {
#if MK_CONVPROBE
    if ((F.c >> 3) >= 28) moe_conv_stream(F, 0, 12288, ((F.c >> 3) - 28) * 8 + (F.c & 7), 32);
#else
    moe_conv_stream(F, 0, CONV_L0DN_BEG, F.c, F.G);
    moe_conv_stream(F, CONV_L1GU_BEG, CONV_P10_BEG, F.c, F.G);
#endif
    for (int u = F.c; u < P0_END; u += F.G) {
        if (u >= P0_CONV4 && u < P0_CONV8) continue;
        if (u < P0_CONV0) conv_batched(F, u, F.in[L0_WIN], WS_WIN, 1024);
        else if (u < P0_CONV1) conv_batched8(F, u - P0_CONV0, F.in[L0_WGLU], WS_WGLU, 1024);
        else if (u < P0_CONV2) conv_batched(F, u - P0_CONV1, F.in[L0_WOUT], WS_WOUT, 1024);
        else if (u < P0_CONV3) { const int r = u - P0_CONV2; conv_unit8(F, F.in[L1_WQKV], F.ws + WS_WQKV, 3072, r / 24, r % 24, true); }
        else if (u < P0_CONV4) conv_batched8(F, u - P0_CONV3, F.in[L1_WO], WS_WO, 1024);
        else if (u < P0_CONV5) conv_batched8(F, u - P0_CONV4, F.in[L0_WGU], WS_WGU0, 2048);
        else if (u < P0_CONV6) conv_batched8(F, u - P0_CONV5, F.in[L0_WDN], WS_WDN0, 1024);
        else if (u < P0_CONV7) conv_batched8(F, u - P0_CONV6, F.in[L1_WGU], WS_WGU1, 2048);
        else if (u < P0_CONV8) conv_batched8(F, u - P0_CONV7, F.in[L1_WDN], WS_WDN1, 1024);
        else if (u < P0_ADA) { const int r = u - P0_CONV8; ada_unit(F, r / 96, r % 96); }
        else if (u < P0_S5) s5tab_unit(F, u - P0_ADA);
        else if (u < P0_ROPE) rope_unit(F, u - P0_S5);
        else if (u < P0_WRB) { const int idx = (u - P0_ROPE) * NTHREADS + F.tid, layer = idx >> 15, e = (idx >> 10) & 31, k = idx & 1023;
               ((bf16_t*)(F.ws + WS_WRB))[idx] = f2bf(F.in[layer ? L1_WR : L0_WR][k * 32 + e]); }
        else *(f32x4*)((float*)(F.ws + WS_KMEAN) + ((u - P0_WRB) * NTHREADS + F.tid) * 4) = (f32x4){0.f, 0.f, 0.f, 0.f};
    }
}

__device__ __forceinline__ void norm_mod_row(const float* __restrict__ xr, const float* __restrict__ gamma, const float* __restrict__ sh, const float* __restrict__ sc, bf16_t* __restrict__ hr, int lane) {
    f32x4 v[4]; float ss = 0.f;
#pragma unroll
    for (int i = 0; i < 4; ++i) { v[i] = *(const f32x4*)(xr + 256 * i + 4 * lane); ss += v[i][0] * v[i][0] + v[i][1] * v[i][1] + v[i][2] * v[i][2] + v[i][3] * v[i][3]; }
    ss = wave_sum(ss);
    const float rs = rsqrtf(ss * (1.f / 1024.f) + 1e-6f);
#pragma unroll
    for (int i = 0; i < 4; ++i) {
        const int col = 256 * i + 4 * lane;
        const f32x4 g = *(const f32x4*)(gamma + col), s1 = *(const f32x4*)(sc + col), s0 = *(const f32x4*)(sh + col);
        f32x4 y;
#pragma unroll
        for (int e = 0; e < 4; ++e) y[e] = v[i][e] * rs * g[e] * (1.f + s1[e]) + s0[e];
        u32x2 o; o.x = cvt_pk_bf16(y[0], y[1]); o.y = cvt_pk_bf16(y[2], y[3]);
        *(u32x2*)(hr + col) = o;
    }
}
__device__ __forceinline__ void phase_norm_mod(const Frame& F, const float* xin, const float* gamma, int layer, int which, bf16_t* hout) {
    const int lane = F.lane;
    for (int r = F.c * 8 + F.wave; r < T; r += F.G * 16) {
        const int r2 = r + F.G * 8; const bool two = r2 < T; const int rb = two ? r2 : r;
        f32x4 v[2][4];
#pragma unroll
        for (int i = 0; i < 4; ++i) { v[0][i] = *(const f32x4*)(xin + (size_t)r * DM + 256 * i + 4 * lane); v[1][i] = *(const f32x4*)(xin + (size_t)rb * DM + 256 * i + 4 * lane); }
#pragma unroll
        for (int q = 0; q < 2; ++q) {
            if (q == 1 && !two) break;
            const int rr = q ? rb : r, b = rr >> 13;
            const float* sh = ada_vec(F, layer, b, which); const float* sc = ada_vec(F, layer, b, which + 1);
            float ss = 0.f;
#pragma unroll
            for (int i = 0; i < 4; ++i) ss += v[q][i][0] * v[q][i][0] + v[q][i][1] * v[q][i][1] + v[q][i][2] * v[q][i][2] + v[q][i][3] * v[q][i][3];
            ss = wave_sum(ss);
            const float rs = rsqrtf(ss * (1.f / 1024.f) + 1e-6f);
#pragma unroll
            for (int i = 0; i < 4; ++i) {
                const int col = 256 * i + 4 * lane;
                const f32x4 g = *(const f32x4*)(gamma + col), s1 = *(const f32x4*)(sc + col), s0 = *(const f32x4*)(sh + col);
                f32x4 y;
#pragma unroll
                for (int e = 0; e < 4; ++e) y[e] = v[q][i][e] * rs * g[e] * (1.f + s1[e]) + s0[e];
                u32x2 o; o.x = cvt_pk_bf16(y[0], y[1]); o.y = cvt_pk_bf16(y[2], y[3]);
                *(u32x2*)(hout + (size_t)rr * DM + col) = o;
            }
        }
    }
}

template <class XT>
__device__ __forceinline__ void phase_norm_router(const Frame& F, const XT* xin, const bf16_t* mres, const float* gamma, int layer, unsigned char* hout) {
    const bf16_t* wrb = (const bf16_t*)(F.ws + WS_WRB) + (size_t)layer * 32 * 1024; const float* br = F.in[layer ? L1_BR : L0_BR];
    LAS unsigned char* hb = F.lds + F.wave * 16640;
    LAS int* cntl = (LAS int*)(F.lds + 133120);
    LAS int* basel = cntl + 32; LAS int* entl = cntl + 64;
    unsigned* gcnt = (unsigned*)(F.ws + ZB_MOECNT + layer * 256);
    int* pos = (int*)(F.ws + WS_TOPK); float* gates = (float*)(F.ws + WS_TOPK + (size_t)T * 4 * 4); int* vtok = (int*)(F.ws + WS_VTOK);
    const int lane = F.lane, e16 = lane & 15, kg = lane >> 4;
    for (int r0 = F.c * 64; r0 < T; r0 += F.G * 64) {
        if (F.tid < 32) cntl[F.tid] = 0;
        __syncthreads();
        const int rw = r0 + F.wave * 8;
        const int b = rw >> 13;
        const float* sh = ada_vec(F, layer, b, 3); const float* sc = ada_vec(F, layer, b, 4);
#pragma unroll 1
        for (int half = 0; half < 2; ++half) {
            f32x4 v[4][4]; u32x2 mr[4][4];
#pragma unroll
            for (int q = 0; q < 4; ++q)
#pragma unroll
                for (int i = 0; i < 4; ++i) { v[q][i] = load_x4(xin + (size_t)(rw + half * 4 + q) * DM + 256 * i + 4 * lane);
                                              mr[q][i] = *(const u32x2*)(mres + (size_t)(rw + half * 4 + q) * DM + 256 * i + 4 * lane); }
            { const float* g1 = ada_vec(F, layer, b, 2);
#pragma unroll
              for (int i = 0; i < 4; ++i) { const f32x4 gv = *(const f32x4*)(g1 + 256 * i + 4 * lane);
#pragma unroll
                for (int q = 0; q < 4; ++q) { v[q][i][0] = fmaf(gv[0], bf_lo(mr[q][i].x), v[q][i][0]); v[q][i][1] = fmaf(gv[1], bf_hi(mr[q][i].x), v[q][i][1]);
                                              v[q][i][2] = fmaf(gv[2], bf_lo(mr[q][i].y), v[q][i][2]); v[q][i][3] = fmaf(gv[3], bf_hi(mr[q][i].y), v[q][i][3]); } } }
#pragma unroll
            for (int q = 0; q < 4; ++q) {
                const int r = rw + half * 4 + q;
                float ss = 0.f;
#pragma unroll
                for (int i = 0; i < 4; ++i) ss += v[q][i][0] * v[q][i][0] + v[q][i][1] * v[q][i][1] + v[q][i][2] * v[q][i][2] + v[q][i][3] * v[q][i][3];
                ss = wave_sum(ss);
                const float rs = rsqrtf(ss * (1.f / 1024.f) + 1e-6f);
#pragma unroll
                for (int i = 0; i < 4; ++i) {
                    const int col = 256 * i + 4 * lane;
                    const f32x4 g = *(const f32x4*)(gamma + col), s1 = *(const f32x4*)(sc + col), s0 = *(const f32x4*)(sh + col);
                    f32x4 y;
#pragma unroll
                    for (int k = 0; k < 4; ++k) y[k] = v[q][i][k] * rs * g[k] * (1.f + s1[k]) + s0[k];
                    *(unsigned*)(hout + (size_t)r * DM + col) = pack_fp8x4(y[0], y[1], y[2], y[3]);
                    u32x2 o; o.x = cvt_pk_bf16(y[0], y[1]); o.y = cvt_pk_bf16(y[2], y[3]);
                    *(LAS u32x2*)(hb + (half * 4 + q) * 2080 + col * 2) = o;
                }
            }
        }
        f32x4 acc0 = {0.f, 0.f, 0.f, 0.f}, acc1 = {0.f, 0.f, 0.f, 0.f};
        const LAS unsigned char* ap = hb + (e16 & 7) * 2080 + kg * 16;
        const bf16_t* bp0 = wrb + (size_t)e16 * 1024 + kg * 8; const bf16_t* bp1 = bp0 + 16 * 1024;
#pragma unroll 8
        for (int ks = 0; ks < 32; ++ks) {
            const bf16x8 a = *(const LAS bf16x8*)(ap + ks * 64);
            const bf16x8 w0 = *(const bf16x8*)(bp0 + ks * 32), w1 = *(const bf16x8*)(bp1 + ks * 32);
            acc0 = __builtin_amdgcn_mfma_f32_16x16x32_bf16(a, w0, acc0, 0, 0, 0);
            acc1 = __builtin_amdgcn_mfma_f32_16x16x32_bf16(a, w1, acc1, 0, 0, 0);
        }
        const float bias0 = br[e16], bias1 = br[16 + e16];
#pragma unroll
        for (int reg = 0; reg < 4; ++reg) {
            float v0 = acc0[reg] + bias0, v1 = acc1[reg] + bias1;
            const int r = rw + ((4 * kg + reg) & 7);
            int ek[4]; float vk[4];
#pragma unroll
            for (int k = 0; k < 4; ++k) {
                const float m = row16_max(fmaxf(v0, v1));
                const int cand = row16_min((v0 == m) ? e16 : ((v1 == m) ? 16 + e16 : 99));
                ek[k] = cand; vk[k] = m;
                if (cand == e16) v0 = -INFINITY; else if (cand == 16 + e16) v1 = -INFINITY;
            }
            const float e1 = __expf(vk[1] - vk[0]), e2 = __expf(vk[2] - vk[0]), e3 = __expf(vk[3] - vk[0]);
            const float inv = 1.f / (1.f + e1 + e2 + e3);
            if (kg < 2 && e16 < 4) {
                const int ee = e16 == 0 ? ek[0] : e16 == 1 ? ek[1] : e16 == 2 ? ek[2] : ek[3];
                const float gg = (e16 == 0 ? 1.f : e16 == 1 ? e1 : e16 == 2 ? e2 : e3) * inv;
                const int rank = __hip_atomic_fetch_add(&cntl[ee], 1, __ATOMIC_RELAXED, __HIP_MEMORY_SCOPE_WORKGROUP);
                entl[(r - r0) * 4 + e16] = (ee << 16) | rank;
                gates[(size_t)r * 4 + e16] = gg;
            }
        }
        __syncthreads();
        if (F.tid < 32) basel[F.tid] = (int)atomicAdd(&gcnt[F.tid], (unsigned)cntl[F.tid]);
        __syncthreads();
        if (F.tid < 256) {
            const int en = entl[F.tid], ee = en >> 16, v = basel[ee] + (en & 0xffff), tk = r0 * 4 + F.tid;
            vtok[ee * MOE_CAP + v] = tk; pos[tk] = ee * MOE_CAP + v;
        }
        __syncthreads();
    }
}

namespace pg {
constexpr int BM = 256, BK = 64, HALF = 128, HTB = HALF * BK * 2, STAGE_BYTES = 8 * HTB, NXCD = 8, WGM = 8, KD = 1024, NKT = KD / BK;
__device__ __forceinline__ int lds_byte(int r, int c) { const int st = (r >> 4) * 2 + (c >> 5), rr = r & 15, cc = c & 31, ob = rr * 64 + cc * 2; return st * 1024 + (ob ^ (((ob >> 9) & 1) << 5)); }
__device__ __forceinline__ void stage_rc(int b, int& R, int& C) { const int st = b / 1024, sb = b % 1024, swz = sb ^ (((sb >> 9) & 1) << 5); R = (st >> 1) * 16 + swz / 64; C = (st & 1) * 32 + (swz % 64) / 2; }
__device__ __forceinline__ int perm32(int rho) { const int n = rho >> 4, i = rho & 15; return 8 * (i >> 2) + 4 * n + (i & 3); }

struct Unit { int rt, pn, e, ui; };

template <class P>
__device__ __forceinline__ void gemm_phase(LAS unsigned char* lds, const P& S) {
    const int tid = threadIdx.x, wid = __builtin_amdgcn_readfirstlane(tid >> 6), lane = tid & 63, wr = wid >> 2, wc = wid & 3, fr = lane & 15, fq = lane >> 4;
    int R0, C0; stage_rc(tid * 16, R0, C0);
    constexpr int ROWB = P::FP8 ? 1024 : 2048, NKT_ = ROWB / 128, KREP = P::KREP;
    unsigned voffB[2];
#pragma unroll
    for (int i = 0; i < 2; ++i) { const int R = R0 + 64 * i, Rb = P::PERM ? ((R & ~31) + perm32(R & 31)) : R; voffB[i] = (unsigned)(Rb * ROWB + C0 * 2); }
    const unsigned cofs = (unsigned)C0 * 2u;
    const unsigned ldsw = (unsigned)wid * 1024u;
    const int aoff = lds_byte(wr * 64 + fr, fq * 8), boff = lds_byte(wc * 32 + fr, fq * 8);
#define PG_SA(b, h) (((b) * 2 + (h)) * HTB)
#define PG_SB(b, h) ((4 + (b) * 2 + (h)) * HTB)
#define PG_STA(bufoff, kptr, V0, V1) do { \
        __builtin_amdgcn_global_load_lds((const unsigned*)((kptr) + (V0)), (LAS unsigned*)(lds + (bufoff) + ldsw), 16, 0, 0); \
        __builtin_amdgcn_global_load_lds((const unsigned*)((kptr) + (V1)), (LAS unsigned*)(lds + (bufoff) + ldsw + 8192), 16, 0, 0); } while (0)
#define PG_STB(bufoff, bptr) PG_STA(bufoff, bptr, voffB[0], voffB[1])
#define PG_LDA(dst, b, h) do { _Pragma("unroll") for (int m = 0; m < 4; ++m) dst[m] = __builtin_shufflevector(*(const LAS v4i*)(lds + PG_SA(b, h) + aoff + m * 2048), *(const LAS v4i*)(lds + PG_SA(b, h) + aoff + m * 2048 + 1024), 0, 1, 2, 3, 4, 5, 6, 7); } while (0)
#define PG_LDB(dst, b, h) do { _Pragma("unroll") for (int n = 0; n < 2; ++n) dst[n] = __builtin_shufflevector(*(const LAS v4i*)(lds + PG_SB(b, h) + boff + n * 2048), *(const LAS v4i*)(lds + PG_SB(b, h) + boff + n * 2048 + 1024), 0, 1, 2, 3, 4, 5, 6, 7); } while (0)
#define PG_LO(X) __builtin_bit_cast(bf16x8, __builtin_shufflevector(X, X, 0, 1, 2, 3))
#define PG_HI(X) __builtin_bit_cast(bf16x8, __builtin_shufflevector(X, X, 4, 5, 6, 7))
#define PG_MMA(ai, bj, At, Bt) do { __builtin_amdgcn_s_setprio(1); _Pragma("unroll") for (int m = 0; m < 4; ++m) _Pragma("unroll") for (int n = 0; n < 2; ++n) { \
        if constexpr (P::FP8) asm volatile("v_mfma_scale_f32_16x16x128_f8f6f4 %0, %1, %2, %0, %3, %3 op_sel_hi:[0,0,0]" : "+v"(acc[ai][bj][m][n]) : "v"(Bt[n]), "v"(At[m]), "v"(fp8_one)); \
        else { acc[ai][bj][m][n] = __builtin_amdgcn_mfma_f32_16x16x32_bf16(PG_LO(Bt[n]), PG_LO(At[m]), acc[ai][bj][m][n], 0, 0, 0); \
               acc[ai][bj][m][n] = __builtin_amdgcn_mfma_f32_16x16x32_bf16(PG_HI(Bt[n]), PG_HI(At[m]), acc[ai][bj][m][n], 0, 0, 0); } } \
        __builtin_amdgcn_s_setprio(0); } while (0)
#define PG_WAIT_V(n) asm volatile("s_waitcnt vmcnt(" #n ")" ::: "memory")
#define PG_WAIT_L(n) asm volatile("s_waitcnt lgkmcnt(" #n ")" ::: "memory")
#define PG_BAR __builtin_amdgcn_s_barrier()
#define PG_SCHED __builtin_amdgcn_sched_barrier(0)
    Unit cur, nxt; int ui = 0;
    if (!S.next(0, cur)) return;
    f32x4 acc[2][2][4][2];
    {   f32x4 bi[2][2]; S.binit(cur, wc, fq, bi);
#pragma unroll
        for (int a = 0; a < 2; ++a)
#pragma unroll
            for (int b = 0; b < 2; ++b)
#pragma unroll
                for (int m = 0; m < 4; ++m)
#pragma unroll
                    for (int n = 0; n < 2; ++n) acc[a][b][m][n] = bi[b][n]; }
    v8i At[4], B0[2], B1[2];
    int fp8_one = 0x7F7F7F7F; asm volatile("" : "+v"(fp8_one));
    unsigned va0, va1, va2, va3, vn0, vn1, vn2, vn3;
    S.arows(cur, R0, cofs, va0, va1, va2, va3);
    const char* cb0; const char* cb1; S.bptr(cur, cb0, cb1);
    const char* const A0 = S.abase();
    PG_STB(PG_SB(0, 0), cb0); PG_STA(PG_SA(0, 0), A0, va0, va1); PG_STB(PG_SB(0, 1), cb1); PG_STA(PG_SA(0, 1), A0, va2, va3);
    if (wr == 1) PG_BAR;
    PG_WAIT_V(4); PG_BAR;
    PG_STB(PG_SB(1, 0), cb0 + 128); PG_STA(PG_SA(1, 0), A0 + 128, va0, va1); PG_STB(PG_SB(1, 1), cb1 + 128);
    PG_WAIT_V(6); PG_BAR;
    for (;;) {
        const bool has_next = S.next(ui + 1, nxt);
        const char* nb0 = cb0; const char* nb1 = cb1; vn0 = va0; vn1 = va1; vn2 = va2; vn3 = va3;
        if (has_next) { S.arows(nxt, R0, cofs, vn0, vn1, vn2, vn3); S.bptr(nxt, nb0, nb1); }
#pragma unroll 1
        for (int tt = 0; tt < NKT_ * KREP; tt += 2) {
            const int t = tt % NKT_;
            const bool wrap = (t == NKT_ - 2), last = wrap && (tt == NKT_ * KREP - 2);
            const int kt2 = wrap ? 0 : t + 2;
            const char* a1 = A0 + (size_t)(t + 1) * 128; const char* a2 = A0 + (size_t)kt2 * 128; const char* a3 = a2 + 128;
            const char* b20 = (last ? nb0 : cb0) + (size_t)kt2 * 128; const char* b21 = (last ? nb1 : cb1) + (size_t)kt2 * 128;
            const unsigned w0 = last ? vn0 : va0, w1 = last ? vn1 : va1, w2 = last ? vn2 : va2, w3 = last ? vn3 : va3;
            PG_LDB(B0, 0, 0); PG_SCHED; PG_LDA(At, 0, 0); PG_STA(PG_SA(1, 1), a1, va2, va3);
            PG_WAIT_L(8); PG_BAR; PG_WAIT_L(0); PG_MMA(0, 0, At, B0); PG_BAR; PG_SCHED;
            PG_LDB(B1, 0, 1); PG_STB(PG_SB(0, 0), b20);
            PG_BAR; PG_WAIT_L(0); PG_MMA(0, 1, At, B1); PG_BAR;
            PG_LDA(At, 0, 1); PG_STA(PG_SA(0, 0), a2, w0, w1);
            PG_BAR; PG_WAIT_L(0); PG_MMA(1, 0, At, B0); PG_BAR; PG_SCHED;
            PG_STB(PG_SB(0, 1), b21);
            PG_WAIT_V(6); PG_BAR; PG_MMA(1, 1, At, B1); PG_BAR;
            PG_LDB(B0, 1, 0); PG_SCHED; PG_LDA(At, 1, 0); PG_STA(PG_SA(0, 1), a2, w2, w3);
            PG_WAIT_L(8); PG_BAR; PG_WAIT_L(0); PG_MMA(0, 0, At, B0); PG_BAR; PG_SCHED;
            PG_LDB(B1, 1, 1); PG_STB(PG_SB(1, 0), b20 + 128);
            PG_BAR; PG_WAIT_L(0); PG_MMA(0, 1, At, B1); PG_BAR;
            PG_LDA(At, 1, 1); PG_STA(PG_SA(1, 0), a3, w0, w1);
            PG_BAR; PG_WAIT_L(0); PG_MMA(1, 0, At, B0); PG_BAR; PG_SCHED;
            PG_STB(PG_SB(1, 1), b21 + 128);
            PG_WAIT_V(6); PG_BAR; PG_MMA(1, 1, At, B1); PG_BAR;
        }
        f32x4 bn[2][2];
        if (has_next) S.binit(nxt, wc, fq, bn);
        if constexpr (P::FP8) asm volatile("s_nop 15\n\ts_nop 15" ::: "memory");
        S.epi(acc, cur, wr, wc, fr, fq);
        if (!has_next) break;
#pragma unroll
        for (int a = 0; a < 2; ++a)
#pragma unroll
            for (int b = 0; b < 2; ++b)
#pragma unroll
                for (int m = 0; m < 4; ++m)
#pragma unroll
                    for (int n = 0; n < 2; ++n) acc[a][b][m][n] = bn[b][n];
        cur = nxt; cb0 = nb0; cb1 = nb1; va0 = vn0; va1 = vn1; va2 = vn2; va3 = vn3; ++ui;
    }
    PG_WAIT_V(0);
    if (wr == 0) PG_BAR;
    PG_BAR;
#undef PG_SA
#undef PG_SB
#undef PG_STA
#undef PG_STB
#undef PG_LDA
#undef PG_LDB
#undef PG_MMA
#undef PG_LO
#undef PG_HI
#undef PG_WAIT_V
#undef PG_WAIT_L
#undef PG_BAR
#undef PG_SCHED
}

template <class Epi, bool FP8_ = false> struct Dense {
    static constexpr bool PERM = Epi::PERM, FP8 = FP8_; static constexpr int KREP = 1;
    static constexpr unsigned ROWB = FP8_ ? 1024u : 2048u;
    const void* A; const void* Bt; int nM, nN, G, c; Epi E;
    __device__ __forceinline__ bool next(int i, Unit& u) const {
        const int nwg = nM * nN; const long L = (long)i * G + c; if (L >= nwg) return false;
        int wgid = (int)L; { const int q = nwg / NXCD, r = nwg % NXCD, xcd = wgid % NXCD, off = wgid / NXCD; wgid = (xcd < r ? xcd * (q + 1) : r * (q + 1) + (xcd - r) * q) + off; }
        const int nig = WGM * nN, gid = wgid / nig, fm = gid * WGM, gsz = (nM - fm) < WGM ? (nM - fm) : WGM;
        u.rt = fm + ((wgid % nig) % gsz); u.pn = (wgid % nig) / gsz; u.e = 0; u.ui = i; return true;
    }
    __device__ __forceinline__ void arows(const Unit& u, int R0, unsigned cofs, unsigned& v0, unsigned& v1, unsigned& v2, unsigned& v3) const {
        const unsigned base = (unsigned)(u.rt * 256 + R0) * ROWB + cofs; v0 = base; v1 = base + 64u * ROWB; v2 = base + 128u * ROWB; v3 = base + 192u * ROWB;
    }
    __device__ __forceinline__ const char* abase() const { return (const char*)A; }
    __device__ __forceinline__ void bptr(const Unit& u, const char*& b0, const char*& b1) const { b0 = (const char*)Bt + (size_t)u.pn * 256 * ROWB; b1 = b0 + (size_t)128 * ROWB; }
    __device__ __forceinline__ void epi(const f32x4 (&acc)[2][2][4][2], const Unit& u, int wr, int wc, int fr, int fq) const { E(acc, u, wr, wc, fr, fq); }
    __device__ __forceinline__ void binit(const Unit&, int, int, f32x4 (&bi)[2][2]) const { bi[0][0] = bi[0][1] = bi[1][0] = bi[1][1] = (f32x4){0.f, 0.f, 0.f, 0.f}; }
};

struct EpiBf16 {
    static constexpr bool PERM = true;
    bf16_t* O; float sc;
    __device__ __forceinline__ void operator()(const f32x4 (&acc)[2][2][4][2], const Unit& u, int wr, int wc, int fr, int fq) const {
        const int row0 = u.rt * 256 + wr * 64 + fr, col0 = u.pn * 256 + wc * 32 + 8 * fq;
#pragma unroll
        for (int ai = 0; ai < 2; ++ai)
#pragma unroll
            for (int m = 0; m < 4; ++m) { bf16_t* rowp = O + (size_t)(row0 + ai * 128 + m * 16) * 1024 + col0;
#pragma unroll
                for (int bj = 0; bj < 2; ++bj) { const f32x4 v0 = acc[ai][bj][m][0] * sc, v1 = acc[ai][bj][m][1] * sc;
                    u32x4 w; w.x = cvt_pk_bf16(v0[0], v0[1]); w.y = cvt_pk_bf16(v0[2], v0[3]); w.z = cvt_pk_bf16(v1[0], v1[1]); w.w = cvt_pk_bf16(v1[2], v1[3]);
                    *(u32x4*)(rowp + bj * 128) = w; } }
    }
};
struct EpiGlu {
    static constexpr bool PERM = true;
    const bf16_t* Z; bf16_t* O; float sc;
    __device__ __forceinline__ void operator()(const f32x4 (&acc)[2][2][4][2], const Unit& u, int wr, int wc, int fr, int fq) const {
        const int row0 = u.rt * 256 + wr * 64 + fr, col0 = u.pn * 256 + wc * 32 + 8 * fq;
#pragma unroll
        for (int ai = 0; ai < 2; ++ai)
#pragma unroll
            for (int m = 0; m < 4; ++m) { const size_t ro = (size_t)(row0 + ai * 128 + m * 16) * 1024 + col0;
#pragma unroll
                for (int bj = 0; bj < 2; ++bj) { const f32x4 v0 = acc[ai][bj][m][0] * sc, v1 = acc[ai][bj][m][1] * sc;
                    const u32x4 z = *(const u32x4*)(Z + ro + bj * 128);
                    u32x4 w;
                    w.x = cvt_pk_bf16(bf_lo(z.x) * sigmoidf_fast(v0[0]), bf_hi(z.x) * sigmoidf_fast(v0[1]));
                    w.y = cvt_pk_bf16(bf_lo(z.y) * sigmoidf_fast(v0[2]), bf_hi(z.y) * sigmoidf_fast(v0[3]));
                    w.z = cvt_pk_bf16(bf_lo(z.z) * sigmoidf_fast(v1[0]), bf_hi(z.z) * sigmoidf_fast(v1[1]));
                    w.w = cvt_pk_bf16(bf_lo(z.w) * sigmoidf_fast(v1[2]), bf_hi(z.w) * sigmoidf_fast(v1[3]));
                    *(u32x4*)(O + ro + bj * 128) = w; } }
    }
};
struct EpiResid {
    static constexpr bool PERM = false;
    const float* Xi; float* Xo; const float* gate0; const float* gate1; float sc;
    __device__ __forceinline__ void operator()(const f32x4 (&acc)[2][2][4][2], const Unit& u, int wr, int wc, int fr, int fq) const {
        const int row0 = u.rt * 256 + wr * 64 + fr, col0 = u.pn * 256 + wc * 32 + 4 * fq;
        const float* gate = (u.rt * 256 >= SEQ) ? gate1 : gate0;
        f32x4 gv[2][2];
#pragma unroll
        for (int bj = 0; bj < 2; ++bj)
#pragma unroll
            for (int n = 0; n < 2; ++n) gv[bj][n] = *(const f32x4*)(gate + col0 + bj * 128 + n * 16) * sc;
#pragma unroll
        for (int ai = 0; ai < 2; ++ai)
#pragma unroll
            for (int m = 0; m < 4; ++m) { const size_t ro = (size_t)(row0 + ai * 128 + m * 16) * 1024 + col0;
#pragma unroll
                for (int bj = 0; bj < 2; ++bj)
#pragma unroll
                    for (int n = 0; n < 2; ++n) { const f32x4 xi = *(const f32x4*)(Xi + ro + bj * 128 + n * 16); *(f32x4*)(Xo + ro + bj * 128 + n * 16) = xi + gv[bj][n] * acc[ai][bj][m][n]; } }
    }
};
struct EpiQkv {
    static constexpr bool PERM = true;
    bf16_t* Q; const float* cs; const float* sn; float sc; float* km;
    __device__ __forceinline__ void operator()(const f32x4 (&acc)[2][2][4][2], const Unit& u, int wr, int wc, int fr, int fq) const {
        const int sec = u.pn >> 2, row0 = u.rt * 256 + wr * 64 + fr, col0 = (u.pn & 3) * 256 + wc * 32 + 8 * fq, d0 = 16 * wc + 4 * fq;
        bf16_t* O = Q + (size_t)sec * T * DM;
        float ks[2][8];
#pragma unroll
        for (int bj = 0; bj < 2; ++bj)
#pragma unroll
            for (int j = 0; j < 8; ++j) ks[bj][j] = 0.f;
#pragma unroll
        for (int ai = 0; ai < 2; ++ai)
#pragma unroll
            for (int m = 0; m < 4; ++m) { const int row = row0 + ai * 128 + m * 16; bf16_t* rowp = O + (size_t)row * 1024 + col0;
                f32x4 c = {1.f, 1.f, 1.f, 1.f}, s = {0.f, 0.f, 0.f, 0.f};
                if (sec < 2) { c = *(const f32x4*)(cs + (size_t)row * 64 + d0); s = *(const f32x4*)(sn + (size_t)row * 64 + d0); }
#pragma unroll
                for (int bj = 0; bj < 2; ++bj) { const f32x4 v0 = acc[ai][bj][m][0] * sc, v1 = acc[ai][bj][m][1] * sc;
                    float r[8];
                    if (sec < 2) {
                        r[0] = v0[0] * c[0] - v0[1] * s[0]; r[1] = v0[1] * c[0] + v0[0] * s[0];
                        r[2] = v0[2] * c[1] - v0[3] * s[1]; r[3] = v0[3] * c[1] + v0[2] * s[1];
                        r[4] = v1[0] * c[2] - v1[1] * s[2]; r[5] = v1[1] * c[2] + v1[0] * s[2];
                        r[6] = v1[2] * c[3] - v1[3] * s[3]; r[7] = v1[3] * c[3] + v1[2] * s[3];
                    } else { r[0] = v0[0]; r[1] = v0[1]; r[2] = v0[2]; r[3] = v0[3]; r[4] = v1[0]; r[5] = v1[1]; r[6] = v1[2]; r[7] = v1[3]; }
                    if (sec == 1) {
#pragma unroll
                        for (int j = 0; j < 8; ++j) ks[bj][j] += r[j]; }
                    u32x4 w; w.x = cvt_pk_bf16(r[0], r[1]); w.y = cvt_pk_bf16(r[2], r[3]); w.z = cvt_pk_bf16(r[4], r[5]); w.w = cvt_pk_bf16(r[6], r[7]);
                    *(u32x4*)(rowp + bj * 128) = w; } }
        if (sec == 1) {
            const int b = (u.rt * 256) >> 13, n = (u.rt & 31);
#pragma unroll
            for (int bj = 0; bj < 2; ++bj) {
                const int h = (u.pn & 3) * 2 + bj;
#pragma unroll
                for (int j = 0; j < 8; ++j) ks[bj][j] = row16_sum(ks[bj][j]);
                if (fr == 0) { float* kp = km + ((size_t)(b * 8 + h) * 32 + n) * 128 + wc * 32 + 8 * fq;
#pragma unroll
                    for (int j = 0; j < 8; ++j) atomicAdd(kp + j, ks[bj][j] * (1.f / 256.f)); }
            }
        }
    }
};

constexpr int MOE_LDS_IDX = STAGE_BYTES;
constexpr int MOE_LDS_TILE_E = STAGE_BYTES + 12 * 1024;
constexpr int MOE_LDS_EBASE = MOE_LDS_TILE_E + 1280;
constexpr int MOE_LDS_ECNT = MOE_LDS_EBASE + 256;
struct MoeTabs { LAS int* idx; LAS int* tile_e; LAS int* ebase; LAS int* ecnt; int R; };
struct MoeGeo { int W, x, s, G, c; bool xcd; };
__device__ __forceinline__ MoeGeo moe_geo(int G, int c, int W) { MoeGeo g; g.xcd = (G == 256); g.W = W; g.x = c & 7; g.s = c >> 3; g.G = G; g.c = c; return g; }
template <int NPN>
__device__ __forceinline__ bool moe_unit(int i, const MoeGeo& g, int R, int& rt, int& pn) {
    if (g.xcd) {
        const int total = R * NPN, quota = (total + 7) >> 3, local = i * g.W + g.s, U = g.x * quota + local;
        rt = U / NPN; pn = U % NPN; return local < quota && U < total; }
    const long L = (long)i * g.G + g.c; rt = (int)(L / NPN); pn = (int)(L % NPN); return rt < R;
}
template <int NPN>
__device__ __forceinline__ MoeTabs moe_setup(const Frame& F, int layer, bool want_idx, const MoeGeo& geo) {
    MoeTabs M; M.idx = (LAS int*)(F.lds + MOE_LDS_IDX); M.tile_e = (LAS int*)(F.lds + MOE_LDS_TILE_E); M.ebase = (LAS int*)(F.lds + MOE_LDS_EBASE); M.ecnt = (LAS int*)(F.lds + MOE_LDS_ECNT);
    const unsigned* gcnt = (const unsigned*)(F.ws + ZB_MOECNT + layer * 256);
    if (F.tid < 64) {
        const int cnt = F.tid < 32 ? (int)gcnt[F.tid] : 0, nt = (cnt + 255) >> 8;
        int incl = nt;
#pragma unroll
        for (int o = 1; o < 32; o <<= 1) { const int y = __shfl_up(incl, o, 64); if (F.lane >= o) incl += y; }
        if (F.tid < 32) { M.ecnt[F.tid] = cnt; M.ebase[F.tid] = incl - nt; }
        if (F.tid == 31) M.ebase[32] = incl;
    }
    __syncthreads();
    M.R = M.ebase[32];
    if (F.tid < M.R) { int lo = 0, hi = 31;
        while (lo < hi) { const int mid = (lo + hi + 1) >> 1; if (M.ebase[mid] <= F.tid) lo = mid; else hi = mid - 1; }
        M.tile_e[F.tid] = lo; }
    __syncthreads();
    if (want_idx) {
        const int* vtok = (const int*)(F.ws + WS_VTOK);
        int tk[12];
#pragma unroll
        for (int i = 0; i < 12; ++i) { int rt, pn; tk[i] = 0;
            if (F.tid < 256 && moe_unit<NPN>(i, geo, M.R, rt, pn)) { const int e = M.tile_e[rt], v = (rt - M.ebase[e]) * 256 + F.tid; if (v < M.ecnt[e]) tk[i] = vtok[e * MOE_CAP + v]; } }
        if (F.tid < 256) {
#pragma unroll
            for (int i = 0; i < 12; ++i) M.idx[i * 256 + F.tid] = tk[i] >> 2; }
        __syncthreads();
    }
    return M;
}

template <int NPN>
__device__ __forceinline__ MoeTabs moe_setup(const Frame& F, int layer, bool want_idx, const MoeGeo& geo);
__device__ __forceinline__ MoeTabs moe_tabs_reuse(const Frame& F, int layer, const MoeGeo& geo) {
#if MK_MULTI
    return moe_setup<4>(F, layer, false, geo);
#endif
    MoeTabs M; M.idx = (LAS int*)(F.lds + MOE_LDS_IDX); M.tile_e = (LAS int*)(F.lds + MOE_LDS_TILE_E); M.ebase = (LAS int*)(F.lds + MOE_LDS_EBASE); M.ecnt = (LAS int*)(F.lds + MOE_LDS_ECNT);
    M.R = M.ebase[32]; return M;
}
struct MoeGateUp {
    static constexpr bool PERM = true, FP8 = true; static constexpr int KREP = MK_KREP;
    const unsigned char* A; const unsigned char* W; const float* bias; unsigned char* O; MoeTabs M; MoeGeo geo;
    __device__ __forceinline__ bool next(int i, Unit& u) const {
        if (!moe_unit<8>(i, geo, M.R, u.rt, u.pn)) return false;
        u.e = __builtin_amdgcn_readfirstlane(M.tile_e[u.rt]); u.ui = i; return true;
    }
    __device__ __forceinline__ void arows(const Unit& u, int R0, unsigned cofs, unsigned& v0, unsigned& v1, unsigned& v2, unsigned& v3) const {
        const LAS int* ip = M.idx + u.ui * 256 + R0;
        v0 = (unsigned)ip[0] * 1024u + cofs; v1 = (unsigned)ip[64] * 1024u + cofs; v2 = (unsigned)ip[128] * 1024u + cofs; v3 = (unsigned)ip[192] * 1024u + cofs;
    }
    __device__ __forceinline__ const char* abase() const { return (const char*)A; }
    __device__ __forceinline__ void bptr(const Unit& u, const char*& b0, const char*& b1) const {
        const unsigned char* w = W + (size_t)u.e * 2048 * KD; b0 = (const char*)(w + (size_t)(u.pn * 128) * KD); b1 = (const char*)(w + (size_t)(1024 + u.pn * 128) * KD);
    }
    __device__ __forceinline__ void binit(const Unit& u, int wc, int fq, f32x4 (&bi)[2][2]) const {
        const float* bp = bias + (size_t)u.e * 2048 + u.pn * 128 + wc * 32 + 8 * fq; constexpr float IS = FP8_WSCALE * MK_KREP;
        bi[0][0] = *(const f32x4*)bp * IS; bi[0][1] = *(const f32x4*)(bp + 4) * IS; bi[1][0] = *(const f32x4*)(bp + 1024) * IS; bi[1][1] = *(const f32x4*)(bp + 1028) * IS;
    }
    __device__ __forceinline__ void epi(const f32x4 (&acc)[2][2][4][2], const Unit& u, int wr, int wc, int fr, int fq) const {
        const int row0 = u.rt * 256 + wr * 64 + fr, col0 = u.pn * 128 + wc * 32 + 8 * fq;
        constexpr float SC = 1.f / (FP8_WSCALE * MK_KREP);
#pragma unroll
        for (int ai = 0; ai < 2; ++ai)
#pragma unroll
            for (int m = 0; m < 4; ++m) {
                unsigned wq[2];
#pragma unroll
                for (int n = 0; n < 2; ++n) {
                    f32x4 g = acc[ai][0][m][n] * SC, uu = acc[ai][1][m][n] * SC;
#pragma unroll
                    for (int j = 0; j < 4; ++j) { g[j] = fminf(g[j], 7.f); uu[j] = __builtin_amdgcn_fmed3f(uu[j], -7.f, 7.f); }
                    f32x4 t = g * (-1.702f * 1.4426950408889634f);
#pragma unroll
                    for (int j = 0; j < 4; ++j) t[j] = __builtin_amdgcn_exp2f(t[j]);
                    f32x4 d = t * (1.f / FP8_ASCALE) + (1.f / FP8_ASCALE);
#pragma unroll
                    for (int j = 0; j < 4; ++j) d[j] = __builtin_amdgcn_rcpf(d[j]);
                    const f32x4 o = (uu * g + g) * d;
                    wq[n] = pack_fp8x4_nc(o[0], o[1], o[2], o[3]);
                }
                u32x2 w; w.x = wq[0]; w.y = wq[1];
                *(u32x2*)(O + (size_t)(row0 + ai * 128 + m * 16) * 1024 + col0) = w;
            }
    }
};
struct MoeDown {
    static constexpr bool PERM = true, FP8 = true; static constexpr int KREP = MK_KREP;
    const unsigned char* A; const unsigned char* W; const float* bias; unsigned char* O; MoeTabs M; MoeGeo geo;
    __device__ __forceinline__ bool next(int i, Unit& u) const {
        if (!moe_unit<4>(i, geo, M.R, u.rt, u.pn)) return false;
        u.e = __builtin_amdgcn_readfirstlane(M.tile_e[u.rt]); u.ui = i; return true;
    }
    __device__ __forceinline__ void arows(const Unit& u, int R0, unsigned cofs, unsigned& v0, unsigned& v1, unsigned& v2, unsigned& v3) const {
        const unsigned base = (unsigned)(u.rt * 256 + R0) * 1024u + cofs; v0 = base; v1 = base + 64u * 1024u; v2 = base + 128u * 1024u; v3 = base + 192u * 1024u;
    }
    __device__ __forceinline__ const char* abase() const { return (const char*)A; }
    __device__ __forceinline__ void bptr(const Unit& u, const char*& b0, const char*& b1) const { b0 = (const char*)(W + (size_t)u.e * 1024 * KD + (size_t)u.pn * 256 * KD); b1 = b0 + (size_t)128 * KD; }
    __device__ __forceinline__ void binit(const Unit& u, int wc, int fq, f32x4 (&bi)[2][2]) const {
        const float* bp = bias + (size_t)u.e * 1024 + u.pn * 256 + wc * 32 + 8 * fq; constexpr float IS = FP8_WSCALE * FP8_ASCALE * MK_KREP;
#pragma unroll
        for (int bj = 0; bj < 2; ++bj) { bi[bj][0] = *(const f32x4*)(bp + bj * 128) * IS; bi[bj][1] = *(const f32x4*)(bp + bj * 128 + 4) * IS; }
    }
    __device__ __forceinline__ void epi(const f32x4 (&acc)[2][2][4][2], const Unit& u, int wr, int wc, int fr, int fq) const {
        const int row0 = u.rt * 256 + wr * 64 + fr, col0 = u.pn * 256 + wc * 32 + 8 * fq;
        constexpr float SC = FP8_YSCALE / (FP8_WSCALE * FP8_ASCALE * MK_KREP);
#pragma unroll
        for (int ai = 0; ai < 2; ++ai)
#pragma unroll
            for (int m = 0; m < 4; ++m) { unsigned char* rowp = O + (size_t)(row0 + ai * 128 + m * 16) * 1024 + col0;
#pragma unroll
                for (int bj = 0; bj < 2; ++bj) { f32x4 v0 = acc[ai][bj][m][0] * SC, v1 = acc[ai][bj][m][1] * SC;
#pragma unroll
                    for (int j = 0; j < 4; ++j) { v0[j] = __builtin_amdgcn_fmed3f(v0[j], -448.f, 448.f); v1[j] = __builtin_amdgcn_fmed3f(v1[j], -448.f, 448.f); }
                    u32x2 w; w.x = pack_fp8x4_nc(v0[0], v0[1], v0[2], v0[3]); w.y = pack_fp8x4_nc(v1[0], v1[1], v1[2], v1[3]);
                    *(u32x2*)(rowp + bj * 128) = w; } }
    }
};
}

template <int OFF> __device__ __forceinline__ s16x4 ds_tr_read(int vb) {
    s16x4 r; asm volatile("ds_read_b64_tr_b16 %0, %1 offset:%2" : "=&v"(r) : "v"(vb), "i"(OFF) : "memory"); return r;
}
constexpr int S5_PITCH = 136, S5_IMG = 128 * S5_PITCH;

template <bool FULL>
__device__ __forceinline__ void phase_s5(const Frame& F, const bf16_t* __restrict__ U, bf16_t* __restrict__ Z, unsigned char* __restrict__ Z8) {
    const int lane = F.lane, n = lane & 31, h = lane >> 5;
    const float* tab = (const float*)(F.ws + WS_S5A);
    const bf16_t* bop = (const bf16_t*)(F.ws + WS_BOP); const bf16_t* cop = (const bf16_t*)(F.ws + WS_COP);
    float* carry = (float*)(F.ws + WS_CARRY);
    const float* dsk = F.in[L0_D];
    LAS unsigned char* xt = F.lds + F.wave * S5_IMG;
    for (int w = F.c; w < 2048; w += F.G) {
        const int g = (w & 7) * 8 + F.wave, chunk = (w >> 3) & 127, b = w >> 10;
        const int tok0 = b * SEQ + chunk * 64;
        bf16x8 Aop[2], Bop[4];
#pragma unroll
        for (int mt = 0; mt < 2; ++mt) { const int time = 32 * ((n >> 2) & 1) + 16 * mt + 4 * (n >> 3) + (n & 3);
            Aop[mt] = *(const bf16x8*)(U + (size_t)(tok0 + time) * DM + g * 16 + 8 * h); }
#pragma unroll
        for (int nt = 0; nt < 4; ++nt) Bop[nt] = *(const bf16x8*)(bop + (size_t)((g * 128 + nt * 32 + n) * 16 + 8 * h));
        f32x16 acc[2][4];
#pragma unroll
        for (int mt = 0; mt < 2; ++mt)
#pragma unroll
            for (int nt = 0; nt < 4; ++nt) { f32x16 z = {}; acc[mt][nt] = __builtin_amdgcn_mfma_f32_32x32x16_bf16(Aop[mt], Bop[nt], z, 0, 0, 0); }
        const float a0r = tab[g * 64 + n], a0i = tab[4096 + g * 64 + n], a1r = tab[g * 64 + 32 + n], a1i = tab[4096 + g * 64 + 32 + n];
        float* cp = carry + ((size_t)(b * 256 + chunk * 2 + h) * 64 + g) * 128;
        float x0r = 0.f, x0i = 0.f, x1r = 0.f, x1i = 0.f;
        if (FULL) { x0r = cp[n]; x0i = cp[64 + n]; x1r = cp[32 + n]; x1i = cp[96 + n]; }
#pragma unroll
        for (int mt = 0; mt < 2; ++mt)
#pragma unroll
            for (int r = 0; r < 16; ++r) {
                const float n0r = fmaf(a0r, x0r, fmaf(-a0i, x0i, acc[mt][0][r])), n0i = fmaf(a0r, x0i, fmaf(a0i, x0r, acc[mt][2][r]));
                const float n1r = fmaf(a1r, x1r, fmaf(-a1i, x1i, acc[mt][1][r])), n1i = fmaf(a1r, x1i, fmaf(a1i, x1r, acc[mt][3][r]));
                x0r = n0r; x0i = n0i; x1r = n1r; x1i = n1i;
                acc[mt][0][r] = x0r; acc[mt][2][r] = x0i; acc[mt][1][r] = x1r; acc[mt][3][r] = x1i;
            }
        if (!FULL) { cp[n] = x0r; cp[64 + n] = x0i; cp[32 + n] = x1r; cp[96 + n] = x1i; continue; }
#pragma unroll
        for (int mt = 0; mt < 2; ++mt)
#pragma unroll
            for (int nt = 0; nt < 4; ++nt)
#pragma unroll
                for (int q = 0; q < 4; ++q) {
                    u32x2 pk; pk.x = cvt_pk_bf16(acc[mt][nt][4 * q + 0], acc[mt][nt][4 * q + 1]); pk.y = cvt_pk_bf16(acc[mt][nt][4 * q + 2], acc[mt][nt][4 * q + 3]);
                    *(LAS u32x2*)(xt + (nt * 32 + n) * S5_PITCH + (32 * h + 16 * mt + 4 * q) * 2) = pk;
                }
        const int ch = lane & 15, kg = lane >> 4;
        bf16x8 Cf[4];
#pragma unroll
        for (int ks = 0; ks < 4; ++ks) Cf[ks] = *(const bf16x8*)(cop + (size_t)((g * 16 + ch) * 128 + 32 * ks + 8 * kg));
        const int trb = (int)(uintptr_t)xt + (8 * kg + (ch >> 2)) * S5_PITCH + (4 * (ch & 3)) * 2;
        f32x4 y[4];
#pragma unroll
        for (int tb = 0; tb < 4; ++tb) y[tb] = (f32x4){0.f, 0.f, 0.f, 0.f};
        asm volatile("s_waitcnt lgkmcnt(0)" ::: "memory");
#define S5_TR(tb, ks, hi4) ds_tr_read<(32 * (ks) + 4 * (hi4)) * S5_PITCH + 32 * (tb)>(trb)
#define S5_STEP(tb, ks) do { const s16x4 lo = S5_TR(tb, ks, 0), hi = S5_TR(tb, ks, 1); asm volatile("s_waitcnt lgkmcnt(0)" ::: "memory"); __builtin_amdgcn_sched_barrier(0); \
            const bf16x8 bf = (bf16x8){lo[0], lo[1], lo[2], lo[3], hi[0], hi[1], hi[2], hi[3]}; y[tb] = __builtin_amdgcn_mfma_f32_16x16x32_bf16(Cf[ks], bf, y[tb], 0, 0, 0); } while (0)
        S5_STEP(0, 0); S5_STEP(0, 1); S5_STEP(0, 2); S5_STEP(0, 3);
        S5_STEP(1, 0); S5_STEP(1, 1); S5_STEP(1, 2); S5_STEP(1, 3);
        S5_STEP(2, 0); S5_STEP(2, 1); S5_STEP(2, 2); S5_STEP(2, 3);
        S5_STEP(3, 0); S5_STEP(3, 1); S5_STEP(3, 2); S5_STEP(3, 3);
#undef S5_STEP
#undef S5_TR
        const f32x4 dv = *(const f32x4*)(dsk + g * 16 + 4 * kg);
#pragma unroll
        for (int tb = 0; tb < 4; ++tb) {
            const size_t o = (size_t)(tok0 + 16 * tb + ch) * DM + g * 16 + 4 * kg;
            const u32x2 uu = *(const u32x2*)(U + o);
            const float y0 = y[tb][0] + dv[0] * bf_lo(uu.x), y1 = y[tb][1] + dv[1] * bf_hi(uu.x), y2 = y[tb][2] + dv[2] * bf_lo(uu.y), y3 = y[tb][3] + dv[3] * bf_hi(uu.y);
            const float z0 = gelu_tanh(y0), z1 = gelu_tanh(y1), z2 = gelu_tanh(y2), z3 = gelu_tanh(y3);
            u32x2 zz; zz.x = cvt_pk_bf16(z0, z1); zz.y = cvt_pk_bf16(z2, z3);
            *(u32x2*)(Z + o) = zz;
            *(unsigned*)(Z8 + o) = pack_fp8x4(z0, z1, z2, z3);
        }
    }
}

__device__ __forceinline__ void phase_s5_carry(const Frame& F) {
    const float* tab = (const float*)(F.ws + WS_S5A);
    float* carry = (float*)(F.ws + WS_CARRY);
    LAS float* E = (LAS float*)F.lds;
    for (int pair = F.c; pair < 128; pair += F.G) {
        const int b = pair >> 6, g = pair & 63, p = F.lane, w = F.wave;
        const float ar = tab[8192 + g * 64 + p], ai = tab[12288 + g * 64 + p];
        float* ptr = carry + ((size_t)(b * 256 + 32 * w) * 64 + g) * 128 + p;
        float cr[32], ci[32];
#pragma unroll
        for (int j = 0; j < 32; ++j) { cr[j] = ptr[(size_t)j * 8192]; ci[j] = ptr[(size_t)j * 8192 + 64]; }
        float xr = 0.f, xi = 0.f;
#pragma unroll
        for (int j = 0; j < 32; ++j) { const float nr = fmaf(ar, xr, fmaf(-ai, xi, cr[j])), ni = fmaf(ar, xi, fmaf(ai, xr, ci[j])); xr = nr; xi = ni; }
        E[(w * 2 + 0) * 64 + p] = xr; E[(w * 2 + 1) * 64 + p] = xi;
        float sr = ar, si = ai;
#pragma unroll
        for (int q = 0; q < 5; ++q) { const float nr = sr * sr - si * si, ni = 2.f * sr * si; sr = nr; si = ni; }
        __syncthreads();
        xr = 0.f; xi = 0.f;
        for (int v = 0; v < w; ++v) { const float er = E[(v * 2 + 0) * 64 + p], ei = E[(v * 2 + 1) * 64 + p];
            const float nr = fmaf(sr, xr, fmaf(-si, xi, er)), ni = fmaf(sr, xi, fmaf(si, xr, ei)); xr = nr; xi = ni; }
#pragma unroll
        for (int j = 0; j < 32; ++j) {
            ptr[(size_t)j * 8192] = xr; ptr[(size_t)j * 8192 + 64] = xi;
            const float nr = fmaf(ar, xr, fmaf(-ai, xi, cr[j])), ni = fmaf(ar, xi, fmaf(ai, xr, ci[j])); xr = nr; xi = ni;
        }
        __syncthreads();
    }
}

template <bool FINAL, class XT>
__device__ __forceinline__ void phase_moe_combine(const Frame& F, int layer, const XT* xold, const bf16_t* mres, bf16_t* xnew, const float* gamma_next, unsigned char* hnext, float* outp) {
    LAS int* ebase = (LAS int*)F.lds;
    const unsigned* gcnt = (const unsigned*)(F.ws + ZB_MOECNT + layer * 256);
    if (F.tid < 64) {
        const int nt = F.tid < 32 ? (((int)gcnt[F.tid] + 255) >> 8) : 0;
        int incl = nt;
#pragma unroll
        for (int o = 1; o < 32; o <<= 1) { const int y = __shfl_up(incl, o, 64); if (F.lane >= o) incl += y; }
        if (F.tid < 32) ebase[F.tid] = incl - nt;
    }
    __syncthreads();
    const int* pos = (const int*)(F.ws + WS_TOPK); const float* gates = (const float*)(F.ws + WS_TOPK + (size_t)T * 4 * 4);
    const unsigned char* yk = F.ws + WS_YK;
    const int lane = F.lane;
    for (int r0 = F.c * 8 + F.wave; r0 < T; r0 += F.G * 16) {
        const int r1 = (r0 + F.G * 8 < T) ? r0 + F.G * 8 : r0;
        u32x4 pp[2]; f32x4 gg[2];
        pp[0] = *(const u32x4*)(pos + (size_t)r0 * 4); pp[1] = *(const u32x4*)(pos + (size_t)r1 * 4);
        gg[0] = *(const f32x4*)(gates + (size_t)r0 * 4); gg[1] = *(const f32x4*)(gates + (size_t)r1 * 4);
        f32x4 xo[2][4]; u32x2 yv[2][4][2]; u32x4 mv[2][2];
#pragma unroll
        for (int q = 0; q < 2; ++q) { const int r = q ? r1 : r0;
#pragma unroll
            for (int i = 0; i < 2; ++i) { mv[q][i] = *(const u32x4*)(mres + (size_t)r * DM + 512 * i + 8 * lane);
#pragma unroll
                for (int h = 0; h < 2; ++h) xo[q][2 * i + h] = load_x4(xold + (size_t)r * DM + 512 * i + 8 * lane + 4 * h); }
#pragma unroll
            for (int k = 0; k < 4; ++k) { const int pk = (int)pp[q][k], e = pk >> 14, v = pk & 16383; const size_t phys = (size_t)ebase[e] * 256 + v;
#pragma unroll
                for (int i = 0; i < 2; ++i) yv[q][k][i] = *(const u32x2*)(yk + phys * 1024 + 512 * i + 8 * lane); } }
#pragma unroll
        for (int q = 0; q < 2; ++q) {
            const int r = q ? r1 : r0, b = r >> 13;
            const float* g2 = ada_vec(F, layer, b, 5);
            { const float* g1 = ada_vec(F, layer, b, 2);
#pragma unroll
              for (int i = 0; i < 2; ++i) { const f32x4 ga = *(const f32x4*)(g1 + 512 * i + 8 * lane), gb = *(const f32x4*)(g1 + 512 * i + 8 * lane + 4); const u32x4 m = mv[q][i];
                xo[q][2 * i][0] = fmaf(ga[0], bf_lo(m.x), xo[q][2 * i][0]); xo[q][2 * i][1] = fmaf(ga[1], bf_hi(m.x), xo[q][2 * i][1]);
                xo[q][2 * i][2] = fmaf(ga[2], bf_lo(m.y), xo[q][2 * i][2]); xo[q][2 * i][3] = fmaf(ga[3], bf_hi(m.y), xo[q][2 * i][3]);
                xo[q][2 * i + 1][0] = fmaf(gb[0], bf_lo(m.z), xo[q][2 * i + 1][0]); xo[q][2 * i + 1][1] = fmaf(gb[1], bf_hi(m.z), xo[q][2 * i + 1][1]);
                xo[q][2 * i + 1][2] = fmaf(gb[2], bf_lo(m.w), xo[q][2 * i + 1][2]); xo[q][2 * i + 1][3] = fmaf(gb[3], bf_hi(m.w), xo[q][2 * i + 1][3]); } }
            float acc[16];
#pragma unroll
            for (int j = 0; j < 16; ++j) acc[j] = 0.f;
#pragma unroll
            for (int k = 0; k < 4; ++k) { const float gk = gg[q][k] * (1.f / FP8_YSCALE);
#pragma unroll
                for (int i = 0; i < 2; ++i) { const u32x2 w = yv[q][k][i];
                    const f32x2 p0 = __builtin_amdgcn_cvt_pk_f32_fp8((int)w.x, false), p1 = __builtin_amdgcn_cvt_pk_f32_fp8((int)w.x, true);
                    const f32x2 p2 = __builtin_amdgcn_cvt_pk_f32_fp8((int)w.y, false), p3 = __builtin_amdgcn_cvt_pk_f32_fp8((int)w.y, true);
                    acc[8 * i + 0] = fmaf(gk, p0[0], acc[8 * i + 0]); acc[8 * i + 1] = fmaf(gk, p0[1], acc[8 * i + 1]);
                    acc[8 * i + 2] = fmaf(gk, p1[0], acc[8 * i + 2]); acc[8 * i + 3] = fmaf(gk, p1[1], acc[8 * i + 3]);
                    acc[8 * i + 4] = fmaf(gk, p2[0], acc[8 * i + 4]); acc[8 * i + 5] = fmaf(gk, p2[1], acc[8 * i + 5]);
                    acc[8 * i + 6] = fmaf(gk, p3[0], acc[8 * i + 6]); acc[8 * i + 7] = fmaf(gk, p3[1], acc[8 * i + 7]); } }
            float xn[16]; float ss = 0.f;
#pragma unroll
            for (int i = 0; i < 2; ++i)
#pragma unroll
                for (int h = 0; h < 2; ++h) { const int col = 512 * i + 8 * lane + 4 * h;
                    const f32x4 gv = *(const f32x4*)(g2 + col);
                    f32x4 xv;
#pragma unroll
                    for (int j = 0; j < 4; ++j) { xv[j] = xo[q][2 * i + h][j] + gv[j] * acc[8 * i + 4 * h + j]; xn[8 * i + 4 * h + j] = xv[j]; ss += xv[j] * xv[j]; }
                    if (!FINAL) { u32x2 xw; xw.x = cvt_pk_bf16(xv[0], xv[1]); xw.y = cvt_pk_bf16(xv[2], xv[3]); *(u32x2*)(xnew + (size_t)r * DM + col) = xw; } }
            ss = wave_sum(ss);
            const float rs = rsqrtf(ss * (1.f / 1024.f) + 1e-6f);
            if (FINAL) {
#pragma unroll
                for (int i = 0; i < 2; ++i)
#pragma unroll
                    for (int h = 0; h < 2; ++h) { const int col = 512 * i + 8 * lane + 4 * h; const f32x4 g = *(const f32x4*)(gamma_next + col);
                        f32x4 o;
#pragma unroll
                        for (int j = 0; j < 4; ++j) o[j] = xn[8 * i + 4 * h + j] * rs * g[j];
                        *(f32x4*)(outp + (size_t)r * DM + col) = o; }
            } else {
                const float* sh = ada_vec(F, layer + 1, b, 0); const float* sc = ada_vec(F, layer + 1, b, 1);
#pragma unroll
                for (int i = 0; i < 2; ++i) { const int col = 512 * i + 8 * lane;
                    float yv8[8];
#pragma unroll
                    for (int h = 0; h < 2; ++h) { const f32x4 g = *(const f32x4*)(gamma_next + col + 4 * h), s1 = *(const f32x4*)(sc + col + 4 * h), s0 = *(const f32x4*)(sh + col + 4 * h);
#pragma unroll
                        for (int j = 0; j < 4; ++j) yv8[4 * h + j] = xn[8 * i + 4 * h + j] * rs * g[j] * (1.f + s1[j]) + s0[j]; }
                    u32x2 w; w.x = pack_fp8x4(yv8[0], yv8[1], yv8[2], yv8[3]); w.y = pack_fp8x4(yv8[4], yv8[5], yv8[6], yv8[7]);
                    *(u32x2*)(hnext + (size_t)r * DM + col) = w; }
            }
        }
    }
    __syncthreads();
}

__device__ __forceinline__ void phase_kmean(const Frame& F, const bf16_t* __restrict__ K) {
    LAS float* red = (LAS float*)F.lds;
    float* km = (float*)(F.ws + WS_KMEAN);
    for (int u = F.c; u < 512; u += F.G) {
        const int h = u & 7, n = (u >> 3) & 31, b = u >> 8;
        const int colc = F.tid & 15, rg = F.tid >> 4;
        const bf16_t* base = K + ((size_t)(b * SEQ + n * 256 + rg * 8)) * DM + h * 128 + colc * 8;
        float acc[8];
#pragma unroll
        for (int j = 0; j < 8; ++j) acc[j] = 0.f;
#pragma unroll
        for (int r = 0; r < 8; ++r) { const u32x4 w = *(const u32x4*)(base + (size_t)r * DM);
            acc[0] += bf_lo(w.x); acc[1] += bf_hi(w.x); acc[2] += bf_lo(w.y); acc[3] += bf_hi(w.y); acc[4] += bf_lo(w.z); acc[5] += bf_hi(w.z); acc[6] += bf_lo(w.w); acc[7] += bf_hi(w.w); }
#pragma unroll
        for (int j = 0; j < 8; ++j) red[rg * 128 + colc * 8 + j] = acc[j];
        __syncthreads();
        if (F.tid < 128) { float s = 0.f;
#pragma unroll
            for (int q = 0; q < 32; ++q) s += red[q * 128 + F.tid];
            km[((size_t)(b * 8 + h) * 32 + n) * 128 + F.tid] = s * (1.f / 256.f); }
        __syncthreads();
    }
}

__device__ __forceinline__ int alist_base(int n) { return 256 * (31 * n - (n * (n - 1)) / 2); }

__device__ __forceinline__ void phase_gating(const Frame& F, const bf16_t* __restrict__ Q) {
    LAS float* kml = (LAS float*)F.lds;
    LAS int* cntl = (LAS int*)(F.lds + 16384); LAS int* basel = cntl + 32; LAS int* entl = cntl + 64;
    const float* km = (const float*)(F.ws + WS_KMEAN);
    unsigned* gcnt = (unsigned*)(F.ws + ZB_ATTCNT);
    int* alist = (int*)(F.ws + WS_ALIST);
    for (int u = F.c; u < 256; u += F.G) {
        const int jp = u & 15, h = (u >> 4) & 7, b = u >> 7, bh = b * 8 + h;
        for (int i = F.tid; i < 4096; i += NTHREADS) kml[i] = km[(size_t)bh * 4096 + i];
        if (F.tid < 32) cntl[F.tid] = 0;
        __syncthreads();
        const int s = jp * 512 + F.tid, j = __builtin_amdgcn_readfirstlane(s >> 8);
        u32x4 q[16];
        { const bf16_t* qp = Q + (size_t)(b * SEQ + s) * DM + h * 128;
#pragma unroll
          for (int i = 0; i < 16; ++i) q[i] = *(const u32x4*)(qp + 8 * i); }
        float v0 = -INFINITY, v1 = -INFINITY, v2 = -INFINITY; int i0 = 0, i1 = 0, i2 = 0;
#pragma unroll 1
        for (int n = 0; n < j; ++n) {
            float d = 0.f;
#pragma unroll
            for (int i = 0; i < 16; ++i) { const f32x4 ka = *(const LAS f32x4*)(kml + n * 128 + 8 * i), kb = *(const LAS f32x4*)(kml + n * 128 + 8 * i + 4);
                d = fmaf(bf_lo(q[i].x), ka[0], d); d = fmaf(bf_hi(q[i].x), ka[1], d); d = fmaf(bf_lo(q[i].y), ka[2], d); d = fmaf(bf_hi(q[i].y), ka[3], d);
                d = fmaf(bf_lo(q[i].z), kb[0], d); d = fmaf(bf_hi(q[i].z), kb[1], d); d = fmaf(bf_lo(q[i].w), kb[2], d); d = fmaf(bf_hi(q[i].w), kb[3], d); }
            if (d > v0) { v2 = v1; i2 = i1; v1 = v0; i1 = i0; v0 = d; i0 = n; }
            else if (d > v1) { v2 = v1; i2 = i1; v1 = d; i1 = n; }
            else if (d > v2) { v2 = d; i2 = n; }
        }
        const int nsel = j < 3 ? j : 3;
        if (nsel > 0) entl[F.tid * 3 + 0] = (i0 << 16) | __hip_atomic_fetch_add(&cntl[i0], 1, __ATOMIC_RELAXED, __HIP_MEMORY_SCOPE_WORKGROUP);
        if (nsel > 1) entl[F.tid * 3 + 1] = (i1 << 16) | __hip_atomic_fetch_add(&cntl[i1], 1, __ATOMIC_RELAXED, __HIP_MEMORY_SCOPE_WORKGROUP);
        if (nsel > 2) entl[F.tid * 3 + 2] = (i2 << 16) | __hip_atomic_fetch_add(&cntl[i2], 1, __ATOMIC_RELAXED, __HIP_MEMORY_SCOPE_WORKGROUP);
        __syncthreads();
        if (F.tid < 32) basel[F.tid] = cntl[F.tid] ? (int)atomicAdd(&gcnt[bh * 32 + F.tid], (unsigned)cntl[F.tid]) : 0;
        __syncthreads();
#pragma unroll
        for (int k = 0; k < 3; ++k) if (k < nsel) { const int en = entl[F.tid * 3 + k], n = en >> 16, v = basel[n] + (en & 0xffff);
            alist[(size_t)bh * ALIST_PER_BH + alist_base(n) + v] = s | (k << 16); }
        __syncthreads();
    }
}

namespace at {
constexpr int D = 128, NW = 8, QBLK = 32, KVBLK = 64, LDK = 1024, NT = 4;
constexpr float SCALE = 0.088388347648318440f, THR = 8.f, CL2 = SCALE * 1.4426950408889634f;
constexpr int SHM_V = KVBLK * D * 2, SHM_K = KVBLK * D * 2, SHM_WS = NW * 8704  , SHM_ATTN = SHM_WS + NW * 96 * 4;
constexpr int LDS_PRE = 73728;
#define KSWZ(row, colB) ((row) * 256 + ((colB) ^ (((row) & 7) << 4)))
#define SBAR() __builtin_amdgcn_sched_barrier(0)
__device__ __forceinline__ int crow(int r, int hi) { return (r & 3) + 8 * (r >> 2) + 4 * hi; }
__device__ __forceinline__ void partialSM(f32x16& p0, f32x16& p1, float& m_reg, float& mn, float& alpha) {
    float pmax = p0[0];
#pragma unroll
    for (int r = 1; r < 16; ++r) pmax = fmaxf(pmax, p0[r]);
#pragma unroll
    for (int r = 0; r < 16; ++r) pmax = fmaxf(pmax, p1[r]);
    { auto rr = __builtin_amdgcn_permlane32_swap(__float_as_uint(pmax), __float_as_uint(pmax), false, false);
      pmax = fmaxf(__uint_as_float(rr[0]), __uint_as_float(rr[1])); }
    if (__builtin_expect(__all(pmax - m_reg <= THR / SCALE), 1)) { mn = m_reg; alpha = 1.f; }
    else { mn = fmaxf(m_reg, pmax); alpha = __builtin_amdgcn_exp2f((m_reg - mn) * CL2); m_reg = mn; }
    const float mnC = -mn * CL2;
#pragma unroll
    for (int r = 0; r < 16; ++r) p0[r] = fmaf(p0[r], CL2, mnC);
#pragma unroll
    for (int r = 0; r < 16; ++r) p1[r] = fmaf(p1[r], CL2, mnC);
#pragma unroll
    for (int r = 0; r < 16; ++r) p0[r] = __builtin_amdgcn_exp2f(p0[r]);
}
__device__ __forceinline__ void finishSM(f32x16& p0, f32x16& p1, float alpha, float& l_reg, bf16x8& pa0, bf16x8& pa1, bf16x8& pa2, bf16x8& pa3) {
#pragma unroll
    for (int r = 0; r < 16; ++r) p1[r] = __builtin_amdgcn_exp2f(p1[r]);
    float ps = 0;
#pragma unroll
    for (int r = 0; r < 16; ++r) ps += p0[r];
#pragma unroll
    for (int r = 0; r < 16; ++r) ps += p1[r];
    { auto rr = __builtin_amdgcn_permlane32_swap(__float_as_uint(ps), __float_as_uint(ps), false, false);
      ps = __uint_as_float(rr[0]) + __uint_as_float(rr[1]); }
    l_reg = l_reg * alpha + ps;
#define PK4(P, BASE, OUT) do { unsigned a0 = cvt_pk_bf16(P[BASE + 0], P[BASE + 1]), a1 = cvt_pk_bf16(P[BASE + 2], P[BASE + 3]);   \
    unsigned b0 = cvt_pk_bf16(P[BASE + 4], P[BASE + 5]), b1 = cvt_pk_bf16(P[BASE + 6], P[BASE + 7]);                              \
    auto r0 = __builtin_amdgcn_permlane32_swap(a0, b0, false, false); auto r1 = __builtin_amdgcn_permlane32_swap(a1, b1, false, false); \
    u32x4 w = {r0[0], r1[0], r0[1], r1[1]}; OUT = *reinterpret_cast<bf16x8*>(&w); } while (0)
    PK4(p0, 0, pa0); PK4(p0, 8, pa1); PK4(p1, 0, pa2); PK4(p1, 8, pa3);
#undef PK4
}
__device__ __forceinline__ void qkt(f32x16& p0, f32x16& p1, const char* Ks, const bf16x8* qr, int r32, int hi) {
    p0 = f32x16{}; p1 = f32x16{};
#pragma unroll
    for (int d0 = 0; d0 < 8; ++d0) { const int cb = (d0 * 16 + hi * 8) * 2;
        const bf16x8 b0 = *reinterpret_cast<const bf16x8*>(Ks + KSWZ(r32, cb));
        const bf16x8 b1 = *reinterpret_cast<const bf16x8*>(Ks + KSWZ(32 + r32, cb));
        p0 = __builtin_amdgcn_mfma_f32_32x32x16_bf16(b0, qr[d0], p0, 0, 0, 0);
        p1 = __builtin_amdgcn_mfma_f32_32x32x16_bf16(b1, qr[d0], p1, 0, 0, 0); }
}
__device__ __forceinline__ void causal_mask(f32x16& p0, f32x16& p1, int kt, int qrow, int hi) {
#pragma unroll
    for (int r = 0; r < 16; ++r) { const int key = kt * 64 + crow(r, hi); if (key > qrow) p0[r] = -1e30f; if (key + 32 > qrow) p1[r] = -1e30f; }
}
__device__ __forceinline__ int v_st(int k, int c) { const int kk = (k & ~0xC) | ((k & 4) << 1) | ((k & 8) >> 1); return ((kk >> 3) * 4 + (c >> 5)) * 512 + ((kk & 7) * 32 + (c & 31)) * 2; }
__device__ __forceinline__ int v_rd_base(int lane) { return ((lane & 3) << 3) | (((lane >> 2) & 3) << 6) | (((lane >> 4) & 1) << 5) | (((lane >> 5) & 1) << 8); }
constexpr int v_rd_off(int d0, int ks, int half) { return d0 * 512 + ks * 4096 + half * 2048; }
template <int D0> __device__ __forceinline__ void pv_one(f32x16& od, int vb, bf16x8 pa0, bf16x8 pa1, bf16x8 pa2, bf16x8 pa3) {
    const s16x4 l0 = ds_tr_read<v_rd_off(D0, 0, 0)>(vb), h0 = ds_tr_read<v_rd_off(D0, 0, 1)>(vb), l1 = ds_tr_read<v_rd_off(D0, 1, 0)>(vb), h1 = ds_tr_read<v_rd_off(D0, 1, 1)>(vb);
    const s16x4 l2 = ds_tr_read<v_rd_off(D0, 2, 0)>(vb), h2 = ds_tr_read<v_rd_off(D0, 2, 1)>(vb), l3 = ds_tr_read<v_rd_off(D0, 3, 0)>(vb), h3 = ds_tr_read<v_rd_off(D0, 3, 1)>(vb);
    asm volatile("s_waitcnt lgkmcnt(0)" ::: "memory"); SBAR();
#define PK(L, H) (bf16x8){L[0], L[1], L[2], L[3], H[0], H[1], H[2], H[3]}
    od = __builtin_amdgcn_mfma_f32_32x32x16_bf16(pa0, PK(l0, h0), od, 0, 0, 0);
    od = __builtin_amdgcn_mfma_f32_32x32x16_bf16(pa1, PK(l1, h1), od, 0, 0, 0);
    od = __builtin_amdgcn_mfma_f32_32x32x16_bf16(pa2, PK(l2, h2), od, 0, 0, 0);
    od = __builtin_amdgcn_mfma_f32_32x32x16_bf16(pa3, PK(l3, h3), od, 0, 0, 0);
#undef PK
}
__device__ __forceinline__ void pv_d0(f32x16* o, int vb, bf16x8 pa0, bf16x8 pa1, bf16x8 pa2, bf16x8 pa3) {
    pv_one<0>(o[0], vb, pa0, pa1, pa2, pa3); pv_one<1>(o[1], vb, pa0, pa1, pa2, pa3); pv_one<2>(o[2], vb, pa0, pa1, pa2, pa3); pv_one<3>(o[3], vb, pa0, pa1, pa2, pa3);
}

struct AUnit { unsigned qoff; unsigned kv; int dst; bool causal; };
__device__ __forceinline__ bool attn_decode(int u, int total, const bf16_t* Q, const int* alist, const LAS int* pre, const LAS int* cntl, int wid, int r32, AUnit& D) {
    if (u >= total) return false;
    int bh, n;
    if (u < 512) {
        bh = u >> 5; n = u & 31; D.causal = true;
        const int b = bh >> 3, h = bh & 7, s = n * 256 + wid * 32 + r32; const size_t t = (size_t)b * SEQ + s;
        D.qoff = (unsigned)(t * DM + h * 128); D.dst = (int)((t * 8 + h) * 4 + 3);
    } else {
        const int ut = u - 512; int lo = 0, hi_ = 511;
        while (lo < hi_) { const int mid = (lo + hi_ + 1) >> 1; if (pre[mid] <= ut) lo = mid; else hi_ = mid - 1; }
        bh = lo >> 5; n = lo & 31; D.causal = false;
        const int tile = ut - pre[lo], cntv = cntl[lo], idx = tile * 256 + wid * 32 + r32;
        const int b = bh >> 3, h = bh & 7;
        const int en = alist[(size_t)bh * ALIST_PER_BH + alist_base(n) + (idx < cntv ? idx : cntv - 1)];
        const int s = en & 0xffff, k = en >> 16; const size_t t = (size_t)b * SEQ + s;
        D.qoff = (unsigned)(t * DM + h * 128); D.dst = idx < cntv ? (int)((t * 8 + h) * 4 + k) : -1;
    }
    D.kv = (unsigned)(((size_t)(bh >> 3) * SEQ + n * 256) * DM + (bh & 7) * 128);
    return true;
}

__device__ __forceinline__ void attn_stream(const bf16_t* __restrict__ Q, const bf16_t* __restrict__ K, const bf16_t* __restrict__ V, const int* __restrict__ alist,
                                            const LAS int* pre, const LAS int* cntl, int total, int c, int G,
                                            unsigned char* __restrict__ part, float* __restrict__ lse, char* lds) {
    const int tid = threadIdx.x, wid = tid >> 6, lane = tid & 63, r32 = lane & 31, hi = lane >> 5;
    char* V_lds = lds; char* K_lds = lds + 2 * SHM_V;
    float* wsl = (float*)(lds + SHM_WS) + wid * 96; float* li_l = wsl; float* al_l = wsl + 32; int* dst_l = (int*)(wsl + 64);
#define TZ() ({ int _t = threadIdx.x; asm volatile("" : "+v"(_t)); _t; })
#define qrow_i ((TZ() >> 6) * 32 + (TZ() & 31))
#define vb0 ((int)(uintptr_t)V_lds + v_rd_base(TZ() & 63))
    struct { bf16x8 vs0, vs1, ks0, ks1; } sr_[2];
#define SLOAD(i, KP, VP, k0) do { const int _tz = TZ(), sr = _tz >> 4, sc = (_tz & 15) * 8; sr_[i].vs0 = *(const bf16x8*)(&(VP)[(long)((k0) + sr) * LDK + sc]); sr_[i].vs1 = *(const bf16x8*)(&(VP)[(long)((k0) + 32 + sr) * LDK + sc]); \
    sr_[i].ks0 = *(const bf16x8*)(&(KP)[(long)((k0) + sr) * LDK + sc]); sr_[i].ks1 = *(const bf16x8*)(&(KP)[(long)((k0) + 32 + sr) * LDK + sc]); } while (0)
#define SWRITE(b, i) do { const int _tz = TZ(), sr = _tz >> 4, sc = (_tz & 15) * 8, vst0 = v_st(sr, sc), vst1 = v_st(32 + sr, sc); *(bf16x8*)(V_lds + (b) * SHM_V + vst0) = sr_[i].vs0;          \
    *(bf16x8*)(V_lds + (b) * SHM_V + vst1) = sr_[i].vs1; const int kc = sc * 2;          \
    *(bf16x8*)(K_lds + (b) * SHM_K + KSWZ(sr, kc)) = sr_[i].ks0;                          \
    *(bf16x8*)(K_lds + (b) * SHM_K + KSWZ(32 + sr, kc)) = sr_[i].ks1; } while (0)
#define SWAIT() asm volatile("s_waitcnt vmcnt(4)" ::: "memory")
#define RESC(a) do { if (__any((a) < 1.f)) { if (hi == 0) al_l[r32] = (a); asm volatile("s_waitcnt lgkmcnt(0)" ::: "memory"); \
    _Pragma("unroll") for (int d = 0; d < 4; ++d) _Pragma("unroll") for (int r = 0; r < 16; ++r) o[d][r] *= al_l[crow(r, hi)]; } } while (0)
    AUnit cur, nxt;
    int u = c;
    if (!attn_decode(u, total, Q, alist, pre, cntl, wid, r32, cur)) return;
#define stash ((int*)(lds + 81920) + TZ() * 2)
    stash[0] = (int)cur.qoff; stash[1] = cur.dst;
    unsigned ckv = __builtin_amdgcn_readfirstlane(cur.kv); bool ccausal = cur.causal;
    SLOAD(0, K + ckv, V + ckv, 0);
    for (;;) {
        bf16x8 qr[8];
        { const bf16_t* Qw = Q + (unsigned)stash[0] + hi * 8;
#pragma unroll
          for (int d0 = 0; d0 < 8; ++d0) qr[d0] = *reinterpret_cast<const bf16x8*>(Qw + d0 * 16); }
        u += G;
        const bool has_next = attn_decode(u, total, Q, alist, pre, cntl, wid, r32, nxt);
        const int dst0 = stash[1];
        if (hi == 0) dst_l[r32] = dst0;
        asm volatile("s_waitcnt lgkmcnt(0)" ::: "memory");
        if (has_next) { stash[0] = (int)nxt.qoff; stash[1] = nxt.dst; }
        const unsigned nkv = __builtin_amdgcn_readfirstlane(nxt.kv); const bool ncausal = nxt.causal;
        const bf16_t* Kh = K + ckv; const bf16_t* Vh = V + ckv; const bool causal = ccausal;
        float m_reg = -1e30f, l_reg = 0; f32x16 o[4] = {};
        f32x16 pA0, pA1, pB0, pB1; float mnA, mnB, alA, alB; bf16x8 pa0, pa1, pa2, pa3;
        asm volatile("s_waitcnt vmcnt(0)" ::: "memory"); SWRITE(0, 0); __syncthreads();
        qkt(pA0, pA1, K_lds, qr, r32, hi); if (causal) causal_mask(pA0, pA1, 0, qrow_i, hi); partialSM(pA0, pA1, m_reg, mnA, alA);
        SLOAD(1, Kh, Vh, KVBLK); SLOAD(0, Kh, Vh, 2 * KVBLK);
        SWAIT(); SWRITE(1, 1); __syncthreads();
        {
            SBAR(); qkt(pB0, pB1, K_lds + SHM_K, qr, r32, hi); if (causal) causal_mask(pB0, pB1, 1, qrow_i, hi);
            finishSM(pA0, pA1, alA, l_reg, pa0, pa1, pa2, pa3); SBAR();
            SLOAD(1, Kh, Vh, 3 * KVBLK); SBAR();
            pv_d0(o, vb0, pa0, pa1, pa2, pa3); partialSM(pB0, pB1, m_reg, mnB, alB);
            __syncthreads(); SWAIT(); SWRITE(0, 0);
            RESC(alB); __syncthreads();
            SBAR(); qkt(pA0, pA1, K_lds, qr, r32, hi); if (causal) causal_mask(pA0, pA1, 2, qrow_i, hi);
            finishSM(pB0, pB1, alB, l_reg, pa0, pa1, pa2, pa3); SBAR();
            pv_d0(o, vb0 + SHM_V, pa0, pa1, pa2, pa3); partialSM(pA0, pA1, m_reg, mnA, alA);
            __syncthreads(); asm volatile("s_waitcnt vmcnt(0)" ::: "memory"); SWRITE(1, 1);
            RESC(alA); __syncthreads();
        }
        SBAR(); qkt(pB0, pB1, K_lds + SHM_K, qr, r32, hi); if (causal) causal_mask(pB0, pB1, 3, qrow_i, hi);
        finishSM(pA0, pA1, alA, l_reg, pa0, pa1, pa2, pa3); SBAR();
        pv_d0(o, vb0, pa0, pa1, pa2, pa3); partialSM(pB0, pB1, m_reg, mnB, alB);
        __syncthreads(); RESC(alB);
        finishSM(pB0, pB1, alB, l_reg, pa0, pa1, pa2, pa3); SBAR();
        pv_d0(o, vb0 + SHM_V, pa0, pa1, pa2, pa3);
        SBAR();
        if (has_next) {
            SLOAD(0, K + nkv, V + nkv, 0);
        }
        SBAR();
        if (hi == 0) li_l[r32] = l_reg; asm volatile("s_waitcnt lgkmcnt(0)" ::: "memory");
        { const int dst = dst_l[r32]; if (hi == 0 && dst >= 0) lse[dst] = m_reg * CL2 + __builtin_amdgcn_logf(l_reg); }
        __syncthreads();
        char* ost = lds + wid * 8704;
#pragma unroll
        for (int r = 0; r < 16; ++r) { const int orow = crow(r, hi); const float rl = __builtin_amdgcn_rcpf(li_l[orow]);
#pragma unroll
            for (int d0 = 0; d0 < 4; ++d0) *(bf16_t*)(ost + orow * 272 + (d0 * 32 + r32) * 2) = f2bf(o[d0][r] * rl); }
#pragma unroll
        for (int j = 0; j < 8; ++j) { const int cidx = lane + 64 * j, row = cidx >> 4, ch = cidx & 15; const int dd = dst_l[row];
            const u32x4 w = *(const u32x4*)(ost + row * 272 + ch * 16);
            u32x2 f; f.x = pack_fp8x4(bf_lo(w.x) * FP8_OSCALE, bf_hi(w.x) * FP8_OSCALE, bf_lo(w.y) * FP8_OSCALE, bf_hi(w.y) * FP8_OSCALE);
            f.y = pack_fp8x4(bf_lo(w.z) * FP8_OSCALE, bf_hi(w.z) * FP8_OSCALE, bf_lo(w.w) * FP8_OSCALE, bf_hi(w.w) * FP8_OSCALE);
            if (dd >= 0) *(u32x2*)(part + (size_t)dd * 128 + ch * 8) = f; }
        __syncthreads();
        if (!has_next) break;
        ckv = nkv; ccausal = ncausal;
    }
#undef SLOAD
#undef stash
#undef TZ
#undef qrow_i
#undef vb0
#undef SWRITE
#undef SWAIT
#undef RESC
}
#undef KSWZ
#undef SBAR
}

__device__ __forceinline__ void phase_attn(const Frame& F, const bf16_t* Q, const bf16_t* K, const bf16_t* V, unsigned char* part, float* lse, int wi, int wn) {
    LAS int* pre = (LAS int*)(F.lds + at::LDS_PRE);
    LAS int* wtot = pre + 520; LAS int* cntl = pre + 536;
    const unsigned* gcnt = (const unsigned*)(F.ws + ZB_ATTCNT);
    const int* alist = (const int*)(F.ws + WS_ALIST);
    {
        const int cntv = (int)gcnt[F.tid]; const int v = (cntv + 255) >> 8;
        cntl[F.tid] = cntv;
        int incl = v;
#pragma unroll
        for (int o = 1; o < 64; o <<= 1) { const int y = __shfl_up(incl, o, 64); if (F.lane >= o) incl += y; }
        if (F.lane == 63) wtot[F.wave] = incl;
        __syncthreads();
        int off = 0;
        for (int w = 0; w < F.wave; ++w) off += wtot[w];
        pre[F.tid + 1] = off + incl; if (F.tid == 0) pre[0] = 0;
        __syncthreads();
    }
    const int total = 512 + pre[512];
    at::attn_stream(Q, K, V, alist, pre, cntl, total, wi, wn, part, lse, (char*)F.lds);
}

__device__ __forceinline__ void phase_attn_combine(const Frame& F, const unsigned char* part, const float* lse, unsigned char* O) {
    for (size_t idx = (size_t)F.c * NTHREADS + F.tid; idx < (size_t)T * 128; idx += (size_t)F.G * NTHREADS) {
        const int dc = (int)(idx & 15), h = (int)((idx >> 4) & 7); const size_t t = idx >> 7;
        const int s = (int)(t & (SEQ - 1)), j = s >> 8, nsel = j < 3 ? j : 3;
        const size_t base = (t * 8 + h) * 4;
        const f32x4 l4 = *(const f32x4*)(lse + base);
        float lk[4]; lk[0] = nsel > 0 ? l4[0] : -INFINITY; lk[1] = nsel > 1 ? l4[1] : -INFINITY; lk[2] = nsel > 2 ? l4[2] : -INFINITY; lk[3] = l4[3];
        const float mx = fmaxf(fmaxf(lk[0], lk[1]), fmaxf(lk[2], lk[3]));
        float acc[8] = {0.f, 0.f, 0.f, 0.f, 0.f, 0.f, 0.f, 0.f}; float wsum = 0.f;
#pragma unroll
        for (int k = 0; k < 4; ++k) if (k == 3 || k < nsel) {
            const float w = __builtin_amdgcn_exp2f(lk[k] - mx); wsum += w;
            const u32x2 p = *(const u32x2*)(part + (base + k) * 128 + dc * 8);
            const f32x2 p0 = __builtin_amdgcn_cvt_pk_f32_fp8((int)p.x, false), p1 = __builtin_amdgcn_cvt_pk_f32_fp8((int)p.x, true);
            const f32x2 p2 = __builtin_amdgcn_cvt_pk_f32_fp8((int)p.y, false), p3 = __builtin_amdgcn_cvt_pk_f32_fp8((int)p.y, true);
            acc[0] = fmaf(w, p0[0], acc[0]); acc[1] = fmaf(w, p0[1], acc[1]); acc[2] = fmaf(w, p1[0], acc[2]); acc[3] = fmaf(w, p1[1], acc[3]);
            acc[4] = fmaf(w, p2[0], acc[4]); acc[5] = fmaf(w, p2[1], acc[5]); acc[6] = fmaf(w, p3[0], acc[6]); acc[7] = fmaf(w, p3[1], acc[7]); }
        const float inv = 1.f / wsum;
        u32x2 w; w.x = pack_fp8x4(acc[0] * inv, acc[1] * inv, acc[2] * inv, acc[3] * inv); w.y = pack_fp8x4(acc[4] * inv, acc[5] * inv, acc[6] * inv, acc[7] * inv);
        *(u32x2*)(O + t * DM + h * 128 + dc * 8) = w;
    }
}

constexpr int N_PHASES = 22;
__global__ void __launch_bounds__(NTHREADS, 2) mk_fwd(Args a) {
    extern __shared__ __attribute__((aligned(16))) unsigned char lds_raw[];
    Frame F; F.lds = (LAS unsigned char*)lds_raw; F.tid = threadIdx.x; F.lane = F.tid & 63; F.wave = __builtin_amdgcn_readfirstlane(F.tid >> 6);
    F.G = gridDim.x; F.c = blockIdx.x; F.in = a.in; F.out = a.out; F.ws = a.ws;
    const int lo = a.ph_lo, hi = a.ph_hi;
    if (F.tid == 0) *(LAS u32x4*)(F.lds + LDS_BARW) = (u32x4){0u, 0u, 0u, 0u};
    __syncthreads();
    XcdBarrier bar; bar.bar = (unsigned*)(F.ws + ZB_BAR); bar.x = 0; bar.st = (volatile LAS unsigned*)(F.lds + LDS_BARW);
    if (hi - lo > 1) bar = xcd_barrier_post((unsigned*)(F.ws + ZB_BAR), (volatile LAS unsigned*)(F.lds + LDS_BARW));
#ifndef MK_ONLY
#define MK_ONLY -1
#endif
#define IN(k) ((MK_ONLY < 0 || MK_ONLY == (k)) && lo <= (k) && (k) < hi)
#define SEAM(k) do { if ((k) + 1 < hi) xcd_barrier(bar); { int _t = threadIdx.x; asm volatile("" : "+v"(_t)); F.tid = _t; F.lane = _t & 63; } } while (0)
#define PHASE_WS() unsigned char* ws; { unsigned long long w_ = (unsigned long long)a.ws; asm volatile("" : "+s"(w_)); ws = (unsigned char*)w_; F.ws = ws; } \
    bf16_t* actA = (bf16_t*)(ws + WS_ACTA); bf16_t* actB = (bf16_t*)(ws + WS_ACTB); bf16_t* actC = (bf16_t*)(ws + WS_ACTC); bf16_t* actD = (bf16_t*)(ws + WS_ACTD); \
    bf16_t* XB = (bf16_t*)(ws + WS_XB); bf16_t* actg = (bf16_t*)(ws + WS_ACTG); bf16_t* yk = (bf16_t*)(ws + WS_YK); \
    (void)actA; (void)actB; (void)actC; (void)actD; (void)XB; (void)actg; (void)yk;
    if (IN(0)) { PHASE_WS(); phase_prologue(F); SEAM(0); }
    if (IN(1)) { PHASE_WS(); phase_norm_mod(F, F.in[IN_X], F.in[L0_NORM1], 0, 0, actA); SEAM(1); }
    if (IN(2)) { PHASE_WS(); pg::Dense<pg::EpiBf16> S{actA, (const bf16_t*)(ws + WS_WIN), T / 256, 4, F.G, F.c, pg::EpiBf16{actB, 1.f}}; pg::gemm_phase(F.lds, S); SEAM(2); }
    if (IN(3)) { PHASE_WS(); phase_s5<false>(F, actB, actA, nullptr); SEAM(3); }
    if (IN(4)) { PHASE_WS(); phase_s5_carry(F); SEAM(4); }
    if (IN(5)) { PHASE_WS(); phase_s5<true>(F, actB, actA, (unsigned char*)actC); SEAM(5); }
    if (IN(6)) { PHASE_WS(); pg::Dense<pg::EpiGlu, true> S{actC, ws + WS_WGLU, T / 256, 4, F.G, F.c, pg::EpiGlu{actA, actB, 1.f / FP8_WSCALE}}; pg::gemm_phase(F.lds, S); SEAM(6); }
    if (IN(7)) { PHASE_WS(); pg::Dense<pg::EpiBf16> S{actB, (const bf16_t*)(ws + WS_WOUT), T / 256, 4, F.G, F.c, pg::EpiBf16{actC, 1.f}}; pg::gemm_phase(F.lds, S); SEAM(7); }
    if (IN(8)) { PHASE_WS(); phase_norm_router(F, F.in[IN_X], actC, F.in[L0_NORM2], 0, (unsigned char*)actA); SEAM(8); }
    const bool has_cv = (F.G == 256); const bool is_cv = has_cv && (F.c >> 3) >= 28; const int cvi = ((F.c >> 3) - 28) * 8 + (F.c & 7);
    const pg::MoeGeo geo0 = pg::moe_geo(F.G, F.c, has_cv ? 28 : 32), geo1 = pg::moe_geo(F.G, F.c, 32);
    if (IN(9)) { PHASE_WS(); if (is_cv) moe_conv_stream(F, CONV_L0DN_BEG, CONV_L1GU_BEG, cvi, 32);
        else { pg::MoeTabs M = pg::moe_setup<8>(F, 0, true, geo0);
            pg::MoeGateUp S{(const unsigned char*)actA, ws + WS_WGU0, F.in[L0_BGU], (unsigned char*)actg, M, geo0}; pg::gemm_phase(F.lds, S); }
        SEAM(9); }
    if (IN(10)) { PHASE_WS(); if (is_cv) moe_conv_stream(F, CONV_P10_BEG, CONV_P15_BEG, cvi, 32);
        else { pg::MoeTabs M = pg::moe_tabs_reuse(F, 0, geo0);
            pg::MoeDown S{(const unsigned char*)actg, ws + WS_WDN0, F.in[L0_BDN], (unsigned char*)yk, M, geo0}; pg::gemm_phase(F.lds, S); }
        SEAM(10); }
    if (IN(11)) { PHASE_WS(); phase_moe_combine<false, float>(F, 0, F.in[IN_X], actC, XB, F.in[L1_NORM1], (unsigned char*)actA, nullptr); SEAM(11); }
    if (IN(12)) { PHASE_WS(); pg::Dense<pg::EpiQkv, true> S{actA, ws + WS_WQKV, T / 256, 12, F.G, F.c,
                    pg::EpiQkv{actB, (const float*)(ws + WS_ROPE), (const float*)(ws + WS_ROPE) + (size_t)T * 64, 1.f / FP8_WSCALE, (float*)(ws + WS_KMEAN)}}; pg::gemm_phase(F.lds, S); SEAM(12); }
    if (IN(14)) { PHASE_WS(); phase_gating(F, actB); SEAM(14); }
    if (IN(15)) { PHASE_WS(); if (is_cv) moe_conv_stream(F, CONV_P15_BEG, CONV_L1DN_BEG, cvi, 32);
        else phase_attn(F, actB, actC, actD, (unsigned char*)actg, (float*)(ws + WS_LSE), has_cv ? (F.c >> 3) * 8 + (F.c & 7) : F.c, has_cv ? 224 : F.G);
        SEAM(15); }
    if (IN(16)) { PHASE_WS(); phase_attn_combine(F, (const unsigned char*)actg, (const float*)(ws + WS_LSE), (unsigned char*)actA); SEAM(16); }
    if (IN(17)) { PHASE_WS(); pg::Dense<pg::EpiBf16, true> S{actA, ws + WS_WO, T / 256, 4, F.G, F.c, pg::EpiBf16{actC, 1.f / (FP8_WSCALE * FP8_OSCALE)}}; pg::gemm_phase(F.lds, S); SEAM(17); }
    if (IN(18)) { PHASE_WS(); phase_norm_router(F, XB, actC, F.in[L1_NORM2], 1, (unsigned char*)actB); SEAM(18); }
    if (IN(19)) { PHASE_WS(); if (is_cv) moe_conv_stream(F, CONV_L1DN_BEG, CONV_END, cvi, 32);
        else { pg::MoeTabs M = pg::moe_setup<8>(F, 1, true, geo0);
            pg::MoeGateUp S{(const unsigned char*)actB, ws + WS_WGU1, F.in[L1_BGU], (unsigned char*)actg, M, geo0}; pg::gemm_phase(F.lds, S); }
        SEAM(19); }
    if (IN(20)) { PHASE_WS(); if (!is_cv) { pg::MoeTabs M = pg::moe_tabs_reuse(F, 1, geo0);
            pg::MoeDown S{(const unsigned char*)actg, ws + WS_WDN1, F.in[L1_BDN], (unsigned char*)yk, M, geo0}; pg::gemm_phase(F.lds, S); }
        SEAM(20); }
    if (IN(21)) { PHASE_WS(); phase_moe_combine<true, bf16_t>(F, 1, XB, actC, nullptr, F.in[IN_FNORM], nullptr, F.out); }
#undef IN
#undef SEAM
}

extern "C" void kernel_launch(void* const* d_in, const int* in_sizes, int n_in, void* d_out, int out_size, void* d_ws, size_t ws_size, hipStream_t stream) {
    static int grid = 0;
    if (grid == 0) {
        if (n_in != 37 || in_sizes[0] != T * DM || out_size != T * DM || ws_size < WS_END) {
            fprintf(stderr, "kernel_launch: built for 37 inputs, x/out of %d floats, >= %zu bytes of workspace; got n_in %d, in0 %d, out %d, ws %zu\n", T * DM, (size_t)WS_END, n_in, n_in > 0 ? in_sizes[0] : -1, out_size, ws_size);
            grid = -1; return; }
        int dev = 0, cus = 0, per_cu = 0;
        if (hipGetDevice(&dev) != hipSuccess || hipDeviceGetAttribute(&cus, hipDeviceAttributeMultiprocessorCount, dev) != hipSuccess) { grid = -1; return; }
        if (hipFuncSetAttribute((const void*)mk_fwd, hipFuncAttributeMaxDynamicSharedMemorySize, LDS_BYTES) != hipSuccess) { fprintf(stderr, "kernel_launch: hipFuncSetAttribute failed\n"); grid = -1; return; }
        if (hipOccupancyMaxActiveBlocksPerMultiprocessor(&per_cu, (const void*)mk_fwd, NTHREADS, LDS_BYTES) != hipSuccess || per_cu < 1)
            fprintf(stderr, "kernel_launch: occupancy query reports %d workgroups per CU\n", per_cu);
        (void)hipGetLastError();
        grid = cus;
    }
    if (grid < 0) return;
    if (hipMemsetAsync(d_ws, 0, ZERO_BYTES, stream) != hipSuccess) { fprintf(stderr, "kernel_launch: memset failed\n"); return; }
    Args a{};
    for (int i = 0; i < 37; ++i) a.in[i] = (const float*)d_in[i];
    a.out = (float*)d_out; a.ws = (unsigned char*)d_ws;
#if MK_MULTI
    for (int k = 0; k < MK_EMPTY; ++k) { a.ph_lo = N_PHASES; a.ph_hi = N_PHASES + 1; hipLaunchKernelGGL(mk_fwd, dim3(grid), dim3(NTHREADS), LDS_BYTES, stream, a); }
    for (int k = 0; k < N_PHASES; ++k) { a.ph_lo = k; a.ph_hi = k + 1;
        for (int rep = 0; rep < 1 + (int)((MK_DUP >> k) & 1u); ++rep) {
            if (rep && k == 8) hipMemsetAsync((char*)d_ws + ZB_MOECNT, 0, 256, stream);
            if (rep && k == 18) hipMemsetAsync((char*)d_ws + ZB_MOECNT + 256, 0, 256, stream);
            if (rep && k == 14) hipMemsetAsync((char*)d_ws + ZB_ATTCNT, 0, 2048, stream);
            hipLaunchKernelGGL(mk_fwd, dim3(grid), dim3(NTHREADS), LDS_BYTES, stream, a); } }
#else
    a.ph_lo = 0; a.ph_hi = N_PHASES;
    hipLaunchKernelGGL(mk_fwd, dim3(grid), dim3(NTHREADS), LDS_BYTES, stream, a);
#endif
    const hipError_t le = hipPeekAtLastError();
    if (le != hipSuccess) fprintf(stderr, "kernel_launch: launch failed: %s\n", hipGetErrorName(le));
}
```

```cpp
#include <hip/hip_runtime.h>
#include <cstdio>
#include <cstdint>

#ifndef MK_DUP
#define MK_DUP 0u
#endif
#ifndef MK_EMPTY
#define MK_EMPTY 0
#endif
#ifndef MK_KREP
#define MK_KREP 1
#endif
#ifndef MK_CONVPROBE
#define MK_CONVPROBE 0
#endif
#ifndef MK_CV0
#define MK_CV0 1280
#endif
#ifndef MK_CV9
#define MK_CV9 2048
#endif
#ifndef MK_CV10
#define MK_CV10 1152
#endif
#ifndef MK_MULTI
#define MK_MULTI 0
#endif

typedef unsigned short bf16_t;
typedef short bf16x8 __attribute__((ext_vector_type(8)));
typedef short s16x4 __attribute__((ext_vector_type(4)));
typedef float f32x2 __attribute__((ext_vector_type(2)));
typedef float f32x4 __attribute__((ext_vector_type(4)));
typedef float f32x16 __attribute__((ext_vector_type(16)));
typedef unsigned u32x2 __attribute__((ext_vector_type(2)));
typedef unsigned u32x4 __attribute__((ext_vector_type(4)));
typedef int v4i __attribute__((ext_vector_type(4)));
typedef int v8i __attribute__((ext_vector_type(8)));
#define LAS __attribute__((address_space(3)))

constexpr int DM = 1024, NB = 2, SEQ = 8192, T = NB * SEQ;
constexpr int NH = 8, HD = 128, MBLK = 256, NBLK = SEQ / MBLK;
constexpr int NE = 32, TOPK = 4, DFF = 1024;
constexpr int S5G = 64, S5P = 64, S5C = 16;
constexpr int NTHREADS = 512;
constexpr int LDS_BYTES = 147456;
constexpr int LDS_BARW = LDS_BYTES - 16;
constexpr int MOE_CAP = T;
constexpr int MOE_MAXROWS = T * TOPK + NE * 256;
constexpr int MOE_MAXTILES = MOE_MAXROWS / 256;

constexpr size_t al256(size_t x) { return (x + 255) / 256 * 256; }
constexpr size_t WS_ZERO = 0;
constexpr size_t   ZB_BAR = 0;
constexpr size_t   ZB_MOECNT = 16384;
constexpr size_t   ZB_ATTCNT = 20480;
constexpr size_t ZERO_BYTES = 32768;
constexpr size_t WS_ADA = ZERO_BYTES;
constexpr size_t WS_S5A = WS_ADA + al256(2 * 2 * 6 * 1024 * 4);
constexpr size_t WS_BOP = WS_S5A + 4 * 64 * 64 * 4;
constexpr size_t WS_COP = WS_BOP + 64 * 128 * 16 * 2;
constexpr size_t WS_ROPE = WS_COP + 64 * 16 * 128 * 2;
constexpr size_t WS_WRB = WS_ROPE + 2 * (size_t)T * 64 * 4;
constexpr size_t WS_KMEAN = WS_WRB + 2 * 32 * 1024 * 2;
constexpr size_t WS_TOPK = WS_KMEAN + 2 * 8 * 32 * 128 * 4;
constexpr size_t WS_VTOK = WS_TOPK + 2 * (size_t)T * 4 * 4;
constexpr size_t ALIST_PER_BH = 256 * 496;
constexpr size_t WS_ALIST = WS_VTOK + (size_t)NE * MOE_CAP * 4;
constexpr size_t WS_LSE = WS_ALIST + 16 * ALIST_PER_BH * 4;
constexpr size_t WS_CARRY = WS_LSE + (size_t)T * 8 * 4 * 4;
constexpr size_t WS_WIN = WS_CARRY + (size_t)2 * 256 * 64 * 128 * 4;
constexpr size_t WS_WGLU = WS_WIN + 2097152, WS_WOUT = WS_WGLU + 2097152, WS_WQKV = WS_WOUT + 2097152, WS_WO = WS_WQKV + 3 * 2097152;
constexpr size_t WS_WGU0 = WS_WO + 2097152;
constexpr size_t WS_WGU1 = WS_WGU0 + (size_t)NE * 2048 * 1024 * 2;
constexpr size_t WS_WDN0 = WS_WGU1 + (size_t)NE * 2048 * 1024 * 2;
constexpr size_t WS_WDN1 = WS_WDN0 + (size_t)NE * 1024 * 1024 * 2;
constexpr size_t WS_ACTA = WS_WDN1 + (size_t)NE * 1024 * 1024 * 2;
constexpr size_t ACT_BYTES = (size_t)T * DM * 2;
constexpr size_t WS_ACTB = WS_ACTA + ACT_BYTES, WS_ACTC = WS_ACTB + ACT_BYTES, WS_ACTD = WS_ACTC + ACT_BYTES;
constexpr size_t WS_XA = WS_ACTD + ACT_BYTES;
constexpr size_t WS_XB = WS_XA + (size_t)T * DM * 4;
constexpr size_t WS_ACTG = WS_XB + (size_t)T * DM * 4;
constexpr size_t WS_YK = WS_ACTG + (size_t)MOE_MAXROWS * 1024 * 2;
constexpr size_t WS_END = WS_YK + (size_t)MOE_MAXROWS * 1024 * 2;

__device__ __forceinline__ unsigned cvt_pk_bf16(float lo, float hi) { unsigned r; asm volatile("v_cvt_pk_bf16_f32 %0, %1, %2" : "=v"(r) : "v"(lo), "v"(hi)); return r; }
__device__ __forceinline__ float bf_lo(unsigned w) { return __uint_as_float(w << 16); }
__device__ __forceinline__ float bf_hi(unsigned w) { return __uint_as_float(w & 0xffff0000u); }
__device__ __forceinline__ bf16_t f2bf(float f) { return (bf16_t)(cvt_pk_bf16(f, 0.f) & 0xffffu); }
__device__ __forceinline__ unsigned pack_fp8x4(float a, float b, float c, float d) {
    a = fminf(fmaxf(a, -448.f), 448.f); b = fminf(fmaxf(b, -448.f), 448.f); c = fminf(fmaxf(c, -448.f), 448.f); d = fminf(fmaxf(d, -448.f), 448.f);
    int w = 0; w = __builtin_amdgcn_cvt_pk_fp8_f32(a, b, w, false); w = __builtin_amdgcn_cvt_pk_fp8_f32(c, d, w, true); return (unsigned)w;
}
__device__ __forceinline__ unsigned pack_fp8x4_nc(float a, float b, float c, float d) {
    int w = 0; w = __builtin_amdgcn_cvt_pk_fp8_f32(a, b, w, false); w = __builtin_amdgcn_cvt_pk_fp8_f32(c, d, w, true); return (unsigned)w;
}
constexpr float FP8_WSCALE = 64.f, FP8_ASCALE = 4.f, FP8_OSCALE = 64.f, FP8_YSCALE = 8.f;
__device__ __forceinline__ f32x4 load_x4(const float* p) { return *(const f32x4*)p; }
__device__ __forceinline__ f32x4 load_x4(const bf16_t* p) { const u32x2 w = *(const u32x2*)p; return (f32x4){bf_lo(w.x), bf_hi(w.x), bf_lo(w.y), bf_hi(w.y)}; }
template <int CTRL> __device__ __forceinline__ float dpp_f(float v) { return __builtin_bit_cast(float, __builtin_amdgcn_update_dpp(0, __builtin_bit_cast(int, v), CTRL, 0xF, 0xF, false)); }
template <int CTRL> __device__ __forceinline__ int dpp_i(int v) { return __builtin_amdgcn_update_dpp(0, v, CTRL, 0xF, 0xF, false); }
__device__ __forceinline__ float row16_sum(float v) { v += dpp_f<0xB1>(v); v += dpp_f<0x4E>(v); v += dpp_f<0x124>(v); v += dpp_f<0x128>(v); return v; }
__device__ __forceinline__ float row16_max(float v) { v = fmaxf(v, dpp_f<0xB1>(v)); v = fmaxf(v, dpp_f<0x4E>(v)); v = fmaxf(v, dpp_f<0x124>(v)); v = fmaxf(v, dpp_f<0x128>(v)); return v; }
__device__ __forceinline__ int row16_min(int v) { v = min(v, dpp_i<0xB1>(v)); v = min(v, dpp_i<0x4E>(v)); v = min(v, dpp_i<0x124>(v)); v = min(v, dpp_i<0x128>(v)); return v; }
__device__ __forceinline__ float wave_sum(float v) {
    const int r = __builtin_bit_cast(int, row16_sum(v));
    return (__builtin_bit_cast(float, __builtin_amdgcn_readlane(r, 0)) + __builtin_bit_cast(float, __builtin_amdgcn_readlane(r, 16)))
         + (__builtin_bit_cast(float, __builtin_amdgcn_readlane(r, 32)) + __builtin_bit_cast(float, __builtin_amdgcn_readlane(r, 48)));
}
__device__ __forceinline__ float wave_max(float v) {
    const int r = __builtin_bit_cast(int, row16_max(v));
    return fmaxf(fmaxf(__builtin_bit_cast(float, __builtin_amdgcn_readlane(r, 0)), __builtin_bit_cast(float, __builtin_amdgcn_readlane(r, 16))),
                 fmaxf(__builtin_bit_cast(float, __builtin_amdgcn_readlane(r, 32)), __builtin_bit_cast(float, __builtin_amdgcn_readlane(r, 48))));
}
__device__ __forceinline__ float sigmoidf_fast(float x) { return __builtin_amdgcn_rcpf(1.f + __builtin_amdgcn_exp2f(-1.4426950408889634f * x)); }
__device__ __forceinline__ float gelu_tanh(float y) {
    const float u = 1.5957691216057308f * (y + 0.044715f * y * y * y);
    return y * sigmoidf_fast(u);
}

#define XB_TMO      128
#define XB_XCNT(j)  (256  + 64 * (j))
#define XB_XSUB(j)  (1280 + 64 * (j))
#define XB_XGEN(j)  (2304 + 64 * (j))
#define XB_TOP      3328
#define XB_TOPGEN   3392
#define XCD_BAR_WORDS 3456
#define XB_SPIN_CAP (1u << 18)

__device__ __forceinline__ unsigned xb_ld(unsigned* p)              { return __hip_atomic_load(p, __ATOMIC_RELAXED, __HIP_MEMORY_SCOPE_AGENT); }
__device__ __forceinline__ unsigned xb_add(unsigned* p, unsigned v) { return __hip_atomic_fetch_add(p, v, __ATOMIC_RELAXED, __HIP_MEMORY_SCOPE_AGENT); }
__device__ __forceinline__ unsigned xb_xcc_id() { return (unsigned)__builtin_amdgcn_s_getreg((3 << 11) | 20) & 0xFu; }
#define XB_SPIN(cond, bar) do { unsigned _sp = 0; while (cond) { __builtin_amdgcn_s_sleep(1); \
    if ((++_sp & 255u) == 0u) { if (xb_ld(&(bar)[XB_TMO])) break; if (_sp > XB_SPIN_CAP) { atomicAdd(&(bar)[XB_TMO], 1u); break; } } } } while (0)

struct XcdBarrier { unsigned* bar; unsigned x; volatile LAS unsigned* st; };

__device__ __forceinline__ XcdBarrier xcd_barrier_post(unsigned* bar, volatile LAS unsigned* st) {
    XcdBarrier b; b.bar = bar; b.x = xb_xcc_id(); b.st = st;
    if (threadIdx.x == 0) (void)xb_add(&bar[XB_XCNT(b.x)], 1u);
    return b;
}
__device__ __forceinline__ void xcd_barrier_complete(unsigned* bar, unsigned x, unsigned& nloc, unsigned& nx) {
    const unsigned G = gridDim.x * gridDim.y * gridDim.z;
    unsigned sum, cnt, mine, sp = 0u;
    for (;;) {
        sum = 0u; cnt = 0u; mine = 0u;
#pragma unroll
        for (unsigned j = 0; j < 16; ++j) { const unsigned c = xb_ld(&bar[XB_XCNT(j)]); sum += c; cnt += (c > 0u) ? 1u : 0u; mine = (j == x) ? c : mine; }
        if (sum == G) break;
        __builtin_amdgcn_s_sleep(1);
        if ((++sp & 255u) == 0u) { if (xb_ld(&bar[XB_TMO])) break; if (sp > XB_SPIN_CAP) { atomicAdd(&bar[XB_TMO], 1u); break; } }
    }
    nloc = mine > 0u ? mine : 1u; nx = cnt > 0u ? cnt : 1u;
}
__device__ __forceinline__ void xcd_barrier(const XcdBarrier& b) {
    asm volatile("s_waitcnt vmcnt(0)" ::: "memory");
    __syncthreads();
    if (threadIdx.x == 0) {
        unsigned* bar = b.bar;
        __builtin_amdgcn_s_waitcnt(0);
        unsigned nloc = b.st[0], nx = b.st[1];
        if (nloc == 0u) { xcd_barrier_complete(bar, b.x, nloc, nx); b.st[0] = nloc; b.st[1] = nx; }
        const unsigned old = xb_add(&bar[XB_XSUB(b.x)], 1u);
        const unsigned gen = old / nloc;
        if (old + 1u == (gen + 1u) * nloc) {
            __builtin_amdgcn_fence(__ATOMIC_RELEASE, "agent");
            asm volatile("s_waitcnt vmcnt(0)" ::: "memory");
            const unsigned og = xb_add(&bar[XB_TOP], 1u);
            const unsigned tg = og / nx;
            if (og + 1u == (tg + 1u) * nx) xb_add(&bar[XB_TOPGEN], 1u);
            else XB_SPIN(xb_ld(&bar[XB_TOPGEN]) == tg, bar);
            __builtin_amdgcn_fence(__ATOMIC_ACQUIRE, "agent");
            xb_add(&bar[XB_XGEN(b.x)], 1u);
            asm volatile("s_waitcnt vmcnt(0)" ::: "memory");
        } else {
            XB_SPIN(xb_ld(&bar[XB_XGEN(b.x)]) == gen, bar);
            __builtin_amdgcn_fence(__ATOMIC_ACQUIRE, "agent");
            asm volatile("s_waitcnt vmcnt(0)" ::: "memory");
        }
    }
    __syncthreads();
}

struct Args { const float* in[37]; float* out; unsigned char* ws; int ph_lo, ph_hi; };

struct Frame {
    LAS unsigned char* lds;
    int tid, lane, wave, G, c;
    const float* const* in; float* out; unsigned char* ws;
};

enum { IN_X = 0, IN_C = 1, IN_POS = 2,
       L0_NORM1 = 3, L0_ADAW = 4, L0_ADAB = 5, L0_WIN = 6, L0_BRE = 7, L0_BIM = 8, L0_CRE = 9, L0_CIM = 10, L0_LRE = 11, L0_LIM = 12, L0_LOGDT = 13, L0_D = 14, L0_WGLU = 15, L0_WOUT = 16,
       L0_NORM2 = 17, L0_WR = 18, L0_BR = 19, L0_WGU = 20, L0_BGU = 21, L0_WDN = 22, L0_BDN = 23,
       L1_NORM1 = 24, L1_ADAW = 25, L1_ADAB = 26, L1_WQKV = 27, L1_WO = 28, L1_NORM2 = 29, L1_WR = 30, L1_BR = 31, L1_WGU = 32, L1_BGU = 33, L1_WDN = 34, L1_BDN = 35, IN_FNORM = 36 };

__device__ __forceinline__ const float* ada_vec(const Frame& F, int layer, int b, int which) { return (const float*)(F.ws + WS_ADA) + ((layer * 2 + b) * 6 + which) * 1024; }

__device__ __forceinline__ void conv_unit(const Frame& F, const float* __restrict__ src, bf16_t* __restrict__ dst, int N, int kt, int ntile, bool qkperm) {
    LAS unsigned* L = (LAS unsigned*)F.lds;
    const int k0 = kt * 64, n0 = ntile * 256, lane = F.lane, w = F.wave;
#pragma unroll
    for (int j = 0; j < 4; ++j) {
        const float* sp = src + (size_t)(k0 + 2 * w) * N + n0 + lane + 64 * j;
        float a[4], b[4];
#pragma unroll
        for (int i = 0; i < 4; ++i) { a[i] = sp[(size_t)(16 * i) * N]; b[i] = sp[(size_t)(16 * i + 1) * N]; }
#pragma unroll
        for (int i = 0; i < 4; ++i) L[(lane + 64 * j) * 33 + 8 * i + w] = cvt_pk_bf16(a[i], b[i]);
    }
    __syncthreads();
    const int row = F.tid >> 1, half = F.tid & 1;
    int n = n0 + row;
    if (qkperm && n < 2048) { const int d = n & 127; n = (n & ~127) | (d < 64 ? 2 * d : 2 * (d - 64) + 1); }
    bf16_t* dp = dst + (size_t)n * 1024 + k0 + half * 32;
#pragma unroll
    for (int q = 0; q < 4; ++q) {
        u32x4 v; v.x = L[row * 33 + half * 16 + 4 * q + 0]; v.y = L[row * 33 + half * 16 + 4 * q + 1]; v.z = L[row * 33 + half * 16 + 4 * q + 2]; v.w = L[row * 33 + half * 16 + 4 * q + 3];
        *(u32x4*)(dp + 8 * q) = v;
    }
    __syncthreads();
}

__device__ __forceinline__ void conv_unit8(const Frame& F, const float* __restrict__ src, unsigned char* __restrict__ dst, int N, int kt, int ntile, bool qkperm = false) {
    LAS unsigned* L = (LAS unsigned*)F.lds;
    const int k0 = kt * 128, n0 = ntile * 128, lane = F.lane, w = F.wave;
#pragma unroll
    for (int j = 0; j < 2; ++j) {
        const float* sp = src + (size_t)(k0 + 4 * w) * N + n0 + lane + 64 * j;
        float f[4][4];
#pragma unroll
        for (int i = 0; i < 4; ++i)
#pragma unroll
            for (int q = 0; q < 4; ++q) f[i][q] = sp[(size_t)(32 * i + q) * N];
#pragma unroll
        for (int i = 0; i < 4; ++i) L[(lane + 64 * j) * 33 + w + 8 * i] = pack_fp8x4(f[i][0] * FP8_WSCALE, f[i][1] * FP8_WSCALE, f[i][2] * FP8_WSCALE, f[i][3] * FP8_WSCALE);
    }
    __syncthreads();
    const int row = F.tid >> 2, qtr = F.tid & 3;
    int n = n0 + row;
    if (qkperm && n < 2048) { const int d = n & 127; n = (n & ~127) | (d < 64 ? 2 * d : 2 * (d - 64) + 1); }
    unsigned char* dp = dst + (size_t)n * 1024 + k0 + qtr * 32;
#pragma unroll
    for (int q = 0; q < 2; ++q) {
        u32x4 v; v.x = L[row * 33 + qtr * 8 + 4 * q + 0]; v.y = L[row * 33 + qtr * 8 + 4 * q + 1]; v.z = L[row * 33 + qtr * 8 + 4 * q + 2]; v.w = L[row * 33 + qtr * 8 + 4 * q + 3];
        *(u32x4*)(dp + 16 * q) = v;
    }
    __syncthreads();
}

__device__ __forceinline__ void ada_unit(const Frame& F, int layer, int cg) {
    LAS float* ca = (LAS float*)F.lds;
    const float* cin = F.in[IN_C];
    for (int i = F.tid; i < 2048; i += NTHREADS) { const float c = cin[i]; ca[i] = c * sigmoidf_fast(c); }
    __syncthreads();
    const float* w = F.in[layer ? L1_ADAW : L0_ADAW]; const float* bias = F.in[layer ? L1_ADAB : L0_ADAB];
    const int kq = F.wave, col = cg * 64 + F.lane;
    float a0 = 0.f, a1 = 0.f;
#pragma unroll 8
    for (int k = kq * 128; k < kq * 128 + 128; ++k) { const float wv = w[(size_t)k * 6144 + col]; a0 = fmaf(ca[k], wv, a0); a1 = fmaf(ca[1024 + k], wv, a1); }
    LAS float* red = ca + 2048;
    red[(kq * 2 + 0) * 64 + F.lane] = a0; red[(kq * 2 + 1) * 64 + F.lane] = a1;
    __syncthreads();
    if (F.tid < 128) { const int b = F.tid >> 6, l = F.tid & 63; float s = bias[cg * 64 + l];
#pragma unroll
        for (int q = 0; q < 8; ++q) s += red[(q * 2 + b) * 64 + l];
        ((float*)(F.ws + WS_ADA))[(layer * 2 + b) * 6144 + cg * 64 + l] = s; }
    __syncthreads();
}

__device__ __forceinline__ void s5tab_unit(const Frame& F, int unit) {
    const int idx = unit * NTHREADS + F.tid, g = idx >> 6, p = idx & 63;
    const double dt = exp((double)F.in[L0_LOGDT][g]);
    const double lr = (double)F.in[L0_LRE][idx], li = (double)F.in[L0_LIM][idx];
    const double mag = exp(lr * dt), ar = mag * cos(li * dt), ai = mag * sin(li * dt);
    const double den = lr * lr + li * li;
    const double fr = ((ar - 1.0) * lr + ai * li) / den, fi = (ai * lr - (ar - 1.0) * li) / den;
    const double mag32 = exp(32.0 * lr * dt), a32r = mag32 * cos(32.0 * li * dt), a32i = mag32 * sin(32.0 * li * dt);
    float* tab = (float*)(F.ws + WS_S5A);
    tab[idx] = (float)ar; tab[4096 + idx] = (float)ai; tab[8192 + idx] = (float)a32r; tab[12288 + idx] = (float)a32i;
    bf16_t* bop = (bf16_t*)(F.ws + WS_BOP); bf16_t* cop = (bf16_t*)(F.ws + WS_COP);
    const float* bre = F.in[L0_BRE] + (size_t)idx * 16; const float* bim = F.in[L0_BIM] + (size_t)idx * 16;
#pragma unroll
    for (int ch = 0; ch < 16; ++ch) {
        const double br = bre[ch], bi = bim[ch];
        bop[(g * 128 + p) * 16 + ch] = f2bf((float)(fr * br - fi * bi));
        bop[(g * 128 + 64 + p) * 16 + ch] = f2bf((float)(fr * bi + fi * br));
        cop[(g * 16 + ch) * 128 + p] = f2bf(F.in[L0_CRE][(g * 16 + ch) * 64 + p]);
        cop[(g * 16 + ch) * 128 + 64 + p] = f2bf(-F.in[L0_CIM][(g * 16 + ch) * 64 + p]);
    }
}

__device__ __forceinline__ void rope_unit(const Frame& F, int unit) {
    LAS float* invl = (LAS float*)F.lds;
    if (F.tid < 64) invl[F.tid] = (float)exp2(-(double)F.tid * (13.287712379549449 / 64.0));
    __syncthreads();
    const int idx = (unit * NTHREADS + F.tid) * 4, t = idx >> 6, i0 = idx & 63;
    const float pos = (float)((const int*)F.in[IN_POS])[t];
    f32x4 c, s;
#pragma unroll
    for (int e = 0; e < 4; ++e) {
        const float ang = pos * invl[i0 + e];
        const float k = rintf(ang * 0.15915494309189535f);
        float r = fmaf(-k, 6.28125f, ang); r = fmaf(-k, 1.9353071693331003e-3f, r); r = fmaf(-k, 1.0253131677018246e-11f, r);
        c[e] = __cosf(r); s[e] = __sinf(r);
    }
    *(f32x4*)((float*)(F.ws + WS_ROPE) + idx) = c;
    *(f32x4*)((float*)(F.ws + WS_ROPE) + (size_t)T * 64 + idx) = s;
    __syncthreads();
}

constexpr int CONV_L0DN_BEG = 4096, CONV_L1GU_BEG = 6144, CONV_L1DN_BEG = 10240, CONV_END = 12288;
constexpr int CONV_P10_BEG = CONV_L1GU_BEG + MK_CV0, CONV_P15_BEG = CONV_P10_BEG + MK_CV10;
constexpr int P0_CONV0 = 64, P0_CONV1 = 128, P0_CONV2 = 192, P0_CONV3 = 384, P0_CONV4 = 448, P0_CONV5 = 4544, P0_CONV6 = 6592, P0_CONV7 = 10688, P0_CONV8 = 12736;
constexpr int P0_ADA = P0_CONV8 + 192, P0_S5 = P0_ADA + 8, P0_ROPE = P0_S5 + 512, P0_WRB = P0_ROPE + 128, P0_END = P0_WRB + 32;

__device__ __forceinline__ void conv_batched(const Frame& F, int u, const float* src, size_t dst_off, int N) {
    const int per = 16 * (N / 256), e = u / per, r = u % per, kt = r / (N / 256), nt = r % (N / 256);
    conv_unit(F, src + (size_t)e * 1024 * N, (bf16_t*)(F.ws + dst_off) + (size_t)e * N * 1024, N, kt, nt, false);
}

__device__ __forceinline__ void conv_batched8(const Frame& F, int u, const float* src, size_t dst_off, int N) {
    const int per = 8 * (N / 128), e = u / per, r = u % per, kt = r / (N / 128), nt = r % (N / 128);
    conv_unit8(F, src + (size_t)e * 1024 * N, F.ws + dst_off + (size_t)e * N * 1024, N, kt, nt);
}

__device__ __forceinline__ bool moe_conv_decode(const Frame& F, int u, const float*& src, unsigned char*& dst, int& N) {
    if (u >= 12288) return false;
    const int fam = u < 4096 ? 0 : (u < 6144 ? 1 : (u < 10240 ? 2 : 3));
    const int base = fam == 0 ? 0 : (fam == 1 ? 4096 : (fam == 2 ? 6144 : 10240));
    N = (fam & 1) ? 1024 : 2048;
    const float* sp = fam == 0 ? F.in[L0_WGU] : (fam == 1 ? F.in[L0_WDN] : (fam == 2 ? F.in[L1_WGU] : F.in[L1_WDN]));
    const size_t doff = fam == 0 ? WS_WGU0 : (fam == 1 ? WS_WDN0 : (fam == 2 ? WS_WGU1 : WS_WDN1));
    const int r0 = u - base, per = 8 * (N / 128), e = r0 / per, r = r0 % per, kt = r / (N / 128), nt = r % (N / 128);
    src = sp + (size_t)e * 1024 * N + (size_t)(kt * 128 + 16 * F.wave + 8 * (F.lane >> 5)) * N + nt * 128 + 4 * (F.lane & 31);
    dst = F.ws + doff + (size_t)e * N * 1024 + (size_t)(nt * 128 + (F.tid >> 2)) * 1024 + kt * 128 + (F.tid & 3) * 32;
    return true;
}
__device__ __forceinline__ void moe_conv_stream(const Frame& F, int ubeg, int uend, int ci, int cn) {
    LAS unsigned* L = (LAS unsigned*)F.lds;
    const int nq = F.lane & 31, kd0 = 4 * F.wave + 2 * (F.lane >> 5), row = F.tid >> 2, qtr = F.tid & 3;
    const float* src; unsigned char* dst; int N;
    int u = ubeg + ci;
    if (u >= uend || !moe_conv_decode(F, u, src, dst, N)) return;
    f32x4 fa[8], fb[8]; unsigned char* da = dst; unsigned char* db = nullptr;
#define CV_LOAD(f) do { _Pragma("unroll") for (int i = 0; i < 8; ++i) f[i] = __builtin_nontemporal_load((const f32x4*)(src + (size_t)i * N)); } while (0)
#define CV_EMIT(f, d) do { unsigned pk[4][2]; \
        _Pragma("unroll") for (int c = 0; c < 4; ++c) { pk[c][0] = pack_fp8x4(f[0][c] * FP8_WSCALE, f[1][c] * FP8_WSCALE, f[2][c] * FP8_WSCALE, f[3][c] * FP8_WSCALE); \
                                                         pk[c][1] = pack_fp8x4(f[4][c] * FP8_WSCALE, f[5][c] * FP8_WSCALE, f[6][c] * FP8_WSCALE, f[7][c] * FP8_WSCALE); } \
        u += cn; more = u < uend && moe_conv_decode(F, u, src, dst, N); if (more) CV_LOAD(f); \
        _Pragma("unroll") for (int c = 0; c < 4; ++c) { L[(4 * nq + c) * 33 + kd0] = pk[c][0]; L[(4 * nq + c) * 33 + kd0 + 1] = pk[c][1]; } \
        asm volatile("s_waitcnt lgkmcnt(0)" ::: "memory"); __builtin_amdgcn_s_barrier(); asm volatile("" ::: "memory");     \
        _Pragma("unroll") for (int q = 0; q < 2; ++q) { u32x4 v; v.x = L[row * 33 + qtr * 8 + 4 * q + 0]; v.y = L[row * 33 + qtr * 8 + 4 * q + 1]; v.z = L[row * 33 + qtr * 8 + 4 * q + 2]; v.w = L[row * 33 + qtr * 8 + 4 * q + 3]; \
            *(u32x4*)((d) + 16 * q) = v; } \
        asm volatile("s_waitcnt lgkmcnt(0)" ::: "memory"); __builtin_amdgcn_s_barrier(); asm volatile("" ::: "memory"); } while (0)
    bool more;
    CV_LOAD(fa);
    u += cn; bool have_b = u < uend && moe_conv_decode(F, u, src, dst, N);
    if (have_b) { db = dst; CV_LOAD(fb); }
    for (;;) {
        unsigned char* d0 = da;
        CV_EMIT(fa, d0);
        const bool have_a = more; if (have_a) da = dst;
        if (!have_b) break;
        unsigned char* d1 = db;
        CV_EMIT(fb, d1);
        have_b = more; if (have_b) db = dst;
        if (!have_a) break;
    }
#undef CV_LOAD
#undef CV_EMIT
}

__device__ __forceinline__ void phase_prologue(const Frame& F) {
#if MK_CONVPROBE
    if ((F.c >> 3) >= 28) moe_conv_stream(F, 0, 12288, ((F.c >> 3) - 28) * 8 + (F.c & 7), 32);
#else
    moe_conv_stream(F, 0, CONV_L0DN_BEG, F.c, F.G);
    moe_conv_stream(F, CONV_L1GU_BEG, CONV_P10_BEG, F.c, F.G);
#endif
    for (int u = F.c; u < P0_END; u += F.G) {
        if (u >= P0_CONV4 && u < P0_CONV8) continue;
        if (u < P0_CONV0) conv_batched(F, u, F.in[L0_WIN], WS_WIN, 1024);
        else if (u < P0_CONV1) conv_batched8(F, u - P0_CONV0, F.in[L0_WGLU], WS_WGLU, 1024);
        else if (u < P0_CONV2) conv_batched(F, u - P0_CONV1, F.in[L0_WOUT], WS_WOUT, 1024);
        else if (u < P0_CONV3) { const int r = u - P0_CONV2; conv_unit8(F, F.in[L1_WQKV], F.ws + WS_WQKV, 3072, r / 24, r % 24, true); }
        else if (u < P0_CONV4) conv_batched8(F, u - P0_CONV3, F.in[L1_WO], WS_WO, 1024);
        else if (u < P0_CONV5) conv_batched8(F, u - P0_CONV4, F.in[L0_WGU], WS_WGU0, 2048);
        else if (u < P0_CONV6) conv_batched8(F, u - P0_CONV5, F.in[L0_WDN], WS_WDN0, 1024);
        else if (u < P0_CONV7) conv_batched8(F, u - P0_CONV6, F.in[L1_WGU], WS_WGU1, 2048);
        else if (u < P0_CONV8) conv_batched8(F, u - P0_CONV7, F.in[L1_WDN], WS_WDN1, 1024);
        else if (u < P0_ADA) { const int r = u - P0_CONV8; ada_unit(F, r / 96, r % 96); }
        else if (u < P0_S5) s5tab_unit(F, u - P0_ADA);
        else if (u < P0_ROPE) rope_unit(F, u - P0_S5);
        else if (u < P0_WRB) { const int idx = (u - P0_ROPE) * NTHREADS + F.tid, layer = idx >> 15, e = (idx >> 10) & 31, k = idx & 1023;
               ((bf16_t*)(F.ws + WS_WRB))[idx] = f2bf(F.in[layer ? L1_WR : L0_WR][k * 32 + e]); }
        else *(f32x4*)((float*)(F.ws + WS_KMEAN) + ((u - P0_WRB) * NTHREADS + F.tid) * 4) = (f32x4){0.f, 0.f, 0.f, 0.f};
    }
}

__device__ __forceinline__ void norm_mod_row(const float* __restrict__ xr, const float* __restrict__ gamma, const float* __restrict__ sh, const float* __restrict__ sc, bf16_t* __restrict__ hr, int lane) {
    f32x4 v[4]; float ss = 0.f;
#pragma unroll
    for (int i = 0; i < 4; ++i) { v[i] = *(const f32x4*)(xr + 256 * i + 4 * lane); ss += v[i][0] * v[i][0] + v[i][1] * v[i][1] + v[i][2] * v[i][2] + v[i][3] * v[i][3]; }
    ss = wave_sum(ss);
    const float rs = rsqrtf(ss * (1.f / 1024.f) + 1e-6f);
#pragma unroll
    for (int i = 0; i < 4; ++i) {
        const int col = 256 * i + 4 * lane;
        const f32x4 g = *(const f32x4*)(gamma + col), s1 = *(const f32x4*)(sc + col), s0 = *(const f32x4*)(sh + col);
        f32x4 y;
#pragma unroll
        for (int e = 0; e < 4; ++e) y[e] = v[i][e] * rs * g[e] * (1.f + s1[e]) + s0[e];
        u32x2 o; o.x = cvt_pk_bf16(y[0], y[1]); o.y = cvt_pk_bf16(y[2], y[3]);
        *(u32x2*)(hr + col) = o;
    }
}
__device__ __forceinline__ void phase_norm_mod(const Frame& F, const float* xin, const float* gamma, int layer, int which, bf16_t* hout) {
    const int lane = F.lane;
    for (int r = F.c * 8 + F.wave; r < T; r += F.G * 16) {
        const int r2 = r + F.G * 8; const bool two = r2 < T; const int rb = two ? r2 : r;
        f32x4 v[2][4];
#pragma unroll
        for (int i = 0; i < 4; ++i) { v[0][i] = *(const f32x4*)(xin + (size_t)r * DM + 256 * i + 4 * lane); v[1][i] = *(const f32x4*)(xin + (size_t)rb * DM + 256 * i + 4 * lane); }
#pragma unroll
        for (int q = 0; q < 2; ++q) {
            if (q == 1 && !two) break;
            const int rr = q ? rb : r, b = rr >> 13;
            const float* sh = ada_vec(F, layer, b, which); const float* sc = ada_vec(F, layer, b, which + 1);
            float ss = 0.f;
#pragma unroll
            for (int i = 0; i < 4; ++i) ss += v[q][i][0] * v[q][i][0] + v[q][i][1] * v[q][i][1] + v[q][i][2] * v[q][i][2] + v[q][i][3] * v[q][i][3];
            ss = wave_sum(ss);
            const float rs = rsqrtf(ss * (1.f / 1024.f) + 1e-6f);
#pragma unroll
            for (int i = 0; i < 4; ++i) {
                const int col = 256 * i + 4 * lane;
                const f32x4 g = *(const f32x4*)(gamma + col), s1 = *(const f32x4*)(sc + col), s0 = *(const f32x4*)(sh + col);
                f32x4 y;
#pragma unroll
                for (int e = 0; e < 4; ++e) y[e] = v[q][i][e] * rs * g[e] * (1.f + s1[e]) + s0[e];
                u32x2 o; o.x = cvt_pk_bf16(y[0], y[1]); o.y = cvt_pk_bf16(y[2], y[3]);
                *(u32x2*)(hout + (size_t)rr * DM + col) = o;
            }
        }
    }
}

template <class XT>
__device__ __forceinline__ void phase_norm_router(const Frame& F, const XT* xin, const bf16_t* mres, const float* gamma, int layer, unsigned char* hout) {
    const bf16_t* wrb = (const bf16_t*)(F.ws + WS_WRB) + (size_t)layer * 32 * 1024; const float* br = F.in[layer ? L1_BR : L0_BR];
    LAS unsigned char* hb = F.lds + F.wave * 16640;
    LAS int* cntl = (LAS int*)(F.lds + 133120);
    LAS int* basel = cntl + 32; LAS int* entl = cntl + 64;
    unsigned* gcnt = (unsigned*)(F.ws + ZB_MOECNT + layer * 256);
    int* pos = (int*)(F.ws + WS_TOPK); float* gates = (float*)(F.ws + WS_TOPK + (size_t)T * 4 * 4); int* vtok = (int*)(F.ws + WS_VTOK);
    const int lane = F.lane, e16 = lane & 15, kg = lane >> 4;
    for (int r0 = F.c * 64; r0 < T; r0 += F.G * 64) {
        if (F.tid < 32) cntl[F.tid] = 0;
        __syncthreads();
        const int rw = r0 + F.wave * 8;
        const int b = rw >> 13;
        const float* sh = ada_vec(F, layer, b, 3); const float* sc = ada_vec(F, layer, b, 4);
#pragma unroll 1
        for (int half = 0; half < 2; ++half) {
            f32x4 v[4][4]; u32x2 mr[4][4];
#pragma unroll
            for (int q = 0; q < 4; ++q)
#pragma unroll
                for (int i = 0; i < 4; ++i) { v[q][i] = load_x4(xin + (size_t)(rw + half * 4 + q) * DM + 256 * i + 4 * lane);
                                              mr[q][i] = *(const u32x2*)(mres + (size_t)(rw + half * 4 + q) * DM + 256 * i + 4 * lane); }
            { const float* g1 = ada_vec(F, layer, b, 2);
#pragma unroll
              for (int i = 0; i < 4; ++i) { const f32x4 gv = *(const f32x4*)(g1 + 256 * i + 4 * lane);
#pragma unroll
                for (int q = 0; q < 4; ++q) { v[q][i][0] = fmaf(gv[0], bf_lo(mr[q][i].x), v[q][i][0]); v[q][i][1] = fmaf(gv[1], bf_hi(mr[q][i].x), v[q][i][1]);
                                              v[q][i][2] = fmaf(gv[2], bf_lo(mr[q][i].y), v[q][i][2]); v[q][i][3] = fmaf(gv[3], bf_hi(mr[q][i].y), v[q][i][3]); } } }
#pragma unroll
            for (int q = 0; q < 4; ++q) {
                const int r = rw + half * 4 + q;
                float ss = 0.f;
#pragma unroll
                for (int i = 0; i < 4; ++i) ss += v[q][i][0] * v[q][i][0] + v[q][i][1] * v[q][i][1] + v[q][i][2] * v[q][i][2] + v[q][i][3] * v[q][i][3];
                ss = wave_sum(ss);
                const float rs = rsqrtf(ss * (1.f / 1024.f) + 1e-6f);
#pragma unroll
                for (int i = 0; i < 4; ++i) {
                    const int col = 256 * i + 4 * lane;
                    const f32x4 g = *(const f32x4*)(gamma + col), s1 = *(const f32x4*)(sc + col), s0 = *(const f32x4*)(sh + col);
                    f32x4 y;
#pragma unroll
                    for (int k = 0; k < 4; ++k) y[k] = v[q][i][k] * rs * g[k] * (1.f + s1[k]) + s0[k];
                    *(unsigned*)(hout + (size_t)r * DM + col) = pack_fp8x4(y[0], y[1], y[2], y[3]);
                    u32x2 o; o.x = cvt_pk_bf16(y[0], y[1]); o.y = cvt_pk_bf16(y[2], y[3]);
                    *(LAS u32x2*)(hb + (half * 4 + q) * 2080 + col * 2) = o;
                }
            }
        }
        f32x4 acc0 = {0.f, 0.f, 0.f, 0.f}, acc1 = {0.f, 0.f, 0.f, 0.f};
        const LAS unsigned char* ap = hb + (e16 & 7) * 2080 + kg * 16;
        const bf16_t* bp0 = wrb + (size_t)e16 * 1024 + kg * 8; const bf16_t* bp1 = bp0 + 16 * 1024;
#pragma unroll 8
        for (int ks = 0; ks < 32; ++ks) {
            const bf16x8 a = *(const LAS bf16x8*)(ap + ks * 64);
            const bf16x8 w0 = *(const bf16x8*)(bp0 + ks * 32), w1 = *(const bf16x8*)(bp1 + ks * 32);
            acc0 = __builtin_amdgcn_mfma_f32_16x16x32_bf16(a, w0, acc0, 0, 0, 0);
            acc1 = __builtin_amdgcn_mfma_f32_16x16x32_bf16(a, w1, acc1, 0, 0, 0);
        }
        const float bias0 = br[e16], bias1 = br[16 + e16];
#pragma unroll
        for (int reg = 0; reg < 4; ++reg) {
            float v0 = acc0[reg] + bias0, v1 = acc1[reg] + bias1;
            const int r = rw + ((4 * kg + reg) & 7);
            int ek[4]; float vk[4];
#pragma unroll
            for (int k = 0; k < 4; ++k) {
                const float m = row16_max(fmaxf(v0, v1));
                const int cand = row16_min((v0 == m) ? e16 : ((v1 == m) ? 16 + e16 : 99));
                ek[k] = cand; vk[k] = m;
                if (cand == e16) v0 = -INFINITY; else if (cand == 16 + e16) v1 = -INFINITY;
            }
            const float e1 = __expf(vk[1] - vk[0]), e2 = __expf(vk[2] - vk[0]), e3 = __expf(vk[3] - vk[0]);
            const float inv = 1.f / (1.f + e1 + e2 + e3);
            if (kg < 2 && e16 < 4) {
                const int ee = e16 == 0 ? ek[0] : e16 == 1 ? ek[1] : e16 == 2 ? ek[2] : ek[3];
                const float gg = (e16 == 0 ? 1.f : e16 == 1 ? e1 : e16 == 2 ? e2 : e3) * inv;
                const int rank = __hip_atomic_fetch_add(&cntl[ee], 1, __ATOMIC_RELAXED, __HIP_MEMORY_SCOPE_WORKGROUP);
                entl[(r - r0) * 4 + e16] = (ee << 16) | rank;
                gates[(size_t)r * 4 + e16] = gg;
            }
        }
        __syncthreads();
        if (F.tid < 32) basel[F.tid] = (int)atomicAdd(&gcnt[F.tid], (unsigned)cntl[F.tid]);
        __syncthreads();
        if (F.tid < 256) {
            const int en = entl[F.tid], ee = en >> 16, v = basel[ee] + (en & 0xffff), tk = r0 * 4 + F.tid;
            vtok[ee * MOE_CAP + v] = tk; pos[tk] = ee * MOE_CAP + v;
        }
        __syncthreads();
    }
}

namespace pg {
constexpr int BM = 256, BK = 64, HALF = 128, HTB = HALF * BK * 2, STAGE_BYTES = 8 * HTB, NXCD = 8, WGM = 8, KD = 1024, NKT = KD / BK;
__device__ __forceinline__ int lds_byte(int r, int c) { const int st = (r >> 4) * 2 + (c >> 5), rr = r & 15, cc = c & 31, ob = rr * 64 + cc * 2; return st * 1024 + (ob ^ (((ob >> 9) & 1) << 5)); }
__device__ __forceinline__ void stage_rc(int b, int& R, int& C) { const int st = b / 1024, sb = b % 1024, swz = sb ^ (((sb >> 9) & 1) << 5); R = (st >> 1) * 16 + swz / 64; C = (st & 1) * 32 + (swz % 64) / 2; }
__device__ __forceinline__ int perm32(int rho) { const int n = rho >> 4, i = rho & 15; return 8 * (i >> 2) + 4 * n + (i & 3); }

struct Unit { int rt, pn, e, ui; };

template <class P>
__device__ __forceinline__ void gemm_phase(LAS unsigned char* lds, const P& S) {
    const int tid = threadIdx.x, wid = __builtin_amdgcn_readfirstlane(tid >> 6), lane = tid & 63, wr = wid >> 2, wc = wid & 3, fr = lane & 15, fq = lane >> 4;
    int R0, C0; stage_rc(tid * 16, R0, C0);
    constexpr int ROWB = P::FP8 ? 1024 : 2048, NKT_ = ROWB / 128, KREP = P::KREP;
    unsigned voffB[2];
#pragma unroll
    for (int i = 0; i < 2; ++i) { const int R = R0 + 64 * i, Rb = P::PERM ? ((R & ~31) + perm32(R & 31)) : R; voffB[i] = (unsigned)(Rb * ROWB + C0 * 2); }
    const unsigned cofs = (unsigned)C0 * 2u;
    const unsigned ldsw = (unsigned)wid * 1024u;
    const int aoff = lds_byte(wr * 64 + fr, fq * 8), boff = lds_byte(wc * 32 + fr, fq * 8);
#define PG_SA(b, h) (((b) * 2 + (h)) * HTB)
#define PG_SB(b, h) ((4 + (b) * 2 + (h)) * HTB)
#define PG_STA(bufoff, kptr, V0, V1) do { \
        __builtin_amdgcn_global_load_lds((const unsigned*)((kptr) + (V0)), (LAS unsigned*)(lds + (bufoff) + ldsw), 16, 0, 0); \
        __builtin_amdgcn_global_load_lds((const unsigned*)((kptr) + (V1)), (LAS unsigned*)(lds + (bufoff) + ldsw + 8192), 16, 0, 0); } while (0)
#define PG_STB(bufoff, bptr) PG_STA(bufoff, bptr, voffB[0], voffB[1])
#define PG_LDA(dst, b, h) do { _Pragma("unroll") for (int m = 0; m < 4; ++m) dst[m] = __builtin_shufflevector(*(const LAS v4i*)(lds + PG_SA(b, h) + aoff + m * 2048), *(const LAS v4i*)(lds + PG_SA(b, h) + aoff + m * 2048 + 1024), 0, 1, 2, 3, 4, 5, 6, 7); } while (0)
#define PG_LDB(dst, b, h) do { _Pragma("unroll") for (int n = 0; n < 2; ++n) dst[n] = __builtin_shufflevector(*(const LAS v4i*)(lds + PG_SB(b, h) + boff + n * 2048), *(const LAS v4i*)(lds + PG_SB(b, h) + boff + n * 2048 + 1024), 0, 1, 2, 3, 4, 5, 6, 7); } while (0)
#define PG_LO(X) __builtin_bit_cast(bf16x8, __builtin_shufflevector(X, X, 0, 1, 2, 3))
#define PG_HI(X) __builtin_bit_cast(bf16x8, __builtin_shufflevector(X, X, 4, 5, 6, 7))
#define PG_MMA(ai, bj, At, Bt) do { __builtin_amdgcn_s_setprio(1); _Pragma("unroll") for (int m = 0; m < 4; ++m) _Pragma("unroll") for (int n = 0; n < 2; ++n) { \
        if constexpr (P::FP8) asm volatile("v_mfma_scale_f32_16x16x128_f8f6f4 %0, %1, %2, %0, %3, %3 op_sel_hi:[0,0,0]" : "+v"(acc[ai][bj][m][n]) : "v"(Bt[n]), "v"(At[m]), "v"(fp8_one)); \
        else { acc[ai][bj][m][n] = __builtin_amdgcn_mfma_f32_16x16x32_bf16(PG_LO(Bt[n]), PG_LO(At[m]), acc[ai][bj][m][n], 0, 0, 0); \
               acc[ai][bj][m][n] = __builtin_amdgcn_mfma_f32_16x16x32_bf16(PG_HI(Bt[n]), PG_HI(At[m]), acc[ai][bj][m][n], 0, 0, 0); } } \
        __builtin_amdgcn_s_setprio(0); } while (0)
#define PG_WAIT_V(n) asm volatile("s_waitcnt vmcnt(" #n ")" ::: "memory")
#define PG_WAIT_L(n) asm volatile("s_waitcnt lgkmcnt(" #n ")" ::: "memory")
#define PG_BAR __builtin_amdgcn_s_barrier()
#define PG_SCHED __builtin_amdgcn_sched_barrier(0)
    Unit cur, nxt; int ui = 0;
    if (!S.next(0, cur)) return;
    f32x4 acc[2][2][4][2];
    {   f32x4 bi[2][2]; S.binit(cur, wc, fq, bi);
#pragma unroll
        for (int a = 0; a < 2; ++a)
#pragma unroll
            for (int b = 0; b < 2; ++b)
#pragma unroll
                for (int m = 0; m < 4; ++m)
#pragma unroll
                    for (int n = 0; n < 2; ++n) acc[a][b][m][n] = bi[b][n]; }
    v8i At[4], B0[2], B1[2];
    int fp8_one = 0x7F7F7F7F; asm volatile("" : "+v"(fp8_one));
    unsigned va0, va1, va2, va3, vn0, vn1, vn2, vn3;
    S.arows(cur, R0, cofs, va0, va1, va2, va3);
    const char* cb0; const char* cb1; S.bptr(cur, cb0, cb1);
    const char* const A0 = S.abase();
    PG_STB(PG_SB(0, 0), cb0); PG_STA(PG_SA(0, 0), A0, va0, va1); PG_STB(PG_SB(0, 1), cb1); PG_STA(PG_SA(0, 1), A0, va2, va3);
    if (wr == 1) PG_BAR;
    PG_WAIT_V(4); PG_BAR;
    PG_STB(PG_SB(1, 0), cb0 + 128); PG_STA(PG_SA(1, 0), A0 + 128, va0, va1); PG_STB(PG_SB(1, 1), cb1 + 128);
    PG_WAIT_V(6); PG_BAR;
    for (;;) {
        const bool has_next = S.next(ui + 1, nxt);
        const char* nb0 = cb0; const char* nb1 = cb1; vn0 = va0; vn1 = va1; vn2 = va2; vn3 = va3;
        if (has_next) { S.arows(nxt, R0, cofs, vn0, vn1, vn2, vn3); S.bptr(nxt, nb0, nb1); }
#pragma unroll 1
        for (int tt = 0; tt < NKT_ * KREP; tt += 2) {
            const int t = tt % NKT_;
            const bool wrap = (t == NKT_ - 2), last = wrap && (tt == NKT_ * KREP - 2);
            const int kt2 = wrap ? 0 : t + 2;
            const char* a1 = A0 + (size_t)(t + 1) * 128; const char* a2 = A0 + (size_t)kt2 * 128; const char* a3 = a2 + 128;
            const char* b20 = (last ? nb0 : cb0) + (size_t)kt2 * 128; const char* b21 = (last ? nb1 : cb1) + (size_t)kt2 * 128;
            const unsigned w0 = last ? vn0 : va0, w1 = last ? vn1 : va1, w2 = last ? vn2 : va2, w3 = last ? vn3 : va3;
            PG_LDB(B0, 0, 0); PG_SCHED; PG_LDA(At, 0, 0); PG_STA(PG_SA(1, 1), a1, va2, va3);
            PG_WAIT_L(8); PG_BAR; PG_WAIT_L(0); PG_MMA(0, 0, At, B0); PG_BAR; PG_SCHED;
            PG_LDB(B1, 0, 1); PG_STB(PG_SB(0, 0), b20);
            PG_BAR; PG_WAIT_L(0); PG_MMA(0, 1, At, B1); PG_BAR;
            PG_LDA(At, 0, 1); PG_STA(PG_SA(0, 0), a2, w0, w1);
            PG_BAR; PG_WAIT_L(0); PG_MMA(1, 0, At, B0); PG_BAR; PG_SCHED;
            PG_STB(PG_SB(0, 1), b21);
            PG_WAIT_V(6); PG_BAR; PG_MMA(1, 1, At, B1); PG_BAR;
            PG_LDB(B0, 1, 0); PG_SCHED; PG_LDA(At, 1, 0); PG_STA(PG_SA(0, 1), a2, w2, w3);
            PG_WAIT_L(8); PG_BAR; PG_WAIT_L(0); PG_MMA(0, 0, At, B0); PG_BAR; PG_SCHED;
            PG_LDB(B1, 1, 1); PG_STB(PG_SB(1, 0), b20 + 128);
            PG_BAR; PG_WAIT_L(0); PG_MMA(0, 1, At, B1); PG_BAR;
            PG_LDA(At, 1, 1); PG_STA(PG_SA(1, 0), a3, w0, w1);
            PG_BAR; PG_WAIT_L(0); PG_MMA(1, 0, At, B0); PG_BAR; PG_SCHED;
            PG_STB(PG_SB(1, 1), b21 + 128);
            PG_WAIT_V(6); PG_BAR; PG_MMA(1, 1, At, B1); PG_BAR;
        }
        f32x4 bn[2][2];
        if (has_next) S.binit(nxt, wc, fq, bn);
        if constexpr (P::FP8) asm volatile("s_nop 15\n\ts_nop 15" ::: "memory");
        S.epi(acc, cur, wr, wc, fr, fq);
        if (!has_next) break;
#pragma unroll
        for (int a = 0; a < 2; ++a)
#pragma unroll
            for (int b = 0; b < 2; ++b)
#pragma unroll
                for (int m = 0; m < 4; ++m)
#pragma unroll
                    for (int n = 0; n < 2; ++n) acc[a][b][m][n] = bn[b][n];
        cur = nxt; cb0 = nb0; cb1 = nb1; va0 = vn0; va1 = vn1; va2 = vn2; va3 = vn3; ++ui;
    }
    PG_WAIT_V(0);
    if (wr == 0) PG_BAR;
    PG_BAR;
#undef PG_SA
#undef PG_SB
#undef PG_STA
#undef PG_STB
#undef PG_LDA
#undef PG_LDB
#undef PG_MMA
#undef PG_LO
#undef PG_HI
#undef PG_WAIT_V
#undef PG_WAIT_L
#undef PG_BAR
#undef PG_SCHED
}

template <class Epi, bool FP8_ = false> struct Dense {
    static constexpr bool PERM = Epi::PERM, FP8 = FP8_; static constexpr int KREP = 1;
    static constexpr unsigned ROWB = FP8_ ? 1024u : 2048u;
    const void* A; const void* Bt; int nM, nN, G, c; Epi E;
    __device__ __forceinline__ bool next(int i, Unit& u) const {
        const int nwg = nM * nN; const long L = (long)i * G + c; if (L >= nwg) return false;
        int wgid = (int)L; { const int q = nwg / NXCD, r = nwg % NXCD, xcd = wgid % NXCD, off = wgid / NXCD; wgid = (xcd < r ? xcd * (q + 1) : r * (q + 1) + (xcd - r) * q) + off; }
        const int nig = WGM * nN, gid = wgid / nig, fm = gid * WGM, gsz = (nM - fm) < WGM ? (nM - fm) : WGM;
        u.rt = fm + ((wgid % nig) % gsz); u.pn = (wgid % nig) / gsz; u.e = 0; u.ui = i; return true;
    }
    __device__ __forceinline__ void arows(const Unit& u, int R0, unsigned cofs, unsigned& v0, unsigned& v1, unsigned& v2, unsigned& v3) const {
        const unsigned base = (unsigned)(u.rt * 256 + R0) * ROWB + cofs; v0 = base; v1 = base + 64u * ROWB; v2 = base + 128u * ROWB; v3 = base + 192u * ROWB;
    }
    __device__ __forceinline__ const char* abase() const { return (const char*)A; }
    __device__ __forceinline__ void bptr(const Unit& u, const char*& b0, const char*& b1) const { b0 = (const char*)Bt + (size_t)u.pn * 256 * ROWB; b1 = b0 + (size_t)128 * ROWB; }
    __device__ __forceinline__ void epi(const f32x4 (&acc)[2][2][4][2], const Unit& u, int wr, int wc, int fr, int fq) const { E(acc, u, wr, wc, fr, fq); }
    __device__ __forceinline__ void binit(const Unit&, int, int, f32x4 (&bi)[2][2]) const { bi[0][0] = bi[0][1] = bi[1][0] = bi[1][1] = (f32x4){0.f, 0.f, 0.f, 0.f}; }
};

struct EpiBf16 {
    static constexpr bool PERM = true;
    bf16_t* O; float sc;
    __device__ __forceinline__ void operator()(const f32x4 (&acc)[2][2][4][2], const Unit& u, int wr, int wc, int fr, int fq) const {
        const int row0 = u.rt * 256 + wr * 64 + fr, col0 = u.pn * 256 + wc * 32 + 8 * fq;
#pragma unroll
        for (int ai = 0; ai < 2; ++ai)
#pragma unroll
            for (int m = 0; m < 4; ++m) { bf16_t* rowp = O + (size_t)(row0 + ai * 128 + m * 16) * 1024 + col0;
#pragma unroll
                for (int bj = 0; bj < 2; ++bj) { const f32x4 v0 = acc[ai][bj][m][0] * sc, v1 = acc[ai][bj][m][1] * sc;
                    u32x4 w; w.x = cvt_pk_bf16(v0[0], v0[1]); w.y = cvt_pk_bf16(v0[2], v0[3]); w.z = cvt_pk_bf16(v1[0], v1[1]); w.w = cvt_pk_bf16(v1[2], v1[3]);
                    *(u32x4*)(rowp + bj * 128) = w; } }
    }
};
struct EpiGlu {
    static constexpr bool PERM = true;
    const bf16_t* Z; bf16_t* O; float sc;
    __device__ __forceinline__ void operator()(const f32x4 (&acc)[2][2][4][2], const Unit& u, int wr, int wc, int fr, int fq) const {
        const int row0 = u.rt * 256 + wr * 64 + fr, col0 = u.pn * 256 + wc * 32 + 8 * fq;
#pragma unroll
        for (int ai = 0; ai < 2; ++ai)
#pragma unroll
            for (int m = 0; m < 4; ++m) { const size_t ro = (size_t)(row0 + ai * 128 + m * 16) * 1024 + col0;
#pragma unroll
                for (int bj = 0; bj < 2; ++bj) { const f32x4 v0 = acc[ai][bj][m][0] * sc, v1 = acc[ai][bj][m][1] * sc;
                    const u32x4 z = *(const u32x4*)(Z + ro + bj * 128);
                    u32x4 w;
                    w.x = cvt_pk_bf16(bf_lo(z.x) * sigmoidf_fast(v0[0]), bf_hi(z.x) * sigmoidf_fast(v0[1]));
                    w.y = cvt_pk_bf16(bf_lo(z.y) * sigmoidf_fast(v0[2]), bf_hi(z.y) * sigmoidf_fast(v0[3]));
                    w.z = cvt_pk_bf16(bf_lo(z.z) * sigmoidf_fast(v1[0]), bf_hi(z.z) * sigmoidf_fast(v1[1]));
                    w.w = cvt_pk_bf16(bf_lo(z.w) * sigmoidf_fast(v1[2]), bf_hi(z.w) * sigmoidf_fast(v1[3]));
                    *(u32x4*)(O + ro + bj * 128) = w; } }
    }
};
struct EpiResid {
    static constexpr bool PERM = false;
    const float* Xi; float* Xo; const float* gate0; const float* gate1; float sc;
    __device__ __forceinline__ void operator()(const f32x4 (&acc)[2][2][4][2], const Unit& u, int wr, int wc, int fr, int fq) const {
        const int row0 = u.rt * 256 + wr * 64 + fr, col0 = u.pn * 256 + wc * 32 + 4 * fq;
        const float* gate = (u.rt * 256 >= SEQ) ? gate1 : gate0;
        f32x4 gv[2][2];
#pragma unroll
        for (int bj = 0; bj < 2; ++bj)
#pragma unroll
            for (int n = 0; n < 2; ++n) gv[bj][n] = *(const f32x4*)(gate + col0 + bj * 128 + n * 16) * sc;
#pragma unroll
        for (int ai = 0; ai < 2; ++ai)
#pragma unroll
            for (int m = 0; m < 4; ++m) { const size_t ro = (size_t)(row0 + ai * 128 + m * 16) * 1024 + col0;
#pragma unroll
                for (int bj = 0; bj < 2; ++bj)
#pragma unroll
                    for (int n = 0; n < 2; ++n) { const f32x4 xi = *(const f32x4*)(Xi + ro + bj * 128 + n * 16); *(f32x4*)(Xo + ro + bj * 128 + n * 16) = xi + gv[bj][n] * acc[ai][bj][m][n]; } }
    }
};
struct EpiQkv {
    static constexpr bool PERM = true;
    bf16_t* Q; const float* cs; const float* sn; float sc; float* km;
    __device__ __forceinline__ void operator()(const f32x4 (&acc)[2][2][4][2], const Unit& u, int wr, int wc, int fr, int fq) const {
        const int sec = u.pn >> 2, row0 = u.rt * 256 + wr * 64 + fr, col0 = (u.pn & 3) * 256 + wc * 32 + 8 * fq, d0 = 16 * wc + 4 * fq;
        bf16_t* O = Q + (size_t)sec * T * DM;
        float ks[2][8];
#pragma unroll
        for (int bj = 0; bj < 2; ++bj)
#pragma unroll
            for (int j = 0; j < 8; ++j) ks[bj][j] = 0.f;
#pragma unroll
        for (int ai = 0; ai < 2; ++ai)
#pragma unroll
            for (int m = 0; m < 4; ++m) { const int row = row0 + ai * 128 + m * 16; bf16_t* rowp = O + (size_t)row * 1024 + col0;
                f32x4 c = {1.f, 1.f, 1.f, 1.f}, s = {0.f, 0.f, 0.f, 0.f};
                if (sec < 2) { c = *(const f32x4*)(cs + (size_t)row * 64 + d0); s = *(const f32x4*)(sn + (size_t)row * 64 + d0); }
#pragma unroll
                for (int bj = 0; bj < 2; ++bj) { const f32x4 v0 = acc[ai][bj][m][0] * sc, v1 = acc[ai][bj][m][1] * sc;
                    float r[8];
                    if (sec < 2) {
                        r[0] = v0[0] * c[0] - v0[1] * s[0]; r[1] = v0[1] * c[0] + v0[0] * s[0];
                        r[2] = v0[2] * c[1] - v0[3] * s[1]; r[3] = v0[3] * c[1] + v0[2] * s[1];
                        r[4] = v1[0] * c[2] - v1[1] * s[2]; r[5] = v1[1] * c[2] + v1[0] * s[2];
                        r[6] = v1[2] * c[3] - v1[3] * s[3]; r[7] = v1[3] * c[3] + v1[2] * s[3];
                    } else { r[0] = v0[0]; r[1] = v0[1]; r[2] = v0[2]; r[3] = v0[3]; r[4] = v1[0]; r[5] = v1[1]; r[6] = v1[2]; r[7] = v1[3]; }
                    if (sec == 1) {
#pragma unroll
                        for (int j = 0; j < 8; ++j) ks[bj][j] += r[j]; }
                    u32x4 w; w.x = cvt_pk_bf16(r[0], r[1]); w.y = cvt_pk_bf16(r[2], r[3]); w.z = cvt_pk_bf16(r[4], r[5]); w.w = cvt_pk_bf16(r[6], r[7]);
                    *(u32x4*)(rowp + bj * 128) = w; } }
        if (sec == 1) {
            const int b = (u.rt * 256) >> 13, n = (u.rt & 31);
#pragma unroll
            for (int bj = 0; bj < 2; ++bj) {
                const int h = (u.pn & 3) * 2 + bj;
#pragma unroll
                for (int j = 0; j < 8; ++j) ks[bj][j] = row16_sum(ks[bj][j]);
                if (fr == 0) { float* kp = km + ((size_t)(b * 8 + h) * 32 + n) * 128 + wc * 32 + 8 * fq;
#pragma unroll
                    for (int j = 0; j < 8; ++j) atomicAdd(kp + j, ks[bj][j] * (1.f / 256.f)); }
            }
        }
    }
};

constexpr int MOE_LDS_IDX = STAGE_BYTES;
constexpr int MOE_LDS_TILE_E = STAGE_BYTES + 12 * 1024;
constexpr int MOE_LDS_EBASE = MOE_LDS_TILE_E + 1280;
constexpr int MOE_LDS_ECNT = MOE_LDS_EBASE + 256;
struct MoeTabs { LAS int* idx; LAS int* tile_e; LAS int* ebase; LAS int* ecnt; int R; };
struct MoeGeo { int W, x, s, G, c; bool xcd; };
__device__ __forceinline__ MoeGeo moe_geo(int G, int c, int W) { MoeGeo g; g.xcd = (G == 256); g.W = W; g.x = c & 7; g.s = c >> 3; g.G = G; g.c = c; return g; }
template <int NPN>
__device__ __forceinline__ bool moe_unit(int i, const MoeGeo& g, int R, int& rt, int& pn) {
    if (g.xcd) {
        const int total = R * NPN, quota = (total + 7) >> 3, local = i * g.W + g.s, U = g.x * quota + local;
        rt = U / NPN; pn = U % NPN; return local < quota && U < total; }
    const long L = (long)i * g.G + g.c; rt = (int)(L / NPN); pn = (int)(L % NPN); return rt < R;
}
template <int NPN>
__device__ __forceinline__ MoeTabs moe_setup(const Frame& F, int layer, bool want_idx, const MoeGeo& geo) {
    MoeTabs M; M.idx = (LAS int*)(F.lds + MOE_LDS_IDX); M.tile_e = (LAS int*)(F.lds + MOE_LDS_TILE_E); M.ebase = (LAS int*)(F.lds + MOE_LDS_EBASE); M.ecnt = (LAS int*)(F.lds + MOE_LDS_ECNT);
    const unsigned* gcnt = (const unsigned*)(F.ws + ZB_MOECNT + layer * 256);
    if (F.tid < 64) {
        const int cnt = F.tid < 32 ? (int)gcnt[F.tid] : 0, nt = (cnt + 255) >> 8;
        int incl = nt;
#pragma unroll
        for (int o = 1; o < 32; o <<= 1) { const int y = __shfl_up(incl, o, 64); if (F.lane >= o) incl += y; }
        if (F.tid < 32) { M.ecnt[F.tid] = cnt; M.ebase[F.tid] = incl - nt; }
        if (F.tid == 31) M.ebase[32] = incl;
    }
    __syncthreads();
    M.R = M.ebase[32];
    if (F.tid < M.R) { int lo = 0, hi = 31;
        while (lo < hi) { const int mid = (lo + hi + 1) >> 1; if (M.ebase[mid] <= F.tid) lo = mid; else hi = mid - 1; }
        M.tile_e[F.tid] = lo; }
    __syncthreads();
    if (want_idx) {
        const int* vtok = (const int*)(F.ws + WS_VTOK);
        int tk[12];
#pragma unroll
        for (int i = 0; i < 12; ++i) { int rt, pn; tk[i] = 0;
            if (F.tid < 256 && moe_unit<NPN>(i, geo, M.R, rt, pn)) { const int e = M.tile_e[rt], v = (rt - M.ebase[e]) * 256 + F.tid; if (v < M.ecnt[e]) tk[i] = vtok[e * MOE_CAP + v]; } }
        if (F.tid < 256) {
#pragma unroll
            for (int i = 0; i < 12; ++i) M.idx[i * 256 + F.tid] = tk[i] >> 2; }
        __syncthreads();
    }
    return M;
}

template <int NPN>
__device__ __forceinline__ MoeTabs moe_setup(const Frame& F, int layer, bool want_idx, const MoeGeo& geo);
__device__ __forceinline__ MoeTabs moe_tabs_reuse(const Frame& F, int layer, const MoeGeo& geo) {
#if MK_MULTI
    return moe_setup<4>(F, layer, false, geo);
#endif
    MoeTabs M; M.idx = (LAS int*)(F.lds + MOE_LDS_IDX); M.tile_e = (LAS int*)(F.lds + MOE_LDS_TILE_E); M.ebase = (LAS int*)(F.lds + MOE_LDS_EBASE); M.ecnt = (LAS int*)(F.lds + MOE_LDS_ECNT);
    M.R = M.ebase[32]; return M;
}
struct MoeGateUp {
    static constexpr bool PERM = true, FP8 = true; static constexpr int KREP = MK_KREP;
    const unsigned char* A; const unsigned char* W; const float* bias; unsigned char* O; MoeTabs M; MoeGeo geo;
    __device__ __forceinline__ bool next(int i, Unit& u) const {
        if (!moe_unit<8>(i, geo, M.R, u.rt, u.pn)) return false;
        u.e = __builtin_amdgcn_readfirstlane(M.tile_e[u.rt]); u.ui = i; return true;
    }
    __device__ __forceinline__ void arows(const Unit& u, int R0, unsigned cofs, unsigned& v0, unsigned& v1, unsigned& v2, unsigned& v3) const {
        const LAS int* ip = M.idx + u.ui * 256 + R0;
        v0 = (unsigned)ip[0] * 1024u + cofs; v1 = (unsigned)ip[64] * 1024u + cofs; v2 = (unsigned)ip[128] * 1024u + cofs; v3 = (unsigned)ip[192] * 1024u + cofs;
    }
    __device__ __forceinline__ const char* abase() const { return (const char*)A; }
    __device__ __forceinline__ void bptr(const Unit& u, const char*& b0, const char*& b1) const {
        const unsigned char* w = W + (size_t)u.e * 2048 * KD; b0 = (const char*)(w + (size_t)(u.pn * 128) * KD); b1 = (const char*)(w + (size_t)(1024 + u.pn * 128) * KD);
    }
    __device__ __forceinline__ void binit(const Unit& u, int wc, int fq, f32x4 (&bi)[2][2]) const {
        const float* bp = bias + (size_t)u.e * 2048 + u.pn * 128 + wc * 32 + 8 * fq; constexpr float IS = FP8_WSCALE * MK_KREP;
        bi[0][0] = *(const f32x4*)bp * IS; bi[0][1] = *(const f32x4*)(bp + 4) * IS; bi[1][0] = *(const f32x4*)(bp + 1024) * IS; bi[1][1] = *(const f32x4*)(bp + 1028) * IS;
    }
    __device__ __forceinline__ void epi(const f32x4 (&acc)[2][2][4][2], const Unit& u, int wr, int wc, int fr, int fq) const {
        const int row0 = u.rt * 256 + wr * 64 + fr, col0 = u.pn * 128 + wc * 32 + 8 * fq;
        constexpr float SC = 1.f / (FP8_WSCALE * MK_KREP);
#pragma unroll
        for (int ai = 0; ai < 2; ++ai)
#pragma unroll
            for (int m = 0; m < 4; ++m) {
                unsigned wq[2];
#pragma unroll
                for (int n = 0; n < 2; ++n) {
                    f32x4 g = acc[ai][0][m][n] * SC, uu = acc[ai][1][m][n] * SC;
#pragma unroll
                    for (int j = 0; j < 4; ++j) { g[j] = fminf(g[j], 7.f); uu[j] = __builtin_amdgcn_fmed3f(uu[j], -7.f, 7.f); }
                    f32x4 t = g * (-1.702f * 1.4426950408889634f);
#pragma unroll
                    for (int j = 0; j < 4; ++j) t[j] = __builtin_amdgcn_exp2f(t[j]);
                    f32x4 d = t * (1.f / FP8_ASCALE) + (1.f / FP8_ASCALE);
#pragma unroll
                    for (int j = 0; j < 4; ++j) d[j] = __builtin_amdgcn_rcpf(d[j]);
                    const f32x4 o = (uu * g + g) * d;
                    wq[n] = pack_fp8x4_nc(o[0], o[1], o[2], o[3]);
                }
                u32x2 w; w.x = wq[0]; w.y = wq[1];
                *(u32x2*)(O + (size_t)(row0 + ai * 128 + m * 16) * 1024 + col0) = w;
            }
    }
};
struct MoeDown {
    static constexpr bool PERM = true, FP8 = true; static constexpr int KREP = MK_KREP;
    const unsigned char* A; const unsigned char* W; const float* bias; unsigned char* O; MoeTabs M; MoeGeo geo;
    __device__ __forceinline__ bool next(int i, Unit& u) const {
        if (!moe_unit<4>(i, geo, M.R, u.rt, u.pn)) return false;
        u.e = __builtin_amdgcn_readfirstlane(M.tile_e[u.rt]); u.ui = i; return true;
    }
    __device__ __forceinline__ void arows(const Unit& u, int R0, unsigned cofs, unsigned& v0, unsigned& v1, unsigned& v2, unsigned& v3) const {
        const unsigned base = (unsigned)(u.rt * 256 + R0) * 1024u + cofs; v0 = base; v1 = base + 64u * 1024u; v2 = base + 128u * 1024u; v3 = base + 192u * 1024u;
    }
    __device__ __forceinline__ const char* abase() const { return (const char*)A; }
    __device__ __forceinline__ void bptr(const Unit& u, const char*& b0, const char*& b1) const { b0 = (const char*)(W + (size_t)u.e * 1024 * KD + (size_t)u.pn * 256 * KD); b1 = b0 + (size_t)128 * KD; }
    __device__ __forceinline__ void binit(const Unit& u, int wc, int fq, f32x4 (&bi)[2][2]) const {
        const float* bp = bias + (size_t)u.e * 1024 + u.pn * 256 + wc * 32 + 8 * fq; constexpr float IS = FP8_WSCALE * FP8_ASCALE * MK_KREP;
#pragma unroll
        for (int bj = 0; bj < 2; ++bj) { bi[bj][0] = *(const f32x4*)(bp + bj * 128) * IS; bi[bj][1] = *(const f32x4*)(bp + bj * 128 + 4) * IS; }
    }
    __device__ __forceinline__ void epi(const f32x4 (&acc)[2][2][4][2], const Unit& u, int wr, int wc, int fr, int fq) const {
        const int row0 = u.rt * 256 + wr * 64 + fr, col0 = u.pn * 256 + wc * 32 + 8 * fq;
        constexpr float SC = FP8_YSCALE / (FP8_WSCALE * FP8_ASCALE * MK_KREP);
#pragma unroll
        for (int ai = 0; ai < 2; ++ai)
#pragma unroll
            for (int m = 0; m < 4; ++m) { unsigned char* rowp = O + (size_t)(row0 + ai * 128 + m * 16) * 1024 + col0;
#pragma unroll
                for (int bj = 0; bj < 2; ++bj) { f32x4 v0 = acc[ai][bj][m][0] * SC, v1 = acc[ai][bj][m][1] * SC;
#pragma unroll
                    for (int j = 0; j < 4; ++j) { v0[j] = __builtin_amdgcn_fmed3f(v0[j], -448.f, 448.f); v1[j] = __builtin_amdgcn_fmed3f(v1[j], -448.f, 448.f); }
                    u32x2 w; w.x = pack_fp8x4_nc(v0[0], v0[1], v0[2], v0[3]); w.y = pack_fp8x4_nc(v1[0], v1[1], v1[2], v1[3]);
                    *(u32x2*)(rowp + bj * 128) = w; } }
    }
};
}

template <int OFF> __device__ __forceinline__ s16x4 ds_tr_read(int vb) {
    s16x4 r; asm volatile("ds_read_b64_tr_b16 %0, %1 offset:%2" : "=&v"(r) : "v"(vb), "i"(OFF) : "memory"); return r;
}
constexpr int S5_PITCH = 136, S5_IMG = 128 * S5_PITCH;

template <bool FULL>
__device__ __forceinline__ void phase_s5(const Frame& F, const bf16_t* __restrict__ U, bf16_t* __restrict__ Z, unsigned char* __restrict__ Z8) {
    const int lane = F.lane, n = lane & 31, h = lane >> 5;
    const float* tab = (const float*)(F.ws + WS_S5A);
    const bf16_t* bop = (const bf16_t*)(F.ws + WS_BOP); const bf16_t* cop = (const bf16_t*)(F.ws + WS_COP);
    float* carry = (float*)(F.ws + WS_CARRY);
    const float* dsk = F.in[L0_D];
    LAS unsigned char* xt = F.lds + F.wave * S5_IMG;
    for (int w = F.c; w < 2048; w += F.G) {
        const int g = (w & 7) * 8 + F.wave, chunk = (w >> 3) & 127, b = w >> 10;
        const int tok0 = b * SEQ + chunk * 64;
        bf16x8 Aop[2], Bop[4];
#pragma unroll
        for (int mt = 0; mt < 2; ++mt) { const int time = 32 * ((n >> 2) & 1) + 16 * mt + 4 * (n >> 3) + (n & 3);
            Aop[mt] = *(const bf16x8*)(U + (size_t)(tok0 + time) * DM + g * 16 + 8 * h); }
#pragma unroll
        for (int nt = 0; nt < 4; ++nt) Bop[nt] = *(const bf16x8*)(bop + (size_t)((g * 128 + nt * 32 + n) * 16 + 8 * h));
        f32x16 acc[2][4];
#pragma unroll
        for (int mt = 0; mt < 2; ++mt)
#pragma unroll
            for (int nt = 0; nt < 4; ++nt) { f32x16 z = {}; acc[mt][nt] = __builtin_amdgcn_mfma_f32_32x32x16_bf16(Aop[mt], Bop[nt], z, 0, 0, 0); }
        const float a0r = tab[g * 64 + n], a0i = tab[4096 + g * 64 + n], a1r = tab[g * 64 + 32 + n], a1i = tab[4096 + g * 64 + 32 + n];
        float* cp = carry + ((size_t)(b * 256 + chunk * 2 + h) * 64 + g) * 128;
        float x0r = 0.f, x0i = 0.f, x1r = 0.f, x1i = 0.f;
        if (FULL) { x0r = cp[n]; x0i = cp[64 + n]; x1r = cp[32 + n]; x1i = cp[96 + n]; }
#pragma unroll
        for (int mt = 0; mt < 2; ++mt)
#pragma unroll
            for (int r = 0; r < 16; ++r) {
                const float n0r = fmaf(a0r, x0r, fmaf(-a0i, x0i, acc[mt][0][r])), n0i = fmaf(a0r, x0i, fmaf(a0i, x0r, acc[mt][2][r]));
                const float n1r = fmaf(a1r, x1r, fmaf(-a1i, x1i, acc[mt][1][r])), n1i = fmaf(a1r, x1i, fmaf(a1i, x1r, acc[mt][3][r]));
                x0r = n0r; x0i = n0i; x1r = n1r; x1i = n1i;
                acc[mt][0][r] = x0r; acc[mt][2][r] = x0i; acc[mt][1][r] = x1r; acc[mt][3][r] = x1i;
            }
        if (!FULL) { cp[n] = x0r; cp[64 + n] = x0i; cp[32 + n] = x1r; cp[96 + n] = x1i; continue; }
#pragma unroll
        for (int mt = 0; mt < 2; ++mt)
#pragma unroll
            for (int nt = 0; nt < 4; ++nt)
#pragma unroll
                for (int q = 0; q < 4; ++q) {
                    u32x2 pk; pk.x = cvt_pk_bf16(acc[mt][nt][4 * q + 0], acc[mt][nt][4 * q + 1]); pk.y = cvt_pk_bf16(acc[mt][nt][4 * q + 2], acc[mt][nt][4 * q + 3]);
                    *(LAS u32x2*)(xt + (nt * 32 + n) * S5_PITCH + (32 * h + 16 * mt + 4 * q) * 2) = pk;
                }
        const int ch = lane & 15, kg = lane >> 4;
        bf16x8 Cf[4];
#pragma unroll
        for (int ks = 0; ks < 4; ++ks) Cf[ks] = *(const bf16x8*)(cop + (size_t)((g * 16 + ch) * 128 + 32 * ks + 8 * kg));
        const int trb = (int)(uintptr_t)xt + (8 * kg + (ch >> 2)) * S5_PITCH + (4 * (ch & 3)) * 2;
        f32x4 y[4];
#pragma unroll
        for (int tb = 0; tb < 4; ++tb) y[tb] = (f32x4){0.f, 0.f, 0.f, 0.f};
        asm volatile("s_waitcnt lgkmcnt(0)" ::: "memory");
#define S5_TR(tb, ks, hi4) ds_tr_read<(32 * (ks) + 4 * (hi4)) * S5_PITCH + 32 * (tb)>(trb)
#define S5_STEP(tb, ks) do { const s16x4 lo = S5_TR(tb, ks, 0), hi = S5_TR(tb, ks, 1); asm volatile("s_waitcnt lgkmcnt(0)" ::: "memory"); __builtin_amdgcn_sched_barrier(0); \
            const bf16x8 bf = (bf16x8){lo[0], lo[1], lo[2], lo[3], hi[0], hi[1], hi[2], hi[3]}; y[tb] = __builtin_amdgcn_mfma_f32_16x16x32_bf16(Cf[ks], bf, y[tb], 0, 0, 0); } while (0)
        S5_STEP(0, 0); S5_STEP(0, 1); S5_STEP(0, 2); S5_STEP(0, 3);
        S5_STEP(1, 0); S5_STEP(1, 1); S5_STEP(1, 2); S5_STEP(1, 3);
        S5_STEP(2, 0); S5_STEP(2, 1); S5_STEP(2, 2); S5_STEP(2, 3);
        S5_STEP(3, 0); S5_STEP(3, 1); S5_STEP(3, 2); S5_STEP(3, 3);
#undef S5_STEP
#undef S5_TR
        const f32x4 dv = *(const f32x4*)(dsk + g * 16 + 4 * kg);
#pragma unroll
        for (int tb = 0; tb < 4; ++tb) {
            const size_t o = (size_t)(tok0 + 16 * tb + ch) * DM + g * 16 + 4 * kg;
            const u32x2 uu = *(const u32x2*)(U + o);
            const float y0 = y[tb][0] + dv[0] * bf_lo(uu.x), y1 = y[tb][1] + dv[1] * bf_hi(uu.x), y2 = y[tb][2] + dv[2] * bf_lo(uu.y), y3 = y[tb][3] + dv[3] * bf_hi(uu.y);
            const float z0 = gelu_tanh(y0), z1 = gelu_tanh(y1), z2 = gelu_tanh(y2), z3 = gelu_tanh(y3);
            u32x2 zz; zz.x = cvt_pk_bf16(z0, z1); zz.y = cvt_pk_bf16(z2, z3);
            *(u32x2*)(Z + o) = zz;
            *(unsigned*)(Z8 + o) = pack_fp8x4(z0, z1, z2, z3);
        }
    }
}

__device__ __forceinline__ void phase_s5_carry(const Frame& F) {
    const float* tab = (const float*)(F.ws + WS_S5A);
    float* carry = (float*)(F.ws + WS_CARRY);
    LAS float* E = (LAS float*)F.lds;
    for (int pair = F.c; pair < 128; pair += F.G) {
        const int b = pair >> 6, g = pair & 63, p = F.lane, w = F.wave;
        const float ar = tab[8192 + g * 64 + p], ai = tab[12288 + g * 64 + p];
        float* ptr = carry + ((size_t)(b * 256 + 32 * w) * 64 + g) * 128 + p;
        float cr[32], ci[32];
#pragma unroll
        for (int j = 0; j < 32; ++j) { cr[j] = ptr[(size_t)j * 8192]; ci[j] = ptr[(size_t)j * 8192 + 64]; }
        float xr = 0.f, xi = 0.f;
#pragma unroll
        for (int j = 0; j < 32; ++j) { const float nr = fmaf(ar, xr, fmaf(-ai, xi, cr[j])), ni = fmaf(ar, xi, fmaf(ai, xr, ci[j])); xr = nr; xi = ni; }
        E[(w * 2 + 0) * 64 + p] = xr; E[(w * 2 + 1) * 64 + p] = xi;
        float sr = ar, si = ai;
#pragma unroll
        for (int q = 0; q < 5; ++q) { const float nr = sr * sr - si * si, ni = 2.f * sr * si; sr = nr; si = ni; }
        __syncthreads();
        xr = 0.f; xi = 0.f;
        for (int v = 0; v < w; ++v) { const float er = E[(v * 2 + 0) * 64 + p], ei = E[(v * 2 + 1) * 64 + p];
            const float nr = fmaf(sr, xr, fmaf(-si, xi, er)), ni = fmaf(sr, xi, fmaf(si, xr, ei)); xr = nr; xi = ni; }
#pragma unroll
        for (int j = 0; j < 32; ++j) {
            ptr[(size_t)j * 8192] = xr; ptr[(size_t)j * 8192 + 64] = xi;
            const float nr = fmaf(ar, xr, fmaf(-ai, xi, cr[j])), ni = fmaf(ar, xi, fmaf(ai, xr, ci[j])); xr = nr; xi = ni;
        }
        __syncthreads();
    }
}

template <bool FINAL, class XT>
__device__ __forceinline__ void phase_moe_combine(const Frame& F, int layer, const XT* xold, const bf16_t* mres, bf16_t* xnew, const float* gamma_next, unsigned char* hnext, float* outp) {
    LAS int* ebase = (LAS int*)F.lds;
    const unsigned* gcnt = (const unsigned*)(F.ws + ZB_MOECNT + layer * 256);
    if (F.tid < 64) {
        const int nt = F.tid < 32 ? (((int)gcnt[F.tid] + 255) >> 8) : 0;
        int incl = nt;
#pragma unroll
        for (int o = 1; o < 32; o <<= 1) { const int y = __shfl_up(incl, o, 64); if (F.lane >= o) incl += y; }
        if (F.tid < 32) ebase[F.tid] = incl - nt;
    }
    __syncthreads();
    const int* pos = (const int*)(F.ws + WS_TOPK); const float* gates = (const float*)(F.ws + WS_TOPK + (size_t)T * 4 * 4);
    const unsigned char* yk = F.ws + WS_YK;
    const int lane = F.lane;
    for (int r0 = F.c * 8 + F.wave; r0 < T; r0 += F.G * 16) {
        const int r1 = (r0 + F.G * 8 < T) ? r0 + F.G * 8 : r0;
        u32x4 pp[2]; f32x4 gg[2];
        pp[0] = *(const u32x4*)(pos + (size_t)r0 * 4); pp[1] = *(const u32x4*)(pos + (size_t)r1 * 4);
        gg[0] = *(const f32x4*)(gates + (size_t)r0 * 4); gg[1] = *(const f32x4*)(gates + (size_t)r1 * 4);
        f32x4 xo[2][4]; u32x2 yv[2][4][2]; u32x4 mv[2][2];
#pragma unroll
        for (int q = 0; q < 2; ++q) { const int r = q ? r1 : r0;
#pragma unroll
            for (int i = 0; i < 2; ++i) { mv[q][i] = *(const u32x4*)(mres + (size_t)r * DM + 512 * i + 8 * lane);
#pragma unroll
                for (int h = 0; h < 2; ++h) xo[q][2 * i + h] = load_x4(xold + (size_t)r * DM + 512 * i + 8 * lane + 4 * h); }
#pragma unroll
            for (int k = 0; k < 4; ++k) { const int pk = (int)pp[q][k], e = pk >> 14, v = pk & 16383; const size_t phys = (size_t)ebase[e] * 256 + v;
#pragma unroll
                for (int i = 0; i < 2; ++i) yv[q][k][i] = *(const u32x2*)(yk + phys * 1024 + 512 * i + 8 * lane); } }
#pragma unroll
        for (int q = 0; q < 2; ++q) {
            const int r = q ? r1 : r0, b = r >> 13;
            const float* g2 = ada_vec(F, layer, b, 5);
            { const float* g1 = ada_vec(F, layer, b, 2);
#pragma unroll
              for (int i = 0; i < 2; ++i) { const f32x4 ga = *(const f32x4*)(g1 + 512 * i + 8 * lane), gb = *(const f32x4*)(g1 + 512 * i + 8 * lane + 4); const u32x4 m = mv[q][i];
                xo[q][2 * i][0] = fmaf(ga[0], bf_lo(m.x), xo[q][2 * i][0]); xo[q][2 * i][1] = fmaf(ga[1], bf_hi(m.x), xo[q][2 * i][1]);
                xo[q][2 * i][2] = fmaf(ga[2], bf_lo(m.y), xo[q][2 * i][2]); xo[q][2 * i][3] = fmaf(ga[3], bf_hi(m.y), xo[q][2 * i][3]);
                xo[q][2 * i + 1][0] = fmaf(gb[0], bf_lo(m.z), xo[q][2 * i + 1][0]); xo[q][2 * i + 1][1] = fmaf(gb[1], bf_hi(m.z), xo[q][2 * i + 1][1]);
                xo[q][2 * i + 1][2] = fmaf(gb[2], bf_lo(m.w), xo[q][2 * i + 1][2]); xo[q][2 * i + 1][3] = fmaf(gb[3], bf_hi(m.w), xo[q][2 * i + 1][3]); } }
            float acc[16];
#pragma unroll
            for (int j = 0; j < 16; ++j) acc[j] = 0.f;
#pragma unroll
            for (int k = 0; k < 4; ++k) { const float gk = gg[q][k] * (1.f / FP8_YSCALE);
#pragma unroll
                for (int i = 0; i < 2; ++i) { const u32x2 w = yv[q][k][i];
                    const f32x2 p0 = __builtin_amdgcn_cvt_pk_f32_fp8((int)w.x, false), p1 = __builtin_amdgcn_cvt_pk_f32_fp8((int)w.x, true);
                    const f32x2 p2 = __builtin_amdgcn_cvt_pk_f32_fp8((int)w.y, false), p3 = __builtin_amdgcn_cvt_pk_f32_fp8((int)w.y, true);
                    acc[8 * i + 0] = fmaf(gk, p0[0], acc[8 * i + 0]); acc[8 * i + 1] = fmaf(gk, p0[1], acc[8 * i + 1]);
                    acc[8 * i + 2] = fmaf(gk, p1[0], acc[8 * i + 2]); acc[8 * i + 3] = fmaf(gk, p1[1], acc[8 * i + 3]);
                    acc[8 * i + 4] = fmaf(gk, p2[0], acc[8 * i + 4]); acc[8 * i + 5] = fmaf(gk, p2[1], acc[8 * i + 5]);
                    acc[8 * i + 6] = fmaf(gk, p3[0], acc[8 * i + 6]); acc[8 * i + 7] = fmaf(gk, p3[1], acc[8 * i + 7]); } }
            float xn[16]; float ss = 0.f;
#pragma unroll
            for (int i = 0; i < 2; ++i)
#pragma unroll
                for (int h = 0; h < 2; ++h) { const int col = 512 * i + 8 * lane + 4 * h;
                    const f32x4 gv = *(const f32x4*)(g2 + col);
                    f32x4 xv;
#pragma unroll
                    for (int j = 0; j < 4; ++j) { xv[j] = xo[q][2 * i + h][j] + gv[j] * acc[8 * i + 4 * h + j]; xn[8 * i + 4 * h + j] = xv[j]; ss += xv[j] * xv[j]; }
                    if (!FINAL) { u32x2 xw; xw.x = cvt_pk_bf16(xv[0], xv[1]); xw.y = cvt_pk_bf16(xv[2], xv[3]); *(u32x2*)(xnew + (size_t)r * DM + col) = xw; } }
            ss = wave_sum(ss);
            const float rs = rsqrtf(ss * (1.f / 1024.f) + 1e-6f);
            if (FINAL) {
#pragma unroll
                for (int i = 0; i < 2; ++i)
#pragma unroll
                    for (int h = 0; h < 2; ++h) { const int col = 512 * i + 8 * lane + 4 * h; const f32x4 g = *(const f32x4*)(gamma_next + col);
                        f32x4 o;
#pragma unroll
                        for (int j = 0; j < 4; ++j) o[j] = xn[8 * i + 4 * h + j] * rs * g[j];
                        *(f32x4*)(outp + (size_t)r * DM + col) = o; }
            } else {
                const float* sh = ada_vec(F, layer + 1, b, 0); const float* sc = ada_vec(F, layer + 1, b, 1);
#pragma unroll
                for (int i = 0; i < 2; ++i) { const int col = 512 * i + 8 * lane;
                    float yv8[8];
#pragma unroll
                    for (int h = 0; h < 2; ++h) { const f32x4 g = *(const f32x4*)(gamma_next + col + 4 * h), s1 = *(const f32x4*)(sc + col + 4 * h), s0 = *(const f32x4*)(sh + col + 4 * h);
#pragma unroll
                        for (int j = 0; j < 4; ++j) yv8[4 * h + j] = xn[8 * i + 4 * h + j] * rs * g[j] * (1.f + s1[j]) + s0[j]; }
                    u32x2 w; w.x = pack_fp8x4(yv8[0], yv8[1], yv8[2], yv8[3]); w.y = pack_fp8x4(yv8[4], yv8[5], yv8[6], yv8[7]);
                    *(u32x2*)(hnext + (size_t)r * DM + col) = w; }
            }
        }
    }
    __syncthreads();
}

__device__ __forceinline__ void phase_kmean(const Frame& F, const bf16_t* __restrict__ K) {
    LAS float* red = (LAS float*)F.lds;
    float* km = (float*)(F.ws + WS_KMEAN);
    for (int u = F.c; u < 512; u += F.G) {
        const int h = u & 7, n = (u >> 3) & 31, b = u >> 8;
        const int colc = F.tid & 15, rg = F.tid >> 4;
        const bf16_t* base = K + ((size_t)(b * SEQ + n * 256 + rg * 8)) * DM + h * 128 + colc * 8;
        float acc[8];
#pragma unroll
        for (int j = 0; j < 8; ++j) acc[j] = 0.f;
#pragma unroll
        for (int r = 0; r < 8; ++r) { const u32x4 w = *(const u32x4*)(base + (size_t)r * DM);
            acc[0] += bf_lo(w.x); acc[1] += bf_hi(w.x); acc[2] += bf_lo(w.y); acc[3] += bf_hi(w.y); acc[4] += bf_lo(w.z); acc[5] += bf_hi(w.z); acc[6] += bf_lo(w.w); acc[7] += bf_hi(w.w); }
#pragma unroll
        for (int j = 0; j < 8; ++j) red[rg * 128 + colc * 8 + j] = acc[j];
        __syncthreads();
        if (F.tid < 128) { float s = 0.f;
#pragma unroll
            for (int q = 0; q < 32; ++q) s += red[q * 128 + F.tid];
            km[((size_t)(b * 8 + h) * 32 + n) * 128 + F.tid] = s * (1.f / 256.f); }
        __syncthreads();
    }
}

__device__ __forceinline__ int alist_base(int n) { return 256 * (31 * n - (n * (n - 1)) / 2); }

__device__ __forceinline__ void phase_gating(const Frame& F, const bf16_t* __restrict__ Q) {
    LAS float* kml = (LAS float*)F.lds;
    LAS int* cntl = (LAS int*)(F.lds + 16384); LAS int* basel = cntl + 32; LAS int* entl = cntl + 64;
    const float* km = (const float*)(F.ws + WS_KMEAN);
    unsigned* gcnt = (unsigned*)(F.ws + ZB_ATTCNT);
    int* alist = (int*)(F.ws + WS_ALIST);
    for (int u = F.c; u < 256; u += F.G) {
        const int jp = u & 15, h = (u >> 4) & 7, b = u >> 7, bh = b * 8 + h;
        for (int i = F.tid; i < 4096; i += NTHREADS) kml[i] = km[(size_t)bh * 4096 + i];
        if (F.tid < 32) cntl[F.tid] = 0;
        __syncthreads();
        const int s = jp * 512 + F.tid, j = __builtin_amdgcn_readfirstlane(s >> 8);
        u32x4 q[16];
        { const bf16_t* qp = Q + (size_t)(b * SEQ + s) * DM + h * 128;
#pragma unroll
          for (int i = 0; i < 16; ++i) q[i] = *(const u32x4*)(qp + 8 * i); }
        float v0 = -INFINITY, v1 = -INFINITY, v2 = -INFINITY; int i0 = 0, i1 = 0, i2 = 0;
#pragma unroll 1
        for (int n = 0; n < j; ++n) {
            float d = 0.f;
#pragma unroll
            for (int i = 0; i < 16; ++i) { const f32x4 ka = *(const LAS f32x4*)(kml + n * 128 + 8 * i), kb = *(const LAS f32x4*)(kml + n * 128 + 8 * i + 4);
                d = fmaf(bf_lo(q[i].x), ka[0], d); d = fmaf(bf_hi(q[i].x), ka[1], d); d = fmaf(bf_lo(q[i].y), ka[2], d); d = fmaf(bf_hi(q[i].y), ka[3], d);
                d = fmaf(bf_lo(q[i].z), kb[0], d); d = fmaf(bf_hi(q[i].z), kb[1], d); d = fmaf(bf_lo(q[i].w), kb[2], d); d = fmaf(bf_hi(q[i].w), kb[3], d); }
            if (d > v0) { v2 = v1; i2 = i1; v1 = v0; i1 = i0; v0 = d; i0 = n; }
            else if (d > v1) { v2 = v1; i2 = i1; v1 = d; i1 = n; }
            else if (d > v2) { v2 = d; i2 = n; }
        }
        const int nsel = j < 3 ? j : 3;
        if (nsel > 0) entl[F.tid * 3 + 0] = (i0 << 16) | __hip_atomic_fetch_add(&cntl[i0], 1, __ATOMIC_RELAXED, __HIP_MEMORY_SCOPE_WORKGROUP);
        if (nsel > 1) entl[F.tid * 3 + 1] = (i1 << 16) | __hip_atomic_fetch_add(&cntl[i1], 1, __ATOMIC_RELAXED, __HIP_MEMORY_SCOPE_WORKGROUP);
        if (nsel > 2) entl[F.tid * 3 + 2] = (i2 << 16) | __hip_atomic_fetch_add(&cntl[i2], 1, __ATOMIC_RELAXED, __HIP_MEMORY_SCOPE_WORKGROUP);
        __syncthreads();
        if (F.tid < 32) basel[F.tid] = cntl[F.tid] ? (int)atomicAdd(&gcnt[bh * 32 + F.tid], (unsigned)cntl[F.tid]) : 0;
        __syncthreads();
#pragma unroll
        for (int k = 0; k < 3; ++k) if (k < nsel) { const int en = entl[F.tid * 3 + k], n = en >> 16, v = basel[n] + (en & 0xffff);
            alist[(size_t)bh * ALIST_PER_BH + alist_base(n) + v] = s | (k << 16); }
        __syncthreads();
    }
}

namespace at {
constexpr int D = 128, NW = 8, QBLK = 32, KVBLK = 64, LDK = 1024, NT = 4;
constexpr float SCALE = 0.088388347648318440f, THR = 8.f, CL2 = SCALE * 1.4426950408889634f;
constexpr int SHM_V = KVBLK * D * 2, SHM_K = KVBLK * D * 2, SHM_WS = NW * 8704  , SHM_ATTN = SHM_WS + NW * 96 * 4;
constexpr int LDS_PRE = 73728;
#define KSWZ(row, colB) ((row) * 256 + ((colB) ^ (((row) & 7) << 4)))
#define SBAR() __builtin_amdgcn_sched_barrier(0)
__device__ __forceinline__ int crow(int r, int hi) { return (r & 3) + 8 * (r >> 2) + 4 * hi; }
__device__ __forceinline__ void partialSM(f32x16& p0, f32x16& p1, float& m_reg, float& mn, float& alpha) {
    float pmax = p0[0];
#pragma unroll
    for (int r = 1; r < 16; ++r) pmax = fmaxf(pmax, p0[r]);
#pragma unroll
    for (int r = 0; r < 16; ++r) pmax = fmaxf(pmax, p1[r]);
    { auto rr = __builtin_amdgcn_permlane32_swap(__float_as_uint(pmax), __float_as_uint(pmax), false, false);
      pmax = fmaxf(__uint_as_float(rr[0]), __uint_as_float(rr[1])); }
    if (__builtin_expect(__all(pmax - m_reg <= THR / SCALE), 1)) { mn = m_reg; alpha = 1.f; }
    else { mn = fmaxf(m_reg, pmax); alpha = __builtin_amdgcn_exp2f((m_reg - mn) * CL2); m_reg = mn; }
    const float mnC = -mn * CL2;
#pragma unroll
    for (int r = 0; r < 16; ++r) p0[r] = fmaf(p0[r], CL2, mnC);
#pragma unroll
    for (int r = 0; r < 16; ++r) p1[r] = fmaf(p1[r], CL2, mnC);
#pragma unroll
    for (int r = 0; r < 16; ++r) p0[r] = __builtin_amdgcn_exp2f(p0[r]);
}
__device__ __forceinline__ void finishSM(f32x16& p0, f32x16& p1, float alpha, float& l_reg, bf16x8& pa0, bf16x8& pa1, bf16x8& pa2, bf16x8& pa3) {
#pragma unroll
    for (int r = 0; r < 16; ++r) p1[r] = __builtin_amdgcn_exp2f(p1[r]);
    float ps = 0;
#pragma unroll
    for (int r = 0; r < 16; ++r) ps += p0[r];
#pragma unroll
    for (int r = 0; r < 16; ++r) ps += p1[r];
    { auto rr = __builtin_amdgcn_permlane32_swap(__float_as_uint(ps), __float_as_uint(ps), false, false);
      ps = __uint_as_float(rr[0]) + __uint_as_float(rr[1]); }
    l_reg = l_reg * alpha + ps;
#define PK4(P, BASE, OUT) do { unsigned a0 = cvt_pk_bf16(P[BASE + 0], P[BASE + 1]), a1 = cvt_pk_bf16(P[BASE + 2], P[BASE + 3]);   \
    unsigned b0 = cvt_pk_bf16(P[BASE + 4], P[BASE + 5]), b1 = cvt_pk_bf16(P[BASE + 6], P[BASE + 7]);                              \
    auto r0 = __builtin_amdgcn_permlane32_swap(a0, b0, false, false); auto r1 = __builtin_amdgcn_permlane32_swap(a1, b1, false, false); \
    u32x4 w = {r0[0], r1[0], r0[1], r1[1]}; OUT = *reinterpret_cast<bf16x8*>(&w); } while (0)
    PK4(p0, 0, pa0); PK4(p0, 8, pa1); PK4(p1, 0, pa2); PK4(p1, 8, pa3);
#undef PK4
}
__device__ __forceinline__ void qkt(f32x16& p0, f32x16& p1, const char* Ks, const bf16x8* qr, int r32, int hi) {
    p0 = f32x16{}; p1 = f32x16{};
#pragma unroll
    for (int d0 = 0; d0 < 8; ++d0) { const int cb = (d0 * 16 + hi * 8) * 2;
        const bf16x8 b0 = *reinterpret_cast<const bf16x8*>(Ks + KSWZ(r32, cb));
        const bf16x8 b1 = *reinterpret_cast<const bf16x8*>(Ks + KSWZ(32 + r32, cb));
        p0 = __builtin_amdgcn_mfma_f32_32x32x16_bf16(b0, qr[d0], p0, 0, 0, 0);
        p1 = __builtin_amdgcn_mfma_f32_32x32x16_bf16(b1, qr[d0], p1, 0, 0, 0); }
}
__device__ __forceinline__ void causal_mask(f32x16& p0, f32x16& p1, int kt, int qrow, int hi) {
#pragma unroll
    for (int r = 0; r < 16; ++r) { const int key = kt * 64 + crow(r, hi); if (key > qrow) p0[r] = -1e30f; if (key + 32 > qrow) p1[r] = -1e30f; }
}
__device__ __forceinline__ int v_st(int k, int c) { const int kk = (k & ~0xC) | ((k & 4) << 1) | ((k & 8) >> 1); return ((kk >> 3) * 4 + (c >> 5)) * 512 + ((kk & 7) * 32 + (c & 31)) * 2; }
__device__ __forceinline__ int v_rd_base(int lane) { return ((lane & 3) << 3) | (((lane >> 2) & 3) << 6) | (((lane >> 4) & 1) << 5) | (((lane >> 5) & 1) << 8); }
constexpr int v_rd_off(int d0, int ks, int half) { return d0 * 512 + ks * 4096 + half * 2048; }
template <int D0> __device__ __forceinline__ void pv_one(f32x16& od, int vb, bf16x8 pa0, bf16x8 pa1, bf16x8 pa2, bf16x8 pa3) {
    const s16x4 l0 = ds_tr_read<v_rd_off(D0, 0, 0)>(vb), h0 = ds_tr_read<v_rd_off(D0, 0, 1)>(vb), l1 = ds_tr_read<v_rd_off(D0, 1, 0)>(vb), h1 = ds_tr_read<v_rd_off(D0, 1, 1)>(vb);
    const s16x4 l2 = ds_tr_read<v_rd_off(D0, 2, 0)>(vb), h2 = ds_tr_read<v_rd_off(D0, 2, 1)>(vb), l3 = ds_tr_read<v_rd_off(D0, 3, 0)>(vb), h3 = ds_tr_read<v_rd_off(D0, 3, 1)>(vb);
    asm volatile("s_waitcnt lgkmcnt(0)" ::: "memory"); SBAR();
#define PK(L, H) (bf16x8){L[0], L[1], L[2], L[3], H[0], H[1], H[2], H[3]}
    od = __builtin_amdgcn_mfma_f32_32x32x16_bf16(pa0, PK(l0, h0), od, 0, 0, 0);
    od = __builtin_amdgcn_mfma_f32_32x32x16_bf16(pa1, PK(l1, h1), od, 0, 0, 0);
    od = __builtin_amdgcn_mfma_f32_32x32x16_bf16(pa2, PK(l2, h2), od, 0, 0, 0);
    od = __builtin_amdgcn_mfma_f32_32x32x16_bf16(pa3, PK(l3, h3), od, 0, 0, 0);
#undef PK
}
__device__ __forceinline__ void pv_d0(f32x16* o, int vb, bf16x8 pa0, bf16x8 pa1, bf16x8 pa2, bf16x8 pa3) {
    pv_one<0>(o[0], vb, pa0, pa1, pa2, pa3); pv_one<1>(o[1], vb, pa0, pa1, pa2, pa3); pv_one<2>(o[2], vb, pa0, pa1, pa2, pa3); pv_one<3>(o[3], vb, pa0, pa1, pa2, pa3);
}

struct AUnit { unsigned qoff; unsigned kv; int dst; bool causal; };
__device__ __forceinline__ bool attn_decode(int u, int total, const bf16_t* Q, const int* alist, const LAS int* pre, const LAS int* cntl, int wid, int r32, AUnit& D) {
    if (u >= total) return false;
    int bh, n;
    if (u < 512) {
        bh = u >> 5; n = u & 31; D.causal = true;
        const int b = bh >> 3, h = bh & 7, s = n * 256 + wid * 32 + r32; const size_t t = (size_t)b * SEQ + s;
        D.qoff = (unsigned)(t * DM + h * 128); D.dst = (int)((t * 8 + h) * 4 + 3);
    } else {
        const int ut = u - 512; int lo = 0, hi_ = 511;
        while (lo < hi_) { const int mid = (lo + hi_ + 1) >> 1; if (pre[mid] <= ut) lo = mid; else hi_ = mid - 1; }
        bh = lo >> 5; n = lo & 31; D.causal = false;
        const int tile = ut - pre[lo], cntv = cntl[lo], idx = tile * 256 + wid * 32 + r32;
        const int b = bh >> 3, h = bh & 7;
        const int en = alist[(size_t)bh * ALIST_PER_BH + alist_base(n) + (idx < cntv ? idx : cntv - 1)];
        const int s = en & 0xffff, k = en >> 16; const size_t t = (size_t)b * SEQ + s;
        D.qoff = (unsigned)(t * DM + h * 128); D.dst = idx < cntv ? (int)((t * 8 + h) * 4 + k) : -1;
    }
    D.kv = (unsigned)(((size_t)(bh >> 3) * SEQ + n * 256) * DM + (bh & 7) * 128);
    return true;
}

__device__ __forceinline__ void attn_stream(const bf16_t* __restrict__ Q, const bf16_t* __restrict__ K, const bf16_t* __restrict__ V, const int* __restrict__ alist,
                                            const LAS int* pre, const LAS int* cntl, int total, int c, int G,
                                            unsigned char* __restrict__ part, float* __restrict__ lse, char* lds) {
    const int tid = threadIdx.x, wid = tid >> 6, lane = tid & 63, r32 = lane & 31, hi = lane >> 5;
    char* V_lds = lds; char* K_lds = lds + 2 * SHM_V;
    float* wsl = (float*)(lds + SHM_WS) + wid * 96; float* li_l = wsl; float* al_l = wsl + 32; int* dst_l = (int*)(wsl + 64);
#define TZ() ({ int _t = threadIdx.x; asm volatile("" : "+v"(_t)); _t; })
#define qrow_i ((TZ() >> 6) * 32 + (TZ() & 31))
#define vb0 ((int)(uintptr_t)V_lds + v_rd_base(TZ() & 63))
    struct { bf16x8 vs0, vs1, ks0, ks1; } sr_[2];
#define SLOAD(i, KP, VP, k0) do { const int _tz = TZ(), sr = _tz >> 4, sc = (_tz & 15) * 8; sr_[i].vs0 = *(const bf16x8*)(&(VP)[(long)((k0) + sr) * LDK + sc]); sr_[i].vs1 = *(const bf16x8*)(&(VP)[(long)((k0) + 32 + sr) * LDK + sc]); \
    sr_[i].ks0 = *(const bf16x8*)(&(KP)[(long)((k0) + sr) * LDK + sc]); sr_[i].ks1 = *(const bf16x8*)(&(KP)[(long)((k0) + 32 + sr) * LDK + sc]); } while (0)
#define SWRITE(b, i) do { const int _tz = TZ(), sr = _tz >> 4, sc = (_tz & 15) * 8, vst0 = v_st(sr, sc), vst1 = v_st(32 + sr, sc); *(bf16x8*)(V_lds + (b) * SHM_V + vst0) = sr_[i].vs0;          \
    *(bf16x8*)(V_lds + (b) * SHM_V + vst1) = sr_[i].vs1; const int kc = sc * 2;          \
    *(bf16x8*)(K_lds + (b) * SHM_K + KSWZ(sr, kc)) = sr_[i].ks0;                          \
    *(bf16x8*)(K_lds + (b) * SHM_K + KSWZ(32 + sr, kc)) = sr_[i].ks1; } while (0)
#define SWAIT() asm volatile("s_waitcnt vmcnt(4)" ::: "memory")
#define RESC(a) do { if (__any((a) < 1.f)) { if (hi == 0) al_l[r32] = (a); asm volatile("s_waitcnt lgkmcnt(0)" ::: "memory"); \
    _Pragma("unroll") for (int d = 0; d < 4; ++d) _Pragma("unroll") for (int r = 0; r < 16; ++r) o[d][r] *= al_l[crow(r, hi)]; } } while (0)
    AUnit cur, nxt;
    int u = c;
    if (!attn_decode(u, total, Q, alist, pre, cntl, wid, r32, cur)) return;
#define stash ((int*)(lds + 81920) + TZ() * 2)
    stash[0] = (int)cur.qoff; stash[1] = cur.dst;
    unsigned ckv = __builtin_amdgcn_readfirstlane(cur.kv); bool ccausal = cur.causal;
    SLOAD(0, K + ckv, V + ckv, 0);
    for (;;) {
        bf16x8 qr[8];
        { const bf16_t* Qw = Q + (unsigned)stash[0] + hi * 8;
#pragma unroll
          for (int d0 = 0; d0 < 8; ++d0) qr[d0] = *reinterpret_cast<const bf16x8*>(Qw + d0 * 16); }
        u += G;
        const bool has_next = attn_decode(u, total, Q, alist, pre, cntl, wid, r32, nxt);
        const int dst0 = stash[1];
        if (hi == 0) dst_l[r32] = dst0;
        asm volatile("s_waitcnt lgkmcnt(0)" ::: "memory");
        if (has_next) { stash[0] = (int)nxt.qoff; stash[1] = nxt.dst; }
        const unsigned nkv = __builtin_amdgcn_readfirstlane(nxt.kv); const bool ncausal = nxt.causal;
        const bf16_t* Kh = K + ckv; const bf16_t* Vh = V + ckv; const bool causal = ccausal;
        float m_reg = -1e30f, l_reg = 0; f32x16 o[4] = {};
        f32x16 pA0, pA1, pB0, pB1; float mnA, mnB, alA, alB; bf16x8 pa0, pa1, pa2, pa3;
        asm volatile("s_waitcnt vmcnt(0)" ::: "memory"); SWRITE(0, 0); __syncthreads();
        qkt(pA0, pA1, K_lds, qr, r32, hi); if (causal) causal_mask(pA0, pA1, 0, qrow_i, hi); partialSM(pA0, pA1, m_reg, mnA, alA);
        SLOAD(1, Kh, Vh, KVBLK); SLOAD(0, Kh, Vh, 2 * KVBLK);
        SWAIT(); SWRITE(1, 1); __syncthreads();
        {
            SBAR(); qkt(pB0, pB1, K_lds + SHM_K, qr, r32, hi); if (causal) causal_mask(pB0, pB1, 1, qrow_i, hi);
            finishSM(pA0, pA1, alA, l_reg, pa0, pa1, pa2, pa3); SBAR();
            SLOAD(1, Kh, Vh, 3 * KVBLK); SBAR();
            pv_d0(o, vb0, pa0, pa1, pa2, pa3); partialSM(pB0, pB1, m_reg, mnB, alB);
            __syncthreads(); SWAIT(); SWRITE(0, 0);
            RESC(alB); __syncthreads();
            SBAR(); qkt(pA0, pA1, K_lds, qr, r32, hi); if (causal) causal_mask(pA0, pA1, 2, qrow_i, hi);
            finishSM(pB0, pB1, alB, l_reg, pa0, pa1, pa2, pa3); SBAR();
            pv_d0(o, vb0 + SHM_V, pa0, pa1, pa2, pa3); partialSM(pA0, pA1, m_reg, mnA, alA);
            __syncthreads(); asm volatile("s_waitcnt vmcnt(0)" ::: "memory"); SWRITE(1, 1);
            RESC(alA); __syncthreads();
        }
        SBAR(); qkt(pB0, pB1, K_lds + SHM_K, qr, r32, hi); if (causal) causal_mask(pB0, pB1, 3, qrow_i, hi);
        finishSM(pA0, pA1, alA, l_reg, pa0, pa1, pa2, pa3); SBAR();
        pv_d0(o, vb0, pa0, pa1, pa2, pa3); partialSM(pB0, pB1, m_reg, mnB, alB);
        __syncthreads(); RESC(alB);
        finishSM(pB0, pB1, alB, l_reg, pa0, pa1, pa2, pa3); SBAR();
        pv_d0(o, vb0 + SHM_V, pa0, pa1, pa2, pa3);
        SBAR();
        if (has_next) {
            SLOAD(0, K + nkv, V + nkv, 0);
        }
        SBAR();
        if (hi == 0) li_l[r32] = l_reg; asm volatile("s_waitcnt lgkmcnt(0)" ::: "memory");
        { const int dst = dst_l[r32]; if (hi == 0 && dst >= 0) lse[dst] = m_reg * CL2 + __builtin_amdgcn_logf(l_reg); }
        __syncthreads();
        char* ost = lds + wid * 8704;
#pragma unroll
        for (int r = 0; r < 16; ++r) { const int orow = crow(r, hi); const float rl = __builtin_amdgcn_rcpf(li_l[orow]);
#pragma unroll
            for (int d0 = 0; d0 < 4; ++d0) *(bf16_t*)(ost + orow * 272 + (d0 * 32 + r32) * 2) = f2bf(o[d0][r] * rl); }
#pragma unroll
        for (int j = 0; j < 8; ++j) { const int cidx = lane + 64 * j, row = cidx >> 4, ch = cidx & 15; const int dd = dst_l[row];
            const u32x4 w = *(const u32x4*)(ost + row * 272 + ch * 16);
            u32x2 f; f.x = pack_fp8x4(bf_lo(w.x) * FP8_OSCALE, bf_hi(w.x) * FP8_OSCALE, bf_lo(w.y) * FP8_OSCALE, bf_hi(w.y) * FP8_OSCALE);
            f.y = pack_fp8x4(bf_lo(w.z) * FP8_OSCALE, bf_hi(w.z) * FP8_OSCALE, bf_lo(w.w) * FP8_OSCALE, bf_hi(w.w) * FP8_OSCALE);
            if (dd >= 0) *(u32x2*)(part + (size_t)dd * 128 + ch * 8) = f; }
        __syncthreads();
        if (!has_next) break;
        ckv = nkv; ccausal = ncausal;
    }
#undef SLOAD
#undef stash
#undef TZ
#undef qrow_i
#undef vb0
#undef SWRITE
#undef SWAIT
#undef RESC
}
#undef KSWZ
#undef SBAR
}

__device__ __forceinline__ void phase_attn(const Frame& F, const bf16_t* Q, const bf16_t* K, const bf16_t* V, unsigned char* part, float* lse, int wi, int wn) {
    LAS int* pre = (LAS int*)(F.lds + at::LDS_PRE);
    LAS int* wtot = pre + 520; LAS int* cntl = pre + 536;
    const unsigned* gcnt = (const unsigned*)(F.ws + ZB_ATTCNT);
    const int* alist = (const int*)(F.ws + WS_ALIST);
    {
        const int cntv = (int)gcnt[F.tid]; const int v = (cntv + 255) >> 8;
        cntl[F.tid] = cntv;
        int incl = v;
#pragma unroll
        for (int o = 1; o < 64; o <<= 1) { const int y = __shfl_up(incl, o, 64); if (F.lane >= o) incl += y; }
        if (F.lane == 63) wtot[F.wave] = incl;
        __syncthreads();
        int off = 0;
        for (int w = 0; w < F.wave; ++w) off += wtot[w];
        pre[F.tid + 1] = off + incl; if (F.tid == 0) pre[0] = 0;
        __syncthreads();
    }
    const int total = 512 + pre[512];
    at::attn_stream(Q, K, V, alist, pre, cntl, total, wi, wn, part, lse, (char*)F.lds);
}

__device__ __forceinline__ void phase_attn_combine(const Frame& F, const unsigned char* part, const float* lse, unsigned char* O) {
    for (size_t idx = (size_t)F.c * NTHREADS + F.tid; idx < (size_t)T * 128; idx += (size_t)F.G * NTHREADS) {
        const int dc = (int)(idx & 15), h = (int)((idx >> 4) & 7); const size_t t = idx >> 7;
        const int s = (int)(t & (SEQ - 1)), j = s >> 8, nsel = j < 3 ? j : 3;
        const size_t base = (t * 8 + h) * 4;
        const f32x4 l4 = *(const f32x4*)(lse + base);
        float lk[4]; lk[0] = nsel > 0 ? l4[0] : -INFINITY; lk[1] = nsel > 1 ? l4[1] : -INFINITY; lk[2] = nsel > 2 ? l4[2] : -INFINITY; lk[3] = l4[3];
        const float mx = fmaxf(fmaxf(lk[0], lk[1]), fmaxf(lk[2], lk[3]));
        float acc[8] = {0.f, 0.f, 0.f, 0.f, 0.f, 0.f, 0.f, 0.f}; float wsum = 0.f;
#pragma unroll
        for (int k = 0; k < 4; ++k) if (k == 3 || k < nsel) {
            const float w = __builtin_amdgcn_exp2f(lk[k] - mx); wsum += w;
            const u32x2 p = *(const u32x2*)(part + (base + k) * 128 + dc * 8);
            const f32x2 p0 = __builtin_amdgcn_cvt_pk_f32_fp8((int)p.x, false), p1 = __builtin_amdgcn_cvt_pk_f32_fp8((int)p.x, true);
            const f32x2 p2 = __builtin_amdgcn_cvt_pk_f32_fp8((int)p.y, false), p3 = __builtin_amdgcn_cvt_pk_f32_fp8((int)p.y, true);
            acc[0] = fmaf(w, p0[0], acc[0]); acc[1] = fmaf(w, p0[1], acc[1]); acc[2] = fmaf(w, p1[0], acc[2]); acc[3] = fmaf(w, p1[1], acc[3]);
            acc[4] = fmaf(w, p2[0], acc[4]); acc[5] = fmaf(w, p2[1], acc[5]); acc[6] = fmaf(w, p3[0], acc[6]); acc[7] = fmaf(w, p3[1], acc[7]); }
        const float inv = 1.f / wsum;
        u32x2 w; w.x = pack_fp8x4(acc[0] * inv, acc[1] * inv, acc[2] * inv, acc[3] * inv); w.y = pack_fp8x4(acc[4] * inv, acc[5] * inv, acc[6] * inv, acc[7] * inv);
        *(u32x2*)(O + t * DM + h * 128 + dc * 8) = w;
    }
}

constexpr int N_PHASES = 22;
__global__ void __launch_bounds__(NTHREADS, 2) mk_fwd(Args a) {
    extern __shared__ __attribute__((aligned(16))) unsigned char lds_raw[];
    Frame F; F.lds = (LAS unsigned char*)lds_raw; F.tid = threadIdx.x; F.lane = F.tid & 63; F.wave = __builtin_amdgcn_readfirstlane(F.tid >> 6);
    F.G = gridDim.x; F.c = blockIdx.x; F.in = a.in; F.out = a.out; F.ws = a.ws;
    const int lo = a.ph_lo, hi = a.ph_hi;
    if (F.tid == 0) *(LAS u32x4*)(F.lds + LDS_BARW) = (u32x4){0u, 0u, 0u, 0u};
    __syncthreads();
    XcdBarrier bar; bar.bar = (unsigned*)(F.ws + ZB_BAR); bar.x = 0; bar.st = (volatile LAS unsigned*)(F.lds + LDS_BARW);
    if (hi - lo > 1) bar = xcd_barrier_post((unsigned*)(F.ws + ZB_BAR), (volatile LAS unsigned*)(F.lds + LDS_BARW));
#ifndef MK_ONLY
#define MK_ONLY -1
#endif
#define IN(k) ((MK_ONLY < 0 || MK_ONLY == (k)) && lo <= (k) && (k) < hi)
#define SEAM(k) do { if ((k) + 1 < hi) xcd_barrier(bar); { int _t = threadIdx.x; asm volatile("" : "+v"(_t)); F.tid = _t; F.lane = _t & 63; } } while (0)
#define PHASE_WS() unsigned char* ws; { unsigned long long w_ = (unsigned long long)a.ws; asm volatile("" : "+s"(w_)); ws = (unsigned char*)(__attribute__((address_space(1))) unsigned char*)w_; F.ws = ws; }     \
    bf16_t* actA = (bf16_t*)(ws + WS_ACTA); bf16_t* actB = (bf16_t*)(ws + WS_ACTB); bf16_t* actC = (bf16_t*)(ws + WS_ACTC); bf16_t* actD = (bf16_t*)(ws + WS_ACTD); \
    bf16_t* XB = (bf16_t*)(ws + WS_XB); bf16_t* actg = (bf16_t*)(ws + WS_ACTG); bf16_t* yk = (bf16_t*)(ws + WS_YK); \
    (void)actA; (void)actB; (void)actC; (void)actD; (void)XB; (void)actg; (void)yk;
    if (IN(0)) { PHASE_WS(); phase_prologue(F); SEAM(0); }
    if (IN(1)) { PHASE_WS(); phase_norm_mod(F, F.in[IN_X], F.in[L0_NORM1], 0, 0, actA); SEAM(1); }
    if (IN(2)) { PHASE_WS(); pg::Dense<pg::EpiBf16> S{actA, (const bf16_t*)(ws + WS_WIN), T / 256, 4, F.G, F.c, pg::EpiBf16{actB, 1.f}}; pg::gemm_phase(F.lds, S); SEAM(2); }
    if (IN(3)) { PHASE_WS(); phase_s5<false>(F, actB, actA, nullptr); SEAM(3); }
    if (IN(4)) { PHASE_WS(); phase_s5_carry(F); SEAM(4); }
    if (IN(5)) { PHASE_WS(); phase_s5<true>(F, actB, actA, (unsigned char*)actC); SEAM(5); }
    if (IN(6)) { PHASE_WS(); pg::Dense<pg::EpiGlu, true> S{actC, ws + WS_WGLU, T / 256, 4, F.G, F.c, pg::EpiGlu{actA, actB, 1.f / FP8_WSCALE}}; pg::gemm_phase(F.lds, S); SEAM(6); }
    if (IN(7)) { PHASE_WS(); pg::Dense<pg::EpiBf16> S{actB, (const bf16_t*)(ws + WS_WOUT), T / 256, 4, F.G, F.c, pg::EpiBf16{actC, 1.f}}; pg::gemm_phase(F.lds, S); SEAM(7); }
    if (IN(8)) { PHASE_WS(); phase_norm_router(F, F.in[IN_X], actC, F.in[L0_NORM2], 0, (unsigned char*)actA); SEAM(8); }
    const bool has_cv = (F.G == 256); const bool is_cv = has_cv && (F.c >> 3) >= 28; const int cvi = ((F.c >> 3) - 28) * 8 + (F.c & 7);
    const pg::MoeGeo geo0 = pg::moe_geo(F.G, F.c, has_cv ? 28 : 32), geo1 = pg::moe_geo(F.G, F.c, 32);
    if (IN(9)) { PHASE_WS(); if (is_cv) moe_conv_stream(F, CONV_L0DN_BEG, CONV_L1GU_BEG, cvi, 32);
        else { pg::MoeTabs M = pg::moe_setup<8>(F, 0, true, geo0);
            pg::MoeGateUp S{(const unsigned char*)actA, ws + WS_WGU0, F.in[L0_BGU], (unsigned char*)actg, M, geo0}; pg::gemm_phase(F.lds, S); }
        SEAM(9); }
    if (IN(10)) { PHASE_WS(); if (is_cv) moe_conv_stream(F, CONV_P10_BEG, CONV_P15_BEG, cvi, 32);
        else { pg::MoeTabs M = pg::moe_tabs_reuse(F, 0, geo0);
            pg::MoeDown S{(const unsigned char*)actg, ws + WS_WDN0, F.in[L0_BDN], (unsigned char*)yk, M, geo0}; pg::gemm_phase(F.lds, S); }
        SEAM(10); }
    if (IN(11)) { PHASE_WS(); phase_moe_combine<false, float>(F, 0, F.in[IN_X], actC, XB, F.in[L1_NORM1], (unsigned char*)actA, nullptr); SEAM(11); }
    if (IN(12)) { PHASE_WS(); pg::Dense<pg::EpiQkv, true> S{actA, ws + WS_WQKV, T / 256, 12, F.G, F.c,
                    pg::EpiQkv{actB, (const float*)(ws + WS_ROPE), (const float*)(ws + WS_ROPE) + (size_t)T * 64, 1.f / FP8_WSCALE, (float*)(ws + WS_KMEAN)}}; pg::gemm_phase(F.lds, S); SEAM(12); }
    if (IN(14)) { PHASE_WS(); phase_gating(F, actB); SEAM(14); }
    if (IN(15)) { PHASE_WS(); if (is_cv) moe_conv_stream(F, CONV_P15_BEG, CONV_L1DN_BEG, cvi, 32);
        else phase_attn(F, actB, actC, actD, (unsigned char*)actg, (float*)(ws + WS_LSE), has_cv ? (F.c >> 3) * 8 + (F.c & 7) : F.c, has_cv ? 224 : F.G);
        SEAM(15); }
    if (IN(16)) { PHASE_WS(); phase_attn_combine(F, (const unsigned char*)actg, (const float*)(ws + WS_LSE), (unsigned char*)actA); SEAM(16); }
    if (IN(17)) { PHASE_WS(); pg::Dense<pg::EpiBf16, true> S{actA, ws + WS_WO, T / 256, 4, F.G, F.c, pg::EpiBf16{actC, 1.f / (FP8_WSCALE * FP8_OSCALE)}}; pg::gemm_phase(F.lds, S); SEAM(17); }
    if (IN(18)) { PHASE_WS(); phase_norm_router(F, XB, actC, F.in[L1_NORM2], 1, (unsigned char*)actB); SEAM(18); }
    if (IN(19)) { PHASE_WS(); if (is_cv) moe_conv_stream(F, CONV_L1DN_BEG, CONV_END, cvi, 32);
        else { pg::MoeTabs M = pg::moe_setup<8>(F, 1, true, geo0);
            pg::MoeGateUp S{(const unsigned char*)actB, ws + WS_WGU1, F.in[L1_BGU], (unsigned char*)actg, M, geo0}; pg::gemm_phase(F.lds, S); }
        SEAM(19); }
    if (IN(20)) { PHASE_WS(); if (!is_cv) { pg::MoeTabs M = pg::moe_tabs_reuse(F, 1, geo0);
            pg::MoeDown S{(const unsigned char*)actg, ws + WS_WDN1, F.in[L1_BDN], (unsigned char*)yk, M, geo0}; pg::gemm_phase(F.lds, S); }
        SEAM(20); }
    if (IN(21)) { PHASE_WS(); phase_moe_combine<true, bf16_t>(F, 1, XB, actC, nullptr, F.in[IN_FNORM], nullptr, F.out); }
#undef IN
#undef SEAM
}

extern "C" void kernel_launch(void* const* d_in, const int* in_sizes, int n_in, void* d_out, int out_size, void* d_ws, size_t ws_size, hipStream_t stream) {
    static int grid = 0;
    if (grid == 0) {
        if (n_in != 37 || in_sizes[0] != T * DM || out_size != T * DM || ws_size < WS_END) {
            fprintf(stderr, "kernel_launch: built for 37 inputs, x/out of %d floats, >= %zu bytes of workspace; got n_in %d, in0 %d, out %d, ws %zu\n", T * DM, (size_t)WS_END, n_in, n_in > 0 ? in_sizes[0] : -1, out_size, ws_size);
            grid = -1; return; }
        int dev = 0, cus = 0, per_cu = 0;
        if (hipGetDevice(&dev) != hipSuccess || hipDeviceGetAttribute(&cus, hipDeviceAttributeMultiprocessorCount, dev) != hipSuccess) { grid = -1; return; }
        if (hipFuncSetAttribute((const void*)mk_fwd, hipFuncAttributeMaxDynamicSharedMemorySize, LDS_BYTES) != hipSuccess) { fprintf(stderr, "kernel_launch: hipFuncSetAttribute failed\n"); grid = -1; return; }
        if (hipOccupancyMaxActiveBlocksPerMultiprocessor(&per_cu, (const void*)mk_fwd, NTHREADS, LDS_BYTES) != hipSuccess || per_cu < 1)
            fprintf(stderr, "kernel_launch: occupancy query reports %d workgroups per CU\n", per_cu);
        (void)hipGetLastError();
        grid = cus;
    }
    if (grid < 0) return;
    if (hipMemsetAsync(d_ws, 0, ZERO_BYTES, stream) != hipSuccess) { fprintf(stderr, "kernel_launch: memset failed\n"); return; }
    Args a{};
    for (int i = 0; i < 37; ++i) a.in[i] = (const float*)d_in[i];
    a.out = (float*)d_out; a.ws = (unsigned char*)d_ws;
#if MK_MULTI
    for (int k = 0; k < MK_EMPTY; ++k) { a.ph_lo = N_PHASES; a.ph_hi = N_PHASES + 1; hipLaunchKernelGGL(mk_fwd, dim3(grid), dim3(NTHREADS), LDS_BYTES, stream, a); }
    for (int k = 0; k < N_PHASES; ++k) { a.ph_lo = k; a.ph_hi = k + 1;
        for (int rep = 0; rep < 1 + (int)((MK_DUP >> k) & 1u); ++rep) {
            if (rep && k == 8) hipMemsetAsync((char*)d_ws + ZB_MOECNT, 0, 256, stream);
            if (rep && k == 18) hipMemsetAsync((char*)d_ws + ZB_MOECNT + 256, 0, 256, stream);
            if (rep && k == 14) hipMemsetAsync((char*)d_ws + ZB_ATTCNT, 0, 2048, stream);
            hipLaunchKernelGGL(mk_fwd, dim3(grid), dim3(NTHREADS), LDS_BYTES, stream, a); } }
#else
    a.ph_lo = 0; a.ph_hi = N_PHASES;
    hipLaunchKernelGGL(mk_fwd, dim3(grid), dim3(NTHREADS), LDS_BYTES, stream, a);
#endif
    const hipError_t le = hipPeekAtLastError();
    if (le != hipSuccess) fprintf(stderr, "kernel_launch: launch failed: %s\n", hipGetErrorName(le));
}
```

```cpp
#include <hip/hip_runtime.h>
#include <cstdio>
#include <cstdint>

#ifndef MK_DUP
#define MK_DUP 0u
#endif
#ifndef MK_EMPTY
#define MK_EMPTY 0
#endif
#ifndef MK_KREP
#define MK_KREP 1
#endif
#ifndef MK_CONVPROBE
#define MK_CONVPROBE 0
#endif
#ifndef MK_CV0
#define MK_CV0 1280
#endif
#ifndef MK_CV9
#define MK_CV9 2048
#endif
#ifndef MK_CV10
#define MK_CV10 1152
#endif
#ifndef MK_MULTI
#define MK_MULTI 0
#endif

typedef unsigned short bf16_t;
typedef short bf16x8 __attribute__((ext_vector_type(8)));
typedef short s16x4 __attribute__((ext_vector_type(4)));
typedef float f32x2 __attribute__((ext_vector_type(2)));
typedef float f32x4 __attribute__((ext_vector_type(4)));
typedef float f32x16 __attribute__((ext_vector_type(16)));
typedef unsigned u32x2 __attribute__((ext_vector_type(2)));
typedef unsigned u32x4 __attribute__((ext_vector_type(4)));
typedef int v4i __attribute__((ext_vector_type(4)));
typedef int v8i __attribute__((ext_vector_type(8)));
#define LAS __attribute__((address_space(3)))

constexpr int DM = 1024, NB = 2, SEQ = 8192, T = NB * SEQ;
constexpr int NH = 8, HD = 128, MBLK = 256, NBLK = SEQ / MBLK;
constexpr int NE = 32, TOPK = 4, DFF = 1024;
constexpr int S5G = 64, S5P = 64, S5C = 16;
constexpr int NTHREADS = 512;
constexpr int LDS_BYTES = 147456;
constexpr int LDS_BARW = LDS_BYTES - 16;
constexpr int MOE_CAP = T;
constexpr int MOE_MAXROWS = T * TOPK + NE * 256;
constexpr int MOE_MAXTILES = MOE_MAXROWS / 256;

constexpr size_t al256(size_t x) { return (x + 255) / 256 * 256; }
constexpr size_t WS_ZERO = 0;
constexpr size_t   ZB_BAR = 0;
constexpr size_t   ZB_MOECNT = 16384;
constexpr size_t   ZB_ATTCNT = 20480;
constexpr size_t ZERO_BYTES = 32768;
constexpr size_t WS_ADA = ZERO_BYTES;
constexpr size_t WS_S5A = WS_ADA + al256(2 * 2 * 6 * 1024 * 4);
constexpr size_t WS_BOP = WS_S5A + 4 * 64 * 64 * 4;
constexpr size_t WS_COP = WS_BOP + 64 * 128 * 16 * 2;
constexpr size_t WS_ROPE = WS_COP + 64 * 16 * 128 * 2;
constexpr size_t WS_WRB = WS_ROPE + 2 * (size_t)T * 64 * 4;
constexpr size_t WS_KMEAN = WS_WRB + 2 * 32 * 1024 * 2;
constexpr size_t WS_TOPK = WS_KMEAN + 2 * 8 * 32 * 128 * 4;
constexpr size_t WS_VTOK = WS_TOPK + 2 * (size_t)T * 4 * 4;
constexpr size_t ALIST_PER_BH = 256 * 496;
constexpr size_t WS_ALIST = WS_VTOK + (size_t)NE * MOE_CAP * 4;
constexpr size_t WS_LSE = WS_ALIST + 16 * ALIST_PER_BH * 4;
constexpr size_t WS_CARRY = WS_LSE + (size_t)T * 8 * 4 * 4;
constexpr size_t WS_WIN = WS_CARRY + (size_t)2 * 256 * 64 * 128 * 4;
constexpr size_t WS_WGLU = WS_WIN + 2097152, WS_WOUT = WS_WGLU + 2097152, WS_WQKV = WS_WOUT + 2097152, WS_WO = WS_WQKV + 3 * 2097152;
constexpr size_t WS_WGU0 = WS_WO + 2097152;
constexpr size_t WS_WGU1 = WS_WGU0 + (size_t)NE * 2048 * 1024 * 2;
constexpr size_t WS_WDN0 = WS_WGU1 + (size_t)NE * 2048 * 1024 * 2;
constexpr size_t WS_WDN1 = WS_WDN0 + (size_t)NE * 1024 * 1024 * 2;
constexpr size_t WS_ACTA = WS_WDN1 + (size_t)NE * 1024 * 1024 * 2;
constexpr size_t ACT_BYTES = (size_t)T * DM * 2;
constexpr size_t WS_ACTB = WS_ACTA + ACT_BYTES, WS_ACTC = WS_ACTB + ACT_BYTES, WS_ACTD = WS_ACTC + ACT_BYTES;
constexpr size_t WS_XA = WS_ACTD + ACT_BYTES;
constexpr size_t WS_XB = WS_XA + (size_t)T * DM * 4;
constexpr size_t WS_ACTG = WS_XB + (size_t)T * DM * 4;
constexpr size_t WS_YK = WS_ACTG + (size_t)MOE_MAXROWS * 1024 * 2;
constexpr size_t WS_END = WS_YK + (size_t)MOE_MAXROWS * 1024 * 2;

__device__ __forceinline__ unsigned cvt_pk_bf16(float lo, float hi) { unsigned r; asm volatile("v_cvt_pk_bf16_f32 %0, %1, %2" : "=v"(r) : "v"(lo), "v"(hi)); return r; }
__device__ __forceinline__ float bf_lo(unsigned w) { return __uint_as_float(w << 16); }
__device__ __forceinline__ float bf_hi(unsigned w) { return __uint_as_float(w & 0xffff0000u); }
__device__ __forceinline__ bf16_t f2bf(float f) { return (bf16_t)(cvt_pk_bf16(f, 0.f) & 0xffffu); }
__device__ __forceinline__ unsigned pack_fp8x4(float a, float b, float c, float d) {
    a = fminf(fmaxf(a, -448.f), 448.f); b = fminf(fmaxf(b, -448.f), 448.f); c = fminf(fmaxf(c, -448.f), 448.f); d = fminf(fmaxf(d, -448.f), 448.f);
    int w = 0; w = __builtin_amdgcn_cvt_pk_fp8_f32(a, b, w, false); w = __builtin_amdgcn_cvt_pk_fp8_f32(c, d, w, true); return (unsigned)w;
}
__device__ __forceinline__ unsigned pack_fp8x4_nc(float a, float b, float c, float d) {
    int w = 0; w = __builtin_amdgcn_cvt_pk_fp8_f32(a, b, w, false); w = __builtin_amdgcn_cvt_pk_fp8_f32(c, d, w, true); return (unsigned)w;
}
constexpr float FP8_WSCALE = 64.f, FP8_ASCALE = 4.f, FP8_OSCALE = 64.f, FP8_YSCALE = 8.f;
__device__ __forceinline__ f32x4 load_x4(const float* p) { return *(const f32x4*)p; }
__device__ __forceinline__ f32x4 load_x4(const bf16_t* p) { const u32x2 w = *(const u32x2*)p; return (f32x4){bf_lo(w.x), bf_hi(w.x), bf_lo(w.y), bf_hi(w.y)}; }
template <int CTRL> __device__ __forceinline__ float dpp_f(float v) { return __builtin_bit_cast(float, __builtin_amdgcn_update_dpp(0, __builtin_bit_cast(int, v), CTRL, 0xF, 0xF, false)); }
template <int CTRL> __device__ __forceinline__ int dpp_i(int v) { return __builtin_amdgcn_update_dpp(0, v, CTRL, 0xF, 0xF, false); }
__device__ __forceinline__ float row16_sum(float v) { v += dpp_f<0xB1>(v); v += dpp_f<0x4E>(v); v += dpp_f<0x124>(v); v += dpp_f<0x128>(v); return v; }
__device__ __forceinline__ float row16_max(float v) { v = fmaxf(v, dpp_f<0xB1>(v)); v = fmaxf(v, dpp_f<0x4E>(v)); v = fmaxf(v, dpp_f<0x124>(v)); v = fmaxf(v, dpp_f<0x128>(v)); return v; }
__device__ __forceinline__ int row16_min(int v) { v = min(v, dpp_i<0xB1>(v)); v = min(v, dpp_i<0x4E>(v)); v = min(v, dpp_i<0x124>(v)); v = min(v, dpp_i<0x128>(v)); return v; }
__device__ __forceinline__ float wave_sum(float v) {
    const int r = __builtin_bit_cast(int, row16_sum(v));
    return (__builtin_bit_cast(float, __builtin_amdgcn_readlane(r, 0)) + __builtin_bit_cast(float, __builtin_amdgcn_readlane(r, 16)))
         + (__builtin_bit_cast(float, __builtin_amdgcn_readlane(r, 32)) + __builtin_bit_cast(float, __builtin_amdgcn_readlane(r, 48)));
}
__device__ __forceinline__ float wave_max(float v) {
    const int r = __builtin_bit_cast(int, row16_max(v));
    return fmaxf(fmaxf(__builtin_bit_cast(float, __builtin_amdgcn_readlane(r, 0)), __builtin_bit_cast(float, __builtin_amdgcn_readlane(r, 16))),
                 fmaxf(__builtin_bit_cast(float, __builtin_amdgcn_readlane(r, 32)), __builtin_bit_cast(float, __builtin_amdgcn_readlane(r, 48))));
}
__device__ __forceinline__ float sigmoidf_fast(float x) { return __builtin_amdgcn_rcpf(1.f + __builtin_amdgcn_exp2f(-1.4426950408889634f * x)); }
__device__ __forceinline__ float gelu_tanh(float y) {
    const float u = 1.5957691216057308f * (y + 0.044715f * y * y * y);
    return y * sigmoidf_fast(u);
}

#define XB_TMO      128
#define XB_XCNT(j)  (256  + 64 * (j))
#define XB_XSUB(j)  (1280 + 64 * (j))
#define XB_XGEN(j)  (2304 + 64 * (j))
#define XB_TOP      3328
#define XB_TOPGEN   3392
#define XCD_BAR_WORDS 3456
#define XB_SPIN_CAP (1u << 18)

__device__ __forceinline__ unsigned xb_ld(unsigned* p)              { return __hip_atomic_load(p, __ATOMIC_RELAXED, __HIP_MEMORY_SCOPE_AGENT); }
__device__ __forceinline__ unsigned xb_add(unsigned* p, unsigned v) { return __hip_atomic_fetch_add(p, v, __ATOMIC_RELAXED, __HIP_MEMORY_SCOPE_AGENT); }
__device__ __forceinline__ unsigned xb_xcc_id() { return (unsigned)__builtin_amdgcn_s_getreg((3 << 11) | 20) & 0xFu; }
#define XB_SPIN(cond, bar) do { unsigned _sp = 0; while (cond) { __builtin_amdgcn_s_sleep(1); \
    if ((++_sp & 255u) == 0u) { if (xb_ld(&(bar)[XB_TMO])) break; if (_sp > XB_SPIN_CAP) { atomicAdd(&(bar)[XB_TMO], 1u); break; } } } } while (0)

struct XcdBarrier { unsigned* bar; unsigned x; volatile LAS unsigned* st; };

__device__ __forceinline__ XcdBarrier xcd_barrier_post(unsigned* bar, volatile LAS unsigned* st) {
    XcdBarrier b; b.bar = bar; b.x = xb_xcc_id(); b.st = st;
    if (threadIdx.x == 0) (void)xb_add(&bar[XB_XCNT(b.x)], 1u);
    return b;
}
__device__ __forceinline__ void xcd_barrier_complete(unsigned* bar, unsigned x, unsigned& nloc, unsigned& nx) {
    const unsigned G = gridDim.x * gridDim.y * gridDim.z;
    unsigned sum, cnt, mine, sp = 0u;
    for (;;) {
        sum = 0u; cnt = 0u; mine = 0u;
#pragma unroll
        for (unsigned j = 0; j < 16; ++j) { const unsigned c = xb_ld(&bar[XB_XCNT(j)]); sum += c; cnt += (c > 0u) ? 1u : 0u; mine = (j == x) ? c : mine; }
        if (sum == G) break;
        __builtin_amdgcn_s_sleep(1);
        if ((++sp & 255u) == 0u) { if (xb_ld(&bar[XB_TMO])) break; if (sp > XB_SPIN_CAP) { atomicAdd(&bar[XB_TMO], 1u); break; } }
    }
    nloc = mine > 0u ? mine : 1u; nx = cnt > 0u ? cnt : 1u;
}
__device__ __forceinline__ void xcd_barrier(const XcdBarrier& b) {
    asm volatile("s_waitcnt vmcnt(0)" ::: "memory");
    __syncthreads();
    if (threadIdx.x == 0) {
        unsigned* bar = b.bar;
        __builtin_amdgcn_s_waitcnt(0);
        unsigned nloc = b.st[0], nx = b.st[1];
        if (nloc == 0u) { xcd_barrier_complete(bar, b.x, nloc, nx); b.st[0] = nloc; b.st[1] = nx; }
        const unsigned old = xb_add(&bar[XB_XSUB(b.x)], 1u);
        const unsigned gen = old / nloc;
        if (old + 1u == (gen + 1u) * nloc) {
            __builtin_amdgcn_fence(__ATOMIC_RELEASE, "agent");
            asm volatile("s_waitcnt vmcnt(0)" ::: "memory");
            const unsigned og = xb_add(&bar[XB_TOP], 1u);
            const unsigned tg = og / nx;
            if (og + 1u == (tg + 1u) * nx) xb_add(&bar[XB_TOPGEN], 1u);
            else XB_SPIN(xb_ld(&bar[XB_TOPGEN]) == tg, bar);
            __builtin_amdgcn_fence(__ATOMIC_ACQUIRE, "agent");
            xb_add(&bar[XB_XGEN(b.x)], 1u);
            asm volatile("s_waitcnt vmcnt(0)" ::: "memory");
        } else {
            XB_SPIN(xb_ld(&bar[XB_XGEN(b.x)]) == gen, bar);
            __builtin_amdgcn_fence(__ATOMIC_ACQUIRE, "agent");
            asm volatile("s_waitcnt vmcnt(0)" ::: "memory");
        }
    }
    __syncthreads();
}

struct Args { const float* in[37]; float* out; unsigned char* ws; int ph_lo, ph_hi; };

struct Frame {
    LAS unsigned char* lds;
    int tid, lane, wave, G, c;
    const float* const* in; float* out; unsigned char* ws;
};

enum { IN_X = 0, IN_C = 1, IN_POS = 2,
       L0_NORM1 = 3, L0_ADAW = 4, L0_ADAB = 5, L0_WIN = 6, L0_BRE = 7, L0_BIM = 8, L0_CRE = 9, L0_CIM = 10, L0_LRE = 11, L0_LIM = 12, L0_LOGDT = 13, L0_D = 14, L0_WGLU = 15, L0_WOUT = 16,
       L0_NORM2 = 17, L0_WR = 18, L0_BR = 19, L0_WGU = 20, L0_BGU = 21, L0_WDN = 22, L0_BDN = 23,
       L1_NORM1 = 24, L1_ADAW = 25, L1_ADAB = 26, L1_WQKV = 27, L1_WO = 28, L1_NORM2 = 29, L1_WR = 30, L1_BR = 31, L1_WGU = 32, L1_BGU = 33, L1_WDN = 34, L1_BDN = 35, IN_FNORM = 36 };

__device__ __forceinline__ const float* ada_vec(const Frame& F, int layer, int b, int which) { return (const float*)(F.ws + WS_ADA) + ((layer * 2 + b) * 6 + which) * 1024; }

__device__ __forceinline__ void conv_unit(const Frame& F, const float* __restrict__ src, bf16_t* __restrict__ dst, int N, int kt, int ntile, bool qkperm) {
    LAS unsigned* L = (LAS unsigned*)F.lds;
    const int k0 = kt * 64, n0 = ntile * 256, lane = F.lane, w = F.wave;
#pragma unroll
    for (int j = 0; j < 4; ++j) {
        const float* sp = src + (size_t)(k0 + 2 * w) * N + n0 + lane + 64 * j;
        float a[4], b[4];
#pragma unroll
        for (int i = 0; i < 4; ++i) { a[i] = sp[(size_t)(16 * i) * N]; b[i] = sp[(size_t)(16 * i + 1) * N]; }
#pragma unroll
        for (int i = 0; i < 4; ++i) L[(lane + 64 * j) * 33 + 8 * i + w] = cvt_pk_bf16(a[i], b[i]);
    }
    __syncthreads();
    const int row = F.tid >> 1, half = F.tid & 1;
    int n = n0 + row;
    if (qkperm && n < 2048) { const int d = n & 127; n = (n & ~127) | (d < 64 ? 2 * d : 2 * (d - 64) + 1); }
    bf16_t* dp = dst + (size_t)n * 1024 + k0 + half * 32;
#pragma unroll
    for (int q = 0; q < 4; ++q) {
        u32x4 v; v.x = L[row * 33 + half * 16 + 4 * q + 0]; v.y = L[row * 33 + half * 16 + 4 * q + 1]; v.z = L[row * 33 + half * 16 + 4 * q + 2]; v.w = L[row * 33 + half * 16 + 4 * q + 3];
        *(u32x4*)(dp + 8 * q) = v;
    }
    __syncthreads();
}

__device__ __forceinline__ void conv_unit8(const Frame& F, const float* __restrict__ src, unsigned char* __restrict__ dst, int N, int kt, int ntile, bool qkperm = false) {
    LAS unsigned* L = (LAS unsigned*)F.lds;
    const int k0 = kt * 128, n0 = ntile * 128, lane = F.lane, w = F.wave;
#pragma unroll
    for (int j = 0; j < 2; ++j) {
        const float* sp = src + (size_t)(k0 + 4 * w) * N + n0 + lane + 64 * j;
        float f[4][4];
#pragma unroll
        for (int i = 0; i < 4; ++i)
#pragma unroll
            for (int q = 0; q < 4; ++q) f[i][q] = sp[(size_t)(32 * i + q) * N];
#pragma unroll
        for (int i = 0; i < 4; ++i) L[(lane + 64 * j) * 33 + w + 8 * i] = pack_fp8x4(f[i][0] * FP8_WSCALE, f[i][1] * FP8_WSCALE, f[i][2] * FP8_WSCALE, f[i][3] * FP8_WSCALE);
    }
    __syncthreads();
    const int row = F.tid >> 2, qtr = F.tid & 3;
    int n = n0 + row;
    if (qkperm && n < 2048) { const int d = n & 127; n = (n & ~127) | (d < 64 ? 2 * d : 2 * (d - 64) + 1); }
    unsigned char* dp = dst + (size_t)n * 1024 + k0 + qtr * 32;
#pragma unroll
    for (int q = 0; q < 2; ++q) {
        u32x4 v; v.x = L[row * 33 + qtr * 8 + 4 * q + 0]; v.y = L[row * 33 + qtr * 8 + 4 * q + 1]; v.z = L[row * 33 + qtr * 8 + 4 * q + 2]; v.w = L[row * 33 + qtr * 8 + 4 * q + 3];
        *(u32x4*)(dp + 16 * q) = v;
    }
    __syncthreads();
}

__device__ __forceinline__ void ada_unit(const Frame& F, int layer, int cg) {
    LAS float* ca = (LAS float*)F.lds;
    const float* cin = F.in[IN_C];
    for (int i = F.tid; i < 2048; i += NTHREADS) { const float c = cin[i]; ca[i] = c * sigmoidf_fast(c); }
    __syncthreads();
    const float* w = F.in[layer ? L1_ADAW : L0_ADAW]; const float* bias = F.in[layer ? L1_ADAB : L0_ADAB];
    const int kq = F.wave, col = cg * 64 + F.lane;
    float a0 = 0.f, a1 = 0.f;
#pragma unroll 8
    for (int k = kq * 128; k < kq * 128 + 128; ++k) { const float wv = w[(size_t)k * 6144 + col]; a0 = fmaf(ca[k], wv, a0); a1 = fmaf(ca[1024 + k], wv, a1); }
    LAS float* red = ca + 2048;
    red[(kq * 2 + 0) * 64 + F.lane] = a0; red[(kq * 2 + 1) * 64 + F.lane] = a1;
    __syncthreads();
    if (F.tid < 128) { const int b = F.tid >> 6, l = F.tid & 63; float s = bias[cg * 64 + l];
#pragma unroll
        for (int q = 0; q < 8; ++q) s += red[(q * 2 + b) * 64 + l];
        ((float*)(F.ws + WS_ADA))[(layer * 2 + b) * 6144 + cg * 64 + l] = s; }
    __syncthreads();
}

__device__ __forceinline__ void s5tab_unit(const Frame& F, int unit) {
    const int idx = unit * NTHREADS + F.tid, g = idx >> 6, p = idx & 63;
    const double dt = exp((double)F.in[L0_LOGDT][g]);
    const double lr = (double)F.in[L0_LRE][idx], li = (double)F.in[L0_LIM][idx];
    const double mag = exp(lr * dt), ar = mag * cos(li * dt), ai = mag * sin(li * dt);
    const double den = lr * lr + li * li;
    const double fr = ((ar - 1.0) * lr + ai * li) / den, fi = (ai * lr - (ar - 1.0) * li) / den;
    const double mag32 = exp(32.0 * lr * dt), a32r = mag32 * cos(32.0 * li * dt), a32i = mag32 * sin(32.0 * li * dt);
    float* tab = (float*)(F.ws + WS_S5A);
    tab[idx] = (float)ar; tab[4096 + idx] = (float)ai; tab[8192 + idx] = (float)a32r; tab[12288 + idx] = (float)a32i;
    bf16_t* bop = (bf16_t*)(F.ws + WS_BOP); bf16_t* cop = (bf16_t*)(F.ws + WS_COP);
    const float* bre = F.in[L0_BRE] + (size_t)idx * 16; const float* bim = F.in[L0_BIM] + (size_t)idx * 16;
#pragma unroll
    for (int ch = 0; ch < 16; ++ch) {
        const double br = bre[ch], bi = bim[ch];
        bop[(g * 128 + p) * 16 + ch] = f2bf((float)(fr * br - fi * bi));
        bop[(g * 128 + 64 + p) * 16 + ch] = f2bf((float)(fr * bi + fi * br));
        cop[(g * 16 + ch) * 128 + p] = f2bf(F.in[L0_CRE][(g * 16 + ch) * 64 + p]);
        cop[(g * 16 + ch) * 128 + 64 + p] = f2bf(-F.in[L0_CIM][(g * 16 + ch) * 64 + p]);
    }
}

__device__ __forceinline__ void rope_unit(const Frame& F, int unit) {
    LAS float* invl = (LAS float*)F.lds;
    if (F.tid < 64) invl[F.tid] = (float)exp2(-(double)F.tid * (13.287712379549449 / 64.0));
    __syncthreads();
    const int idx = (unit * NTHREADS + F.tid) * 4, t = idx >> 6, i0 = idx & 63;
    const float pos = (float)((const int*)F.in[IN_POS])[t];
    f32x4 c, s;
#pragma unroll
    for (int e = 0; e < 4; ++e) {
        const float ang = pos * invl[i0 + e];
        const float k = rintf(ang * 0.15915494309189535f);
        float r = fmaf(-k, 6.28125f, ang); r = fmaf(-k, 1.9353071693331003e-3f, r); r = fmaf(-k, 1.0253131677018246e-11f, r);
        c[e] = __cosf(r); s[e] = __sinf(r);
    }
    *(f32x4*)((float*)(F.ws + WS_ROPE) + idx) = c;
    *(f32x4*)((float*)(F.ws + WS_ROPE) + (size_t)T * 64 + idx) = s;
    __syncthreads();
}

constexpr int CONV_L0DN_BEG = 4096, CONV_L1GU_BEG = 6144, CONV_L1DN_BEG = 10240, CONV_END = 12288;
constexpr int CONV_P10_BEG = CONV_L1GU_BEG + MK_CV0, CONV_P15_BEG = CONV_P10_BEG + MK_CV10;
constexpr int P0_CONV0 = 64, P0_CONV1 = 128, P0_CONV2 = 192, P0_CONV3 = 384, P0_CONV4 = 448, P0_CONV5 = 4544, P0_CONV6 = 6592, P0_CONV7 = 10688, P0_CONV8 = 12736;
constexpr int P0_ADA = P0_CONV8 + 192, P0_S5 = P0_ADA + 8, P0_ROPE = P0_S5 + 512, P0_WRB = P0_ROPE + 128, P0_END = P0_WRB + 32;

__device__ __forceinline__ void conv_batched(const Frame& F, int u, const float* src, size_t dst_off, int N) {
    const int per = 16 * (N / 256), e = u / per, r = u % per, kt = r / (N / 256), nt = r % (N / 256);
    conv_unit(F, src + (size_t)e * 1024 * N, (bf16_t*)(F.ws + dst_off) + (size_t)e * N * 1024, N, kt, nt, false);
}

__device__ __forceinline__ void conv_batched8(const Frame& F, int u, const float* src, size_t dst_off, int N) {
    const int per = 8 * (N / 128), e = u / per, r = u % per, kt = r / (N / 128), nt = r % (N / 128);
    conv_unit8(F, src + (size_t)e * 1024 * N, F.ws + dst_off + (size_t)e * N * 1024, N, kt, nt);
}

__device__ __forceinline__ bool moe_conv_decode(const Frame& F, int u, const float*& src, unsigned char*& dst, int& N) {
    if (u >= 12288) return false;
    const int fam = u < 4096 ? 0 : (u < 6144 ? 1 : (u < 10240 ? 2 : 3));
    const int base = fam == 0 ? 0 : (fam == 1 ? 4096 : (fam == 2 ? 6144 : 10240));
    N = (fam & 1) ? 1024 : 2048;
    const float* sp = fam == 0 ? F.in[L0_WGU] : (fam == 1 ? F.in[L0_WDN] : (fam == 2 ? F.in[L1_WGU] : F.in[L1_WDN]));
    const size_t doff = fam == 0 ? WS_WGU0 : (fam == 1 ? WS_WDN0 : (fam == 2 ? WS_WGU1 : WS_WDN1));
    const int r0 = u - base, per = 8 * (N / 128), e = r0 / per, r = r0 % per, kt = r / (N / 128), nt = r % (N / 128);
    src = sp + (size_t)e * 1024 * N + (size_t)(kt * 128 + 16 * F.wave + 8 * (F.lane >> 5)) * N + nt * 128 + 4 * (F.lane & 31);
    dst = F.ws + doff + (size_t)e * N * 1024 + (size_t)(nt * 128 + (F.tid >> 2)) * 1024 + kt * 128 + (F.tid & 3) * 32;
    return true;
}
__device__ __forceinline__ void moe_conv_stream(const Frame& F, int ubeg, int uend, int ci, int cn) {
    LAS unsigned* L = (LAS unsigned*)F.lds;
    const int nq = F.lane & 31, kd0 = 4 * F.wave + 2 * (F.lane >> 5), row = F.tid >> 2, qtr = F.tid & 3;
    const float* src; unsigned char* dst; int N;
    int u = ubeg + ci;
    if (u >= uend || !moe_conv_decode(F, u, src, dst, N)) return;
    f32x4 fa[8], fb[8]; unsigned char* da = dst; unsigned char* db = nullptr;
#define CV_LOAD(f) do { _Pragma("unroll") for (int i = 0; i < 8; ++i) f[i] = __builtin_nontemporal_load((const f32x4*)(src + (size_t)i * N)); } while (0)
#define CV_EMIT(f, d) do { unsigned pk[4][2]; \
        _Pragma("unroll") for (int c = 0; c < 4; ++c) { pk[c][0] = pack_fp8x4(f[0][c] * FP8_WSCALE, f[1][c] * FP8_WSCALE, f[2][c] * FP8_WSCALE, f[3][c] * FP8_WSCALE); \
                                                         pk[c][1] = pack_fp8x4(f[4][c] * FP8_WSCALE, f[5][c] * FP8_WSCALE, f[6][c] * FP8_WSCALE, f[7][c] * FP8_WSCALE); } \
        u += cn; more = u < uend && moe_conv_decode(F, u, src, dst, N); if (more) CV_LOAD(f); \
        _Pragma("unroll") for (int c = 0; c < 4; ++c) { L[(4 * nq + c) * 33 + kd0] = pk[c][0]; L[(4 * nq + c) * 33 + kd0 + 1] = pk[c][1]; } \
        asm volatile("s_waitcnt lgkmcnt(0)" ::: "memory"); __builtin_amdgcn_s_barrier(); asm volatile("" ::: "memory");     \
        _Pragma("unroll") for (int q = 0; q < 2; ++q) { u32x4 v; v.x = L[row * 33 + qtr * 8 + 4 * q + 0]; v.y = L[row * 33 + qtr * 8 + 4 * q + 1]; v.z = L[row * 33 + qtr * 8 + 4 * q + 2]; v.w = L[row * 33 + qtr * 8 + 4 * q + 3]; \
            *(u32x4*)((d) + 16 * q) = v; } \
        asm volatile("s_waitcnt lgkmcnt(0)" ::: "memory"); __builtin_amdgcn_s_barrier(); asm volatile("" ::: "memory"); } while (0)
    bool more;
    CV_LOAD(fa);
    u += cn; bool have_b = u < uend && moe_conv_decode(F, u, src, dst, N);
    if (have_b) { db = dst; CV_LOAD(fb); }
    for (;;) {
        unsigned char* d0 = da;
        CV_EMIT(fa, d0);
        const bool have_a = more; if (have_a) da = dst;
        if (!have_b) break;
        unsigned char* d1 = db;
        CV_EMIT(fb, d1);
        have_b = more; if (have_b) db = dst;
        if (!have_a) break;
    }
#undef CV_LOAD
#undef CV_EMIT
}

__device__ __forceinline__ void phase_prologue(const Frame& F) {
#if MK_CONVPROBE
    if ((F.c >> 3) >= 28) moe_conv_stream(F, 0, 12288, ((F.c >> 3) - 28) * 8 + (F.c & 7), 32);
#else
    moe_conv_stream(F, 0, CONV_L0DN_BEG, F.c, F.G);
    moe_conv_stream(F, CONV_L1GU_BEG, CONV_P10_BEG, F.c, F.G);
#endif
    for (int u = F.c; u < P0_END; u += F.G) {
        if (u >= P0_CONV4 && u < P0_CONV8) continue;
        if (u < P0_CONV0) conv_batched(F, u, F.in[L0_WIN], WS_WIN, 1024);
        else if (u < P0_CONV1) conv_batched8(F, u - P0_CONV0, F.in[L0_WGLU], WS_WGLU, 1024);
        else if (u < P0_CONV2) conv_batched(F, u - P0_CONV1, F.in[L0_WOUT], WS_WOUT, 1024);
        else if (u < P0_CONV3) { const int r = u - P0_CONV2; conv_unit8(F, F.in[L1_WQKV], F.ws + WS_WQKV, 3072, r / 24, r % 24, true); }
        else if (u < P0_CONV4) conv_batched8(F, u - P0_CONV3, F.in[L1_WO], WS_WO, 1024);
        else if (u < P0_CONV5) conv_batched8(F, u - P0_CONV4, F.in[L0_WGU], WS_WGU0, 2048);
        else if (u < P0_CONV6) conv_batched8(F, u - P0_CONV5, F.in[L0_WDN], WS_WDN0, 1024);
        else if (u < P0_CONV7) conv_batched8(F, u - P0_CONV6, F.in[L1_WGU], WS_WGU1, 2048);
        else if (u < P0_CONV8) conv_batched8(F, u - P0_CONV7, F.in[L1_WDN], WS_WDN1, 1024);
        else if (u < P0_ADA) { const int r = u - P0_CONV8; ada_unit(F, r / 96, r % 96); }
        else if (u < P0_S5) s5tab_unit(F, u - P0_ADA);
        else if (u < P0_ROPE) rope_unit(F, u - P0_S5);
        else if (u < P0_WRB) { const int idx = (u - P0_ROPE) * NTHREADS + F.tid, layer = idx >> 15, e = (idx >> 10) & 31, k = idx & 1023;
               ((bf16_t*)(F.ws + WS_WRB))[idx] = f2bf(F.in[layer ? L1_WR : L0_WR][k * 32 + e]); }
        else *(f32x4*)((float*)(F.ws + WS_KMEAN) + ((u - P0_WRB) * NTHREADS + F.tid) * 4) = (f32x4){0.f, 0.f, 0.f, 0.f};
    }
}

__device__ __forceinline__ void norm_mod_row(const float* __restrict__ xr, const float* __restrict__ gamma, const float* __restrict__ sh, const float* __restrict__ sc, bf16_t* __restrict__ hr, int lane) {
    f32x4 v[4]; float ss = 0.f;
#pragma unroll
    for (int i = 0; i < 4; ++i) { v[i] = *(const f32x4*)(xr + 256 * i + 4 * lane); ss += v[i][0] * v[i][0] + v[i][1] * v[i][1] + v[i][2] * v[i][2] + v[i][3] * v[i][3]; }
    ss = wave_sum(ss);
    const float rs = rsqrtf(ss * (1.f / 1024.f) + 1e-6f);
#pragma unroll
    for (int i = 0; i < 4; ++i) {
        const int col = 256 * i + 4 * lane;
        const f32x4 g = *(const f32x4*)(gamma + col), s1 = *(const f32x4*)(sc + col), s0 = *(const f32x4*)(sh + col);
        f32x4 y;
#pragma unroll
        for (int e = 0; e < 4; ++e) y[e] = v[i][e] * rs * g[e] * (1.f + s1[e]) + s0[e];
        u32x2 o; o.x = cvt_pk_bf16(y[0], y[1]); o.y = cvt_pk_bf16(y[2], y[3]);
        *(u32x2*)(hr + col) = o;
    }
}
__device__ __forceinline__ void phase_norm_mod(const Frame& F, const float* xin, const float* gamma, int layer, int which, bf16_t* hout) {
    const int lane = F.lane;
    for (int r = F.c * 8 + F.wave; r < T; r += F.G * 16) {
        const int r2 = r + F.G * 8; const bool two = r2 < T; const int rb = two ? r2 : r;
        f32x4 v[2][4];
#pragma unroll
        for (int i = 0; i < 4; ++i) { v[0][i] = *(const f32x4*)(xin + (size_t)r * DM + 256 * i + 4 * lane); v[1][i] = *(const f32x4*)(xin + (size_t)rb * DM + 256 * i + 4 * lane); }
#pragma unroll
        for (int q = 0; q < 2; ++q) {
            if (q == 1 && !two) break;
            const int rr = q ? rb : r, b = rr >> 13;
            const float* sh = ada_vec(F, layer, b, which); const float* sc = ada_vec(F, layer, b, which + 1);
            float ss = 0.f;
#pragma unroll
            for (int i = 0; i < 4; ++i) ss += v[q][i][0] * v[q][i][0] + v[q][i][1] * v[q][i][1] + v[q][i][2] * v[q][i][2] + v[q][i][3] * v[q][i][3];
            ss = wave_sum(ss);
            const float rs = rsqrtf(ss * (1.f / 1024.f) + 1e-6f);
#pragma unroll
            for (int i = 0; i < 4; ++i) {
                const int col = 256 * i + 4 * lane;
                const f32x4 g = *(const f32x4*)(gamma + col), s1 = *(const f32x4*)(sc + col), s0 = *(const f32x4*)(sh + col);
                f32x4 y;
#pragma unroll
                for (int e = 0; e < 4; ++e) y[e] = v[q][i][e] * rs * g[e] * (1.f + s1[e]) + s0[e];
                u32x2 o; o.x = cvt_pk_bf16(y[0], y[1]); o.y = cvt_pk_bf16(y[2], y[3]);
                *(u32x2*)(hout + (size_t)rr * DM + col) = o;
            }
        }
    }
}

template <class XT>
__device__ __forceinline__ void phase_norm_router(const Frame& F, const XT* xin, const bf16_t* mres, const float* gamma, int layer, unsigned char* hout) {
    const bf16_t* wrb = (const bf16_t*)(F.ws + WS_WRB) + (size_t)layer * 32 * 1024; const float* br = F.in[layer ? L1_BR : L0_BR];
    LAS unsigned char* hb = F.lds + F.wave * 16640;
    LAS int* cntl = (LAS int*)(F.lds + 133120);
    LAS int* basel = cntl + 32; LAS int* entl = cntl + 64;
    unsigned* gcnt = (unsigned*)(F.ws + ZB_MOECNT + layer * 256);
    int* pos = (int*)(F.ws + WS_TOPK); float* gates = (float*)(F.ws + WS_TOPK + (size_t)T * 4 * 4); int* vtok = (int*)(F.ws + WS_VTOK);
    const int lane = F.lane, e16 = lane & 15, kg = lane >> 4;
    for (int r0 = F.c * 64; r0 < T; r0 += F.G * 64) {
        if (F.tid < 32) cntl[F.tid] = 0;
        __syncthreads();
        const int rw = r0 + F.wave * 8;
        const int b = rw >> 13;
        const float* sh = ada_vec(F, layer, b, 3); const float* sc = ada_vec(F, layer, b, 4);
#pragma unroll 1
        for (int half = 0; half < 2; ++half) {
            f32x4 v[4][4]; u32x2 mr[4][4];
#pragma unroll
            for (int q = 0; q < 4; ++q)
#pragma unroll
                for (int i = 0; i < 4; ++i) { v[q][i] = load_x4(xin + (size_t)(rw + half * 4 + q) * DM + 256 * i + 4 * lane);
                                              mr[q][i] = *(const u32x2*)(mres + (size_t)(rw + half * 4 + q) * DM + 256 * i + 4 * lane); }
            { const float* g1 = ada_vec(F, layer, b, 2);
#pragma unroll
              for (int i = 0; i < 4; ++i) { const f32x4 gv = *(const f32x4*)(g1 + 256 * i + 4 * lane);
#pragma unroll
                for (int q = 0; q < 4; ++q) { v[q][i][0] = fmaf(gv[0], bf_lo(mr[q][i].x), v[q][i][0]); v[q][i][1] = fmaf(gv[1], bf_hi(mr[q][i].x), v[q][i][1]);
                                              v[q][i][2] = fmaf(gv[2], bf_lo(mr[q][i].y), v[q][i][2]); v[q][i][3] = fmaf(gv[3], bf_hi(mr[q][i].y), v[q][i][3]); } } }
#pragma unroll
            for (int q = 0; q < 4; ++q) {
                const int r = rw + half * 4 + q;
                float ss = 0.f;
#pragma unroll
                for (int i = 0; i < 4; ++i) ss += v[q][i][0] * v[q][i][0] + v[q][i][1] * v[q][i][1] + v[q][i][2] * v[q][i][2] + v[q][i][3] * v[q][i][3];
                ss = wave_sum(ss);
                const float rs = rsqrtf(ss * (1.f / 1024.f) + 1e-6f);
#pragma unroll
                for (int i = 0; i < 4; ++i) {
                    const int col = 256 * i + 4 * lane;
                    const f32x4 g = *(const f32x4*)(gamma + col), s1 = *(const f32x4*)(sc + col), s0 = *(const f32x4*)(sh + col);
                    f32x4 y;
#pragma unroll
                    for (int k = 0; k < 4; ++k) y[k] = v[q][i][k] * rs * g[k] * (1.f + s1[k]) + s0[k];
                    *(unsigned*)(hout + (size_t)r * DM + col) = pack_fp8x4(y[0], y[1], y[2], y[3]);
                    u32x2 o; o.x = cvt_pk_bf16(y[0], y[1]); o.y = cvt_pk_bf16(y[2], y[3]);
                    *(LAS u32x2*)(hb + (half * 4 + q) * 2080 + col * 2) = o;
                }
            }
        }
        f32x4 acc0 = {0.f, 0.f, 0.f, 0.f}, acc1 = {0.f, 0.f, 0.f, 0.f};
        const LAS unsigned char* ap = hb + (e16 & 7) * 2080 + kg * 16;
        const bf16_t* bp0 = wrb + (size_t)e16 * 1024 + kg * 8; const bf16_t* bp1 = bp0 + 16 * 1024;
#pragma unroll 8
        for (int ks = 0; ks < 32; ++ks) {
            const bf16x8 a = *(const LAS bf16x8*)(ap + ks * 64);
            const bf16x8 w0 = *(const bf16x8*)(bp0 + ks * 32), w1 = *(const bf16x8*)(bp1 + ks * 32);
            acc0 = __builtin_amdgcn_mfma_f32_16x16x32_bf16(a, w0, acc0, 0, 0, 0);
            acc1 = __builtin_amdgcn_mfma_f32_16x16x32_bf16(a, w1, acc1, 0, 0, 0);
        }
        const float bias0 = br[e16], bias1 = br[16 + e16];
#pragma unroll
        for (int reg = 0; reg < 4; ++reg) {
            float v0 = acc0[reg] + bias0, v1 = acc1[reg] + bias1;
            const int r = rw + ((4 * kg + reg) & 7);
            int ek[4]; float vk[4];
#pragma unroll
            for (int k = 0; k < 4; ++k) {
                const float m = row16_max(fmaxf(v0, v1));
                const int cand = row16_min((v0 == m) ? e16 : ((v1 == m) ? 16 + e16 : 99));
                ek[k] = cand; vk[k] = m;
                if (cand == e16) v0 = -INFINITY; else if (cand == 16 + e16) v1 = -INFINITY;
            }
            const float e1 = __expf(vk[1] - vk[0]), e2 = __expf(vk[2] - vk[0]), e3 = __expf(vk[3] - vk[0]);
            const float inv = 1.f / (1.f + e1 + e2 + e3);
            if (kg < 2 && e16 < 4) {
                const int ee = e16 == 0 ? ek[0] : e16 == 1 ? ek[1] : e16 == 2 ? ek[2] : ek[3];
                const float gg = (e16 == 0 ? 1.f : e16 == 1 ? e1 : e16 == 2 ? e2 : e3) * inv;
                const int rank = __hip_atomic_fetch_add(&cntl[ee], 1, __ATOMIC_RELAXED, __HIP_MEMORY_SCOPE_WORKGROUP);
                entl[(r - r0) * 4 + e16] = (ee << 16) | rank;
                gates[(size_t)r * 4 + e16] = gg;
            }
        }
        __syncthreads();
        if (F.tid < 32) basel[F.tid] = (int)atomicAdd(&gcnt[F.tid], (unsigned)cntl[F.tid]);
        __syncthreads();
        if (F.tid < 256) {
            const int en = entl[F.tid], ee = en >> 16, v = basel[ee] + (en & 0xffff), tk = r0 * 4 + F.tid;
            vtok[ee * MOE_CAP + v] = tk; pos[tk] = ee * MOE_CAP + v;
        }
        __syncthreads();
    }
}

namespace pg {
constexpr int BM = 256, BK = 64, HALF = 128, HTB = HALF * BK * 2, STAGE_BYTES = 8 * HTB, NXCD = 8, WGM = 8, KD = 1024, NKT = KD / BK;
__device__ __forceinline__ int lds_byte(int r, int c) { const int st = (r >> 4) * 2 + (c >> 5), rr = r & 15, cc = c & 31, ob = rr * 64 + cc * 2; return st * 1024 + (ob ^ (((ob >> 9) & 1) << 5)); }
__device__ __forceinline__ void stage_rc(int b, int& R, int& C) { const int st = b / 1024, sb = b % 1024, swz = sb ^ (((sb >> 9) & 1) << 5); R = (st >> 1) * 16 + swz / 64; C = (st & 1) * 32 + (swz % 64) / 2; }
__device__ __forceinline__ int perm32(int rho) { const int n = rho >> 4, i = rho & 15; return 8 * (i >> 2) + 4 * n + (i & 3); }

struct Unit { int rt, pn, e, ui; };

template <class P>
__device__ __forceinline__ void gemm_phase(LAS unsigned char* lds, const P& S) {
    const int tid = threadIdx.x, wid = __builtin_amdgcn_readfirstlane(tid >> 6), lane = tid & 63, wr = wid >> 2, wc = wid & 3, fr = lane & 15, fq = lane >> 4;
    int R0, C0; stage_rc(tid * 16, R0, C0);
    constexpr int ROWB = P::FP8 ? 1024 : 2048, NKT_ = ROWB / 128, KREP = P::KREP;
    unsigned voffB[2];
#pragma unroll
    for (int i = 0; i < 2; ++i) { const int R = R0 + 64 * i, Rb = P::PERM ? ((R & ~31) + perm32(R & 31)) : R; voffB[i] = (unsigned)(Rb * ROWB + C0 * 2); }
    const unsigned cofs = (unsigned)C0 * 2u;
    const unsigned ldsw = (unsigned)wid * 1024u;
    const int aoff = lds_byte(wr * 64 + fr, fq * 8), boff = lds_byte(wc * 32 + fr, fq * 8);
#define PG_SA(b, h) (((b) * 2 + (h)) * HTB)
#define PG_SB(b, h) ((4 + (b) * 2 + (h)) * HTB)
#define PG_STA(bufoff, kptr, V0, V1) do { \
        __builtin_amdgcn_global_load_lds((const unsigned*)((kptr) + (V0)), (LAS unsigned*)(lds + (bufoff) + ldsw), 16, 0, 0); \
        __builtin_amdgcn_global_load_lds((const unsigned*)((kptr) + (V1)), (LAS unsigned*)(lds + (bufoff) + ldsw + 8192), 16, 0, 0); } while (0)
#define PG_STB(bufoff, bptr) PG_STA(bufoff, bptr, voffB[0], voffB[1])
#define PG_LDA(dst, b, h) do { _Pragma("unroll") for (int m = 0; m < 4; ++m) dst[m] = __builtin_shufflevector(*(const LAS v4i*)(lds + PG_SA(b, h) + aoff + m * 2048), *(const LAS v4i*)(lds + PG_SA(b, h) + aoff + m * 2048 + 1024), 0, 1, 2, 3, 4, 5, 6, 7); } while (0)
#define PG_LDB(dst, b, h) do { _Pragma("unroll") for (int n = 0; n < 2; ++n) dst[n] = __builtin_shufflevector(*(const LAS v4i*)(lds + PG_SB(b, h) + boff + n * 2048), *(const LAS v4i*)(lds + PG_SB(b, h) + boff + n * 2048 + 1024), 0, 1, 2, 3, 4, 5, 6, 7); } while (0)
#define PG_LO(X) __builtin_bit_cast(bf16x8, __builtin_shufflevector(X, X, 0, 1, 2, 3))
#define PG_HI(X) __builtin_bit_cast(bf16x8, __builtin_shufflevector(X, X, 4, 5, 6, 7))
#define PG_MMA(ai, bj, At, Bt) do { __builtin_amdgcn_s_setprio(1); _Pragma("unroll") for (int m = 0; m < 4; ++m) _Pragma("unroll") for (int n = 0; n < 2; ++n) { \
        if constexpr (P::FP8) asm volatile("v_mfma_scale_f32_16x16x128_f8f6f4 %0, %1, %2, %0, %3, %3 op_sel_hi:[0,0,0]" : "+v"(acc[ai][bj][m][n]) : "v"(Bt[n]), "v"(At[m]), "v"(fp8_one)); \
        else { acc[ai][bj][m][n] = __builtin_amdgcn_mfma_f32_16x16x32_bf16(PG_LO(Bt[n]), PG_LO(At[m]), acc[ai][bj][m][n], 0, 0, 0); \
               acc[ai][bj][m][n] = __builtin_amdgcn_mfma_f32_16x16x32_bf16(PG_HI(Bt[n]), PG_HI(At[m]), acc[ai][bj][m][n], 0, 0, 0); } } \
        __builtin_amdgcn_s_setprio(0); } while (0)
#define PG_WAIT_V(n) asm volatile("s_waitcnt vmcnt(" #n ")" ::: "memory")
#define PG_WAIT_L(n) asm volatile("s_waitcnt lgkmcnt(" #n ")" ::: "memory")
#define PG_BAR __builtin_amdgcn_s_barrier()
#define PG_SCHED __builtin_amdgcn_sched_barrier(0)
    Unit cur, nxt; int ui = 0;
    if (!S.next(0, cur)) return;
    f32x4 acc[2][2][4][2];
    {   f32x4 bi[2][2]; S.binit(cur, wc, fq, bi);
#pragma unroll
        for (int a = 0; a < 2; ++a)
#pragma unroll
            for (int b = 0; b < 2; ++b)
#pragma unroll
                for (int m = 0; m < 4; ++m)
#pragma unroll
                    for (int n = 0; n < 2; ++n) acc[a][b][m][n] = bi[b][n] * P::BIAS_SCALE; }
    v8i At[4], B0[2], B1[2];
    int fp8_one = 0x7F7F7F7F; asm volatile("" : "+v"(fp8_one));
    unsigned va0, va1, va2, va3, vn0, vn1, vn2, vn3;
    S.arows(cur, R0, cofs, va0, va1, va2, va3);
    const char* cb0; const char* cb1; S.bptr(cur, cb0, cb1);
    const char* const A0 = S.abase();
    PG_STB(PG_SB(0, 0), cb0); PG_STA(PG_SA(0, 0), A0, va0, va1); PG_STB(PG_SB(0, 1), cb1); PG_STA(PG_SA(0, 1), A0, va2, va3);
    if (wr == 1) PG_BAR;
    PG_WAIT_V(4); PG_BAR;
    PG_STB(PG_SB(1, 0), cb0 + 128); PG_STA(PG_SA(1, 0), A0 + 128, va0, va1); PG_STB(PG_SB(1, 1), cb1 + 128);
    PG_WAIT_V(6); PG_BAR;
    for (;;) {
        const bool has_next = S.next(ui + 1, nxt);
        const char* nb0 = cb0; const char* nb1 = cb1; vn0 = va0; vn1 = va1; vn2 = va2; vn3 = va3;
        if (has_next) { S.arows(nxt, R0, cofs, vn0, vn1, vn2, vn3); S.bptr(nxt, nb0, nb1); }
#pragma unroll 1
        for (int tt = 0; tt < NKT_ * KREP; tt += 2) {
            const int t = tt % NKT_;
            const bool wrap = (t == NKT_ - 2), last = wrap && (tt == NKT_ * KREP - 2);
            const int kt2 = wrap ? 0 : t + 2;
            const char* a1 = A0 + (size_t)(t + 1) * 128; const char* a2 = A0 + (size_t)kt2 * 128; const char* a3 = a2 + 128;
            const char* b20 = (last ? nb0 : cb0) + (size_t)kt2 * 128; const char* b21 = (last ? nb1 : cb1) + (size_t)kt2 * 128;
            const unsigned w0 = last ? vn0 : va0, w1 = last ? vn1 : va1, w2 = last ? vn2 : va2, w3 = last ? vn3 : va3;
            PG_LDB(B0, 0, 0); PG_SCHED; PG_LDA(At, 0, 0); PG_STA(PG_SA(1, 1), a1, va2, va3);
            PG_WAIT_L(8); PG_BAR; PG_WAIT_L(0); PG_MMA(0, 0, At, B0); PG_BAR; PG_SCHED;
            PG_LDB(B1, 0, 1); PG_STB(PG_SB(0, 0), b20);
            PG_BAR; PG_WAIT_L(0); PG_MMA(0, 1, At, B1); PG_BAR;
            PG_LDA(At, 0, 1); PG_STA(PG_SA(0, 0), a2, w0, w1);
            PG_BAR; PG_WAIT_L(0); PG_MMA(1, 0, At, B0); PG_BAR; PG_SCHED;
            PG_STB(PG_SB(0, 1), b21);
            PG_WAIT_V(6); PG_BAR; PG_MMA(1, 1, At, B1); PG_BAR;
            PG_LDB(B0, 1, 0); PG_SCHED; PG_LDA(At, 1, 0); PG_STA(PG_SA(0, 1), a2, w2, w3);
            PG_WAIT_L(8); PG_BAR; PG_WAIT_L(0); PG_MMA(0, 0, At, B0); PG_BAR; PG_SCHED;
            PG_LDB(B1, 1, 1); PG_STB(PG_SB(1, 0), b20 + 128);
            PG_BAR; PG_WAIT_L(0); PG_MMA(0, 1, At, B1); PG_BAR;
            PG_LDA(At, 1, 1); PG_STA(PG_SA(1, 0), a3, w0, w1);
            PG_BAR; PG_WAIT_L(0); PG_MMA(1, 0, At, B0); PG_BAR; PG_SCHED;
            PG_STB(PG_SB(1, 1), b21 + 128);
            PG_WAIT_V(6); PG_BAR; PG_MMA(1, 1, At, B1); PG_BAR;
        }
        f32x4 bn[2][2];
        if (has_next) S.binit(nxt, wc, fq, bn);
        if constexpr (P::FP8) asm volatile("s_nop 15\n\ts_nop 15" ::: "memory");
        S.epi(acc, cur, wr, wc, fr, fq);
        if (!has_next) break;
#pragma unroll
        for (int a = 0; a < 2; ++a)
#pragma unroll
            for (int b = 0; b < 2; ++b)
#pragma unroll
                for (int m = 0; m < 4; ++m)
#pragma unroll
                    for (int n = 0; n < 2; ++n) acc[a][b][m][n] = bn[b][n] * P::BIAS_SCALE;
        cur = nxt; cb0 = nb0; cb1 = nb1; va0 = vn0; va1 = vn1; va2 = vn2; va3 = vn3; ++ui;
    }
    PG_WAIT_V(0);
    if (wr == 0) PG_BAR;
    PG_BAR;
#undef PG_SA
#undef PG_SB
#undef PG_STA
#undef PG_STB
#undef PG_LDA
#undef PG_LDB
#undef PG_MMA
#undef PG_LO
#undef PG_HI
#undef PG_WAIT_V
#undef PG_WAIT_L
#undef PG_BAR
#undef PG_SCHED
}

template <class Epi, bool FP8_ = false> struct Dense {
    static constexpr bool PERM = Epi::PERM, FP8 = FP8_; static constexpr int KREP = 1; static constexpr float BIAS_SCALE = 0.f;
    static constexpr unsigned ROWB = FP8_ ? 1024u : 2048u;
    const void* A; const void* Bt; int nM, nN, G, c; Epi E;
    __device__ __forceinline__ bool next(int i, Unit& u) const {
        const int nwg = nM * nN; const long L = (long)i * G + c; if (L >= nwg) return false;
        int wgid = (int)L; { const int q = nwg / NXCD, r = nwg % NXCD, xcd = wgid % NXCD, off = wgid / NXCD; wgid = (xcd < r ? xcd * (q + 1) : r * (q + 1) + (xcd - r) * q) + off; }
        const int nig = WGM * nN, gid = wgid / nig, fm = gid * WGM, gsz = (nM - fm) < WGM ? (nM - fm) : WGM;
        u.rt = fm + ((wgid % nig) % gsz); u.pn = (wgid % nig) / gsz; u.e = 0; u.ui = i; return true;
    }
    __device__ __forceinline__ void arows(const Unit& u, int R0, unsigned cofs, unsigned& v0, unsigned& v1, unsigned& v2, unsigned& v3) const {
        const unsigned base = (unsigned)(u.rt * 256 + R0) * ROWB + cofs; v0 = base; v1 = base + 64u * ROWB; v2 = base + 128u * ROWB; v3 = base + 192u * ROWB;
    }
    __device__ __forceinline__ const char* abase() const { return (const char*)A; }
    __device__ __forceinline__ void bptr(const Unit& u, const char*& b0, const char*& b1) const { b0 = (const char*)Bt + (size_t)u.pn * 256 * ROWB; b1 = b0 + (size_t)128 * ROWB; }
    __device__ __forceinline__ void epi(const f32x4 (&acc)[2][2][4][2], const Unit& u, int wr, int wc, int fr, int fq) const { E(acc, u, wr, wc, fr, fq); }
    __device__ __forceinline__ void binit(const Unit&, int, int, f32x4 (&bi)[2][2]) const { bi[0][0] = bi[0][1] = bi[1][0] = bi[1][1] = (f32x4){0.f, 0.f, 0.f, 0.f}; }
};

struct EpiBf16 {
    static constexpr bool PERM = true;
    bf16_t* O; float sc;
    __device__ __forceinline__ void operator()(const f32x4 (&acc)[2][2][4][2], const Unit& u, int wr, int wc, int fr, int fq) const {
        const int row0 = u.rt * 256 + wr * 64 + fr, col0 = u.pn * 256 + wc * 32 + 8 * fq;
#pragma unroll
        for (int ai = 0; ai < 2; ++ai)
#pragma unroll
            for (int m = 0; m < 4; ++m) { bf16_t* rowp = O + (size_t)(row0 + ai * 128 + m * 16) * 1024 + col0;
#pragma unroll
                for (int bj = 0; bj < 2; ++bj) { const f32x4 v0 = acc[ai][bj][m][0] * sc, v1 = acc[ai][bj][m][1] * sc;
                    u32x4 w; w.x = cvt_pk_bf16(v0[0], v0[1]); w.y = cvt_pk_bf16(v0[2], v0[3]); w.z = cvt_pk_bf16(v1[0], v1[1]); w.w = cvt_pk_bf16(v1[2], v1[3]);
                    *(u32x4*)(rowp + bj * 128) = w; } }
    }
};
struct EpiGlu {
    static constexpr bool PERM = true;
    const bf16_t* Z; bf16_t* O; float sc;
    __device__ __forceinline__ void operator()(const f32x4 (&acc)[2][2][4][2], const Unit& u, int wr, int wc, int fr, int fq) const {
        const int row0 = u.rt * 256 + wr * 64 + fr, col0 = u.pn * 256 + wc * 32 + 8 * fq;
#pragma unroll
        for (int ai = 0; ai < 2; ++ai)
#pragma unroll
            for (int m = 0; m < 4; ++m) { const size_t ro = (size_t)(row0 + ai * 128 + m * 16) * 1024 + col0;
#pragma unroll
                for (int bj = 0; bj < 2; ++bj) { const f32x4 v0 = acc[ai][bj][m][0] * sc, v1 = acc[ai][bj][m][1] * sc;
                    const u32x4 z = *(const u32x4*)(Z + ro + bj * 128);
                    u32x4 w;
                    w.x = cvt_pk_bf16(bf_lo(z.x) * sigmoidf_fast(v0[0]), bf_hi(z.x) * sigmoidf_fast(v0[1]));
                    w.y = cvt_pk_bf16(bf_lo(z.y) * sigmoidf_fast(v0[2]), bf_hi(z.y) * sigmoidf_fast(v0[3]));
                    w.z = cvt_pk_bf16(bf_lo(z.z) * sigmoidf_fast(v1[0]), bf_hi(z.z) * sigmoidf_fast(v1[1]));
                    w.w = cvt_pk_bf16(bf_lo(z.w) * sigmoidf_fast(v1[2]), bf_hi(z.w) * sigmoidf_fast(v1[3]));
                    *(u32x4*)(O + ro + bj * 128) = w; } }
    }
};
struct EpiResid {
    static constexpr bool PERM = false;
    const float* Xi; float* Xo; const float* gate0; const float* gate1; float sc;
    __device__ __forceinline__ void operator()(const f32x4 (&acc)[2][2][4][2], const Unit& u, int wr, int wc, int fr, int fq) const {
        const int row0 = u.rt * 256 + wr * 64 + fr, col0 = u.pn * 256 + wc * 32 + 4 * fq;
        const float* gate = (u.rt * 256 >= SEQ) ? gate1 : gate0;
        f32x4 gv[2][2];
#pragma unroll
        for (int bj = 0; bj < 2; ++bj)
#pragma unroll
            for (int n = 0; n < 2; ++n) gv[bj][n] = *(const f32x4*)(gate + col0 + bj * 128 + n * 16) * sc;
#pragma unroll
        for (int ai = 0; ai < 2; ++ai)
#pragma unroll
            for (int m = 0; m < 4; ++m) { const size_t ro = (size_t)(row0 + ai * 128 + m * 16) * 1024 + col0;
#pragma unroll
                for (int bj = 0; bj < 2; ++bj)
#pragma unroll
                    for (int n = 0; n < 2; ++n) { const f32x4 xi = *(const f32x4*)(Xi + ro + bj * 128 + n * 16); *(f32x4*)(Xo + ro + bj * 128 + n * 16) = xi + gv[bj][n] * acc[ai][bj][m][n]; } }
    }
};
struct EpiQkv {
    static constexpr bool PERM = true;
    bf16_t* Q; const float* cs; const float* sn; float sc; float* km;
    __device__ __forceinline__ void operator()(const f32x4 (&acc)[2][2][4][2], const Unit& u, int wr, int wc, int fr, int fq) const {
        const int sec = u.pn >> 2, row0 = u.rt * 256 + wr * 64 + fr, col0 = (u.pn & 3) * 256 + wc * 32 + 8 * fq, d0 = 16 * wc + 4 * fq;
        bf16_t* O = Q + (size_t)sec * T * DM;
        float ks[2][8];
#pragma unroll
        for (int bj = 0; bj < 2; ++bj)
#pragma unroll
            for (int j = 0; j < 8; ++j) ks[bj][j] = 0.f;
#pragma unroll
        for (int ai = 0; ai < 2; ++ai)
#pragma unroll
            for (int m = 0; m < 4; ++m) { const int row = row0 + ai * 128 + m * 16; bf16_t* rowp = O + (size_t)row * 1024 + col0;
                f32x4 c = {1.f, 1.f, 1.f, 1.f}, s = {0.f, 0.f, 0.f, 0.f};
                if (sec < 2) { c = *(const f32x4*)(cs + (size_t)row * 64 + d0); s = *(const f32x4*)(sn + (size_t)row * 64 + d0); }
#pragma unroll
                for (int bj = 0; bj < 2; ++bj) { const f32x4 v0 = acc[ai][bj][m][0] * sc, v1 = acc[ai][bj][m][1] * sc;
                    float r[8];
                    if (sec < 2) {
                        r[0] = v0[0] * c[0] - v0[1] * s[0]; r[1] = v0[1] * c[0] + v0[0] * s[0];
                        r[2] = v0[2] * c[1] - v0[3] * s[1]; r[3] = v0[3] * c[1] + v0[2] * s[1];
                        r[4] = v1[0] * c[2] - v1[1] * s[2]; r[5] = v1[1] * c[2] + v1[0] * s[2];
                        r[6] = v1[2] * c[3] - v1[3] * s[3]; r[7] = v1[3] * c[3] + v1[2] * s[3];
                    } else { r[0] = v0[0]; r[1] = v0[1]; r[2] = v0[2]; r[3] = v0[3]; r[4] = v1[0]; r[5] = v1[1]; r[6] = v1[2]; r[7] = v1[3]; }
                    if (sec == 1) {
#pragma unroll
                        for (int j = 0; j < 8; ++j) ks[bj][j] += r[j]; }
                    u32x4 w; w.x = cvt_pk_bf16(r[0], r[1]); w.y = cvt_pk_bf16(r[2], r[3]); w.z = cvt_pk_bf16(r[4], r[5]); w.w = cvt_pk_bf16(r[6], r[7]);
                    *(u32x4*)(rowp + bj * 128) = w; } }
        if (sec == 1) {
            const int b = (u.rt * 256) >> 13, n = (u.rt & 31);
#pragma unroll
            for (int bj = 0; bj < 2; ++bj) {
                const int h = (u.pn & 3) * 2 + bj;
#pragma unroll
                for (int j = 0; j < 8; ++j) ks[bj][j] = row16_sum(ks[bj][j]);
                if (fr == 0) { float* kp = km + ((size_t)(b * 8 + h) * 32 + n) * 128 + wc * 32 + 8 * fq;
#pragma unroll
                    for (int j = 0; j < 8; ++j) atomicAdd(kp + j, ks[bj][j] * (1.f / 256.f)); }
            }
        }
    }
};

constexpr int MOE_LDS_IDX = STAGE_BYTES;
constexpr int MOE_LDS_TILE_E = STAGE_BYTES + 12 * 1024;
constexpr int MOE_LDS_EBASE = MOE_LDS_TILE_E + 1280;
constexpr int MOE_LDS_ECNT = MOE_LDS_EBASE + 256;
struct MoeTabs { LAS int* idx; LAS int* tile_e; LAS int* ebase; LAS int* ecnt; int R; };
struct MoeGeo { int W, x, s, G, c; bool xcd; };
__device__ __forceinline__ MoeGeo moe_geo(int G, int c, int W) { MoeGeo g; g.xcd = (G == 256); g.W = W; g.x = c & 7; g.s = c >> 3; g.G = G; g.c = c; return g; }
template <int NPN>
__device__ __forceinline__ bool moe_unit(int i, const MoeGeo& g, int R, int& rt, int& pn) {
    if (g.xcd) {
        const int total = R * NPN, quota = (total + 7) >> 3, local = i * g.W + g.s, U = g.x * quota + local;
        rt = U / NPN; pn = U % NPN; return local < quota && U < total; }
    const long L = (long)i * g.G + g.c; rt = (int)(L / NPN); pn = (int)(L % NPN); return rt < R;
}
template <int NPN>
__device__ __forceinline__ MoeTabs moe_setup(const Frame& F, int layer, bool want_idx, const MoeGeo& geo) {
    MoeTabs M; M.idx = (LAS int*)(F.lds + MOE_LDS_IDX); M.tile_e = (LAS int*)(F.lds + MOE_LDS_TILE_E); M.ebase = (LAS int*)(F.lds + MOE_LDS_EBASE); M.ecnt = (LAS int*)(F.lds + MOE_LDS_ECNT);
    const unsigned* gcnt = (const unsigned*)(F.ws + ZB_MOECNT + layer * 256);
    if (F.tid < 64) {
        const int cnt = F.tid < 32 ? (int)gcnt[F.tid] : 0, nt = (cnt + 255) >> 8;
        int incl = nt;
#pragma unroll
        for (int o = 1; o < 32; o <<= 1) { const int y = __shfl_up(incl, o, 64); if (F.lane >= o) incl += y; }
        if (F.tid < 32) { M.ecnt[F.tid] = cnt; M.ebase[F.tid] = incl - nt; }
        if (F.tid == 31) M.ebase[32] = incl;
    }
    __syncthreads();
    M.R = M.ebase[32];
    if (F.tid < M.R) { int lo = 0, hi = 31;
        while (lo < hi) { const int mid = (lo + hi + 1) >> 1; if (M.ebase[mid] <= F.tid) lo = mid; else hi = mid - 1; }
        M.tile_e[F.tid] = lo; }
    __syncthreads();
    if (want_idx) {
        const int* vtok = (const int*)(F.ws + WS_VTOK);
        int tk[12];
#pragma unroll
        for (int i = 0; i < 12; ++i) { int rt, pn; tk[i] = 0;
            if (F.tid < 256 && moe_unit<NPN>(i, geo, M.R, rt, pn)) { const int e = M.tile_e[rt], v = (rt - M.ebase[e]) * 256 + F.tid; if (v < M.ecnt[e]) tk[i] = vtok[e * MOE_CAP + v]; } }
        if (F.tid < 256) {
#pragma unroll
            for (int i = 0; i < 12; ++i) M.idx[i * 256 + F.tid] = tk[i] >> 2; }
        __syncthreads();
    }
    return M;
}

template <int NPN>
__device__ __forceinline__ MoeTabs moe_setup(const Frame& F, int layer, bool want_idx, const MoeGeo& geo);
__device__ __forceinline__ MoeTabs moe_tabs_reuse(const Frame& F, int layer, const MoeGeo& geo) {
#if MK_MULTI
    return moe_setup<4>(F, layer, false, geo);
#endif
    MoeTabs M; M.idx = (LAS int*)(F.lds + MOE_LDS_IDX); M.tile_e = (LAS int*)(F.lds + MOE_LDS_TILE_E); M.ebase = (LAS int*)(F.lds + MOE_LDS_EBASE); M.ecnt = (LAS int*)(F.lds + MOE_LDS_ECNT);
    M.R = M.ebase[32]; return M;
}
struct MoeGateUp {
    static constexpr bool PERM = true, FP8 = true; static constexpr int KREP = MK_KREP; static constexpr float BIAS_SCALE = FP8_WSCALE * MK_KREP;
    const unsigned char* A; const unsigned char* W; const float* bias; unsigned char* O; MoeTabs M; MoeGeo geo;
    __device__ __forceinline__ bool next(int i, Unit& u) const {
        if (!moe_unit<8>(i, geo, M.R, u.rt, u.pn)) return false;
        u.e = __builtin_amdgcn_readfirstlane(M.tile_e[u.rt]); u.ui = i; return true;
    }
    __device__ __forceinline__ void arows(const Unit& u, int R0, unsigned cofs, unsigned& v0, unsigned& v1, unsigned& v2, unsigned& v3) const {
        const LAS int* ip = M.idx + u.ui * 256 + R0;
        v0 = (unsigned)ip[0] * 1024u + cofs; v1 = (unsigned)ip[64] * 1024u + cofs; v2 = (unsigned)ip[128] * 1024u + cofs; v3 = (unsigned)ip[192] * 1024u + cofs;
    }
    __device__ __forceinline__ const char* abase() const { return (const char*)A; }
    __device__ __forceinline__ void bptr(const Unit& u, const char*& b0, const char*& b1) const {
        const unsigned char* w = W + (size_t)u.e * 2048 * KD; b0 = (const char*)(w + (size_t)(u.pn * 128) * KD); b1 = (const char*)(w + (size_t)(1024 + u.pn * 128) * KD);
    }
    __device__ __forceinline__ void binit(const Unit& u, int wc, int fq, f32x4 (&bi)[2][2]) const {
        const float* bp = bias + (size_t)u.e * 2048 + u.pn * 128 + wc * 32 + 8 * fq;
        bi[0][0] = *(const f32x4*)bp; bi[0][1] = *(const f32x4*)(bp + 4); bi[1][0] = *(const f32x4*)(bp + 1024); bi[1][1] = *(const f32x4*)(bp + 1028);
    }
    __device__ __forceinline__ void epi(const f32x4 (&acc)[2][2][4][2], const Unit& u, int wr, int wc, int fr, int fq) const {
        const int row0 = u.rt * 256 + wr * 64 + fr, col0 = u.pn * 128 + wc * 32 + 8 * fq;
        constexpr float SC = 1.f / (FP8_WSCALE * MK_KREP);
#pragma unroll
        for (int ai = 0; ai < 2; ++ai)
#pragma unroll
            for (int m = 0; m < 4; ++m) {
                unsigned wq[2];
#pragma unroll
                for (int n = 0; n < 2; ++n) {
                    f32x4 g = acc[ai][0][m][n] * SC, uu = acc[ai][1][m][n] * SC;
#pragma unroll
                    for (int j = 0; j < 4; ++j) { g[j] = fminf(g[j], 7.f); uu[j] = __builtin_amdgcn_fmed3f(uu[j], -7.f, 7.f); }
                    f32x4 t = g * (-1.702f * 1.4426950408889634f);
#pragma unroll
                    for (int j = 0; j < 4; ++j) t[j] = __builtin_amdgcn_exp2f(t[j]);
                    f32x4 d = t * (1.f / FP8_ASCALE) + (1.f / FP8_ASCALE);
#pragma unroll
                    for (int j = 0; j < 4; ++j) d[j] = __builtin_amdgcn_rcpf(d[j]);
                    const f32x4 o = (uu * g + g) * d;
                    wq[n] = pack_fp8x4_nc(o[0], o[1], o[2], o[3]);
                }
                u32x2 w; w.x = wq[0]; w.y = wq[1];
                *(u32x2*)(O + (size_t)(row0 + ai * 128 + m * 16) * 1024 + col0) = w;
            }
    }
};
struct MoeDown {
    static constexpr bool PERM = true, FP8 = true; static constexpr int KREP = MK_KREP; static constexpr float BIAS_SCALE = FP8_WSCALE * FP8_ASCALE * MK_KREP;
    const unsigned char* A; const unsigned char* W; const float* bias; unsigned char* O; MoeTabs M; MoeGeo geo;
    __device__ __forceinline__ bool next(int i, Unit& u) const {
        if (!moe_unit<4>(i, geo, M.R, u.rt, u.pn)) return false;
        u.e = __builtin_amdgcn_readfirstlane(M.tile_e[u.rt]); u.ui = i; return true;
    }
    __device__ __forceinline__ void arows(const Unit& u, int R0, unsigned cofs, unsigned& v0, unsigned& v1, unsigned& v2, unsigned& v3) const {
        const unsigned base = (unsigned)(u.rt * 256 + R0) * 1024u + cofs; v0 = base; v1 = base + 64u * 1024u; v2 = base + 128u * 1024u; v3 = base + 192u * 1024u;
    }
    __device__ __forceinline__ const char* abase() const { return (const char*)A; }
    __device__ __forceinline__ void bptr(const Unit& u, const char*& b0, const char*& b1) const { b0 = (const char*)(W + (size_t)u.e * 1024 * KD + (size_t)u.pn * 256 * KD); b1 = b0 + (size_t)128 * KD; }
    __device__ __forceinline__ void binit(const Unit& u, int wc, int fq, f32x4 (&bi)[2][2]) const {
        const float* bp = bias + (size_t)u.e * 1024 + u.pn * 256 + wc * 32 + 8 * fq;
#pragma unroll
        for (int bj = 0; bj < 2; ++bj) { bi[bj][0] = *(const f32x4*)(bp + bj * 128); bi[bj][1] = *(const f32x4*)(bp + bj * 128 + 4); }
    }
    __device__ __forceinline__ void epi(const f32x4 (&acc)[2][2][4][2], const Unit& u, int wr, int wc, int fr, int fq) const {
        const int row0 = u.rt * 256 + wr * 64 + fr, col0 = u.pn * 256 + wc * 32 + 8 * fq;
        constexpr float SC = FP8_YSCALE / (FP8_WSCALE * FP8_ASCALE * MK_KREP);
#pragma unroll
        for (int ai = 0; ai < 2; ++ai)
#pragma unroll
            for (int m = 0; m < 4; ++m) { unsigned char* rowp = O + (size_t)(row0 + ai * 128 + m * 16) * 1024 + col0;
#pragma unroll
                for (int bj = 0; bj < 2; ++bj) { f32x4 v0 = acc[ai][bj][m][0] * SC, v1 = acc[ai][bj][m][1] * SC;
#pragma unroll
                    for (int j = 0; j < 4; ++j) { v0[j] = __builtin_amdgcn_fmed3f(v0[j], -448.f, 448.f); v1[j] = __builtin_amdgcn_fmed3f(v1[j], -448.f, 448.f); }
                    u32x2 w; w.x = pack_fp8x4_nc(v0[0], v0[1], v0[2], v0[3]); w.y = pack_fp8x4_nc(v1[0], v1[1], v1[2], v1[3]);
                    *(u32x2*)(rowp + bj * 128) = w; } }
    }
};
}

template <int OFF> __device__ __forceinline__ s16x4 ds_tr_read(int vb) {
    s16x4 r; asm volatile("ds_read_b64_tr_b16 %0, %1 offset:%2" : "=&v"(r) : "v"(vb), "i"(OFF) : "memory"); return r;
}
constexpr int S5_PITCH = 136, S5_IMG = 128 * S5_PITCH;

template <bool FULL>
__device__ __forceinline__ void phase_s5(const Frame& F, const bf16_t* __restrict__ U, bf16_t* __restrict__ Z, unsigned char* __restrict__ Z8) {
    const int lane = F.lane, n = lane & 31, h = lane >> 5;
    const float* tab = (const float*)(F.ws + WS_S5A);
    const bf16_t* bop = (const bf16_t*)(F.ws + WS_BOP); const bf16_t* cop = (const bf16_t*)(F.ws + WS_COP);
    float* carry = (float*)(F.ws + WS_CARRY);
    const float* dsk = F.in[L0_D];
    LAS unsigned char* xt = F.lds + F.wave * S5_IMG;
    for (int w = F.c; w < 2048; w += F.G) {
        const int g = (w & 7) * 8 + F.wave, chunk = (w >> 3) & 127, b = w >> 10;
        const int tok0 = b * SEQ + chunk * 64;
        bf16x8 Aop[2], Bop[4];
#pragma unroll
        for (int mt = 0; mt < 2; ++mt) { const int time = 32 * ((n >> 2) & 1) + 16 * mt + 4 * (n >> 3) + (n & 3);
            Aop[mt] = *(const bf16x8*)(U + (size_t)(tok0 + time) * DM + g * 16 + 8 * h); }
#pragma unroll
        for (int nt = 0; nt < 4; ++nt) Bop[nt] = *(const bf16x8*)(bop + (size_t)((g * 128 + nt * 32 + n) * 16 + 8 * h));
        f32x16 acc[2][4];
#pragma unroll
        for (int mt = 0; mt < 2; ++mt)
#pragma unroll
            for (int nt = 0; nt < 4; ++nt) { f32x16 z = {}; acc[mt][nt] = __builtin_amdgcn_mfma_f32_32x32x16_bf16(Aop[mt], Bop[nt], z, 0, 0, 0); }
        const float a0r = tab[g * 64 + n], a0i = tab[4096 + g * 64 + n], a1r = tab[g * 64 + 32 + n], a1i = tab[4096 + g * 64 + 32 + n];
        float* cp = carry + ((size_t)(b * 256 + chunk * 2 + h) * 64 + g) * 128;
        float x0r = 0.f, x0i = 0.f, x1r = 0.f, x1i = 0.f;
        if (FULL) { x0r = cp[n]; x0i = cp[64 + n]; x1r = cp[32 + n]; x1i = cp[96 + n]; }
#pragma unroll
        for (int mt = 0; mt < 2; ++mt)
#pragma unroll
            for (int r = 0; r < 16; ++r) {
                const float n0r = fmaf(a0r, x0r, fmaf(-a0i, x0i, acc[mt][0][r])), n0i = fmaf(a0r, x0i, fmaf(a0i, x0r, acc[mt][2][r]));
                const float n1r = fmaf(a1r, x1r, fmaf(-a1i, x1i, acc[mt][1][r])), n1i = fmaf(a1r, x1i, fmaf(a1i, x1r, acc[mt][3][r]));
                x0r = n0r; x0i = n0i; x1r = n1r; x1i = n1i;
                acc[mt][0][r] = x0r; acc[mt][2][r] = x0i; acc[mt][1][r] = x1r; acc[mt][3][r] = x1i;
            }
        if (!FULL) { cp[n] = x0r; cp[64 + n] = x0i; cp[32 + n] = x1r; cp[96 + n] = x1i; continue; }
#pragma unroll
        for (int mt = 0; mt < 2; ++mt)
#pragma unroll
            for (int nt = 0; nt < 4; ++nt)
#pragma unroll
                for (int q = 0; q < 4; ++q) {
                    u32x2 pk; pk.x = cvt_pk_bf16(acc[mt][nt][4 * q + 0], acc[mt][nt][4 * q + 1]); pk.y = cvt_pk_bf16(acc[mt][nt][4 * q + 2], acc[mt][nt][4 * q + 3]);
                    *(LAS u32x2*)(xt + (nt * 32 + n) * S5_PITCH + (32 * h + 16 * mt + 4 * q) * 2) = pk;
                }
        const int ch = lane & 15, kg = lane >> 4;
        bf16x8 Cf[4];
#pragma unroll
        for (int ks = 0; ks < 4; ++ks) Cf[ks] = *(const bf16x8*)(cop + (size_t)((g * 16 + ch) * 128 + 32 * ks + 8 * kg));
        const int trb = (int)(uintptr_t)xt + (8 * kg + (ch >> 2)) * S5_PITCH + (4 * (ch & 3)) * 2;
        f32x4 y[4];
#pragma unroll
        for (int tb = 0; tb < 4; ++tb) y[tb] = (f32x4){0.f, 0.f, 0.f, 0.f};
        asm volatile("s_waitcnt lgkmcnt(0)" ::: "memory");
#define S5_TR(tb, ks, hi4) ds_tr_read<(32 * (ks) + 4 * (hi4)) * S5_PITCH + 32 * (tb)>(trb)
#define S5_STEP(tb, ks) do { const s16x4 lo = S5_TR(tb, ks, 0), hi = S5_TR(tb, ks, 1); asm volatile("s_waitcnt lgkmcnt(0)" ::: "memory"); __builtin_amdgcn_sched_barrier(0); \
            const bf16x8 bf = (bf16x8){lo[0], lo[1], lo[2], lo[3], hi[0], hi[1], hi[2], hi[3]}; y[tb] = __builtin_amdgcn_mfma_f32_16x16x32_bf16(Cf[ks], bf, y[tb], 0, 0, 0); } while (0)
        S5_STEP(0, 0); S5_STEP(0, 1); S5_STEP(0, 2); S5_STEP(0, 3);
        S5_STEP(1, 0); S5_STEP(1, 1); S5_STEP(1, 2); S5_STEP(1, 3);
        S5_STEP(2, 0); S5_STEP(2, 1); S5_STEP(2, 2); S5_STEP(2, 3);
        S5_STEP(3, 0); S5_STEP(3, 1); S5_STEP(3, 2); S5_STEP(3, 3);
#undef S5_STEP
#undef S5_TR
        const f32x4 dv = *(const f32x4*)(dsk + g * 16 + 4 * kg);
#pragma unroll
        for (int tb = 0; tb < 4; ++tb) {
            const size_t o = (size_t)(tok0 + 16 * tb + ch) * DM + g * 16 + 4 * kg;
            const u32x2 uu = *(const u32x2*)(U + o);
            const float y0 = y[tb][0] + dv[0] * bf_lo(uu.x), y1 = y[tb][1] + dv[1] * bf_hi(uu.x), y2 = y[tb][2] + dv[2] * bf_lo(uu.y), y3 = y[tb][3] + dv[3] * bf_hi(uu.y);
            const float z0 = gelu_tanh(y0), z1 = gelu_tanh(y1), z2 = gelu_tanh(y2), z3 = gelu_tanh(y3);
            u32x2 zz; zz.x = cvt_pk_bf16(z0, z1); zz.y = cvt_pk_bf16(z2, z3);
            *(u32x2*)(Z + o) = zz;
            *(unsigned*)(Z8 + o) = pack_fp8x4(z0, z1, z2, z3);
        }
    }
}

__device__ __forceinline__ void phase_s5_carry(const Frame& F) {
    const float* tab = (const float*)(F.ws + WS_S5A);
    float* carry = (float*)(F.ws + WS_CARRY);
    LAS float* E = (LAS float*)F.lds;
    for (int pair = F.c; pair < 128; pair += F.G) {
        const int b = pair >> 6, g = pair & 63, p = F.lane, w = F.wave;
        const float ar = tab[8192 + g * 64 + p], ai = tab[12288 + g * 64 + p];
        float* ptr = carry + ((size_t)(b * 256 + 32 * w) * 64 + g) * 128 + p;
        float cr[32], ci[32];
#pragma unroll
        for (int j = 0; j < 32; ++j) { cr[j] = ptr[(size_t)j * 8192]; ci[j] = ptr[(size_t)j * 8192 + 64]; }
        float xr = 0.f, xi = 0.f;
#pragma unroll
        for (int j = 0; j < 32; ++j) { const float nr = fmaf(ar, xr, fmaf(-ai, xi, cr[j])), ni = fmaf(ar, xi, fmaf(ai, xr, ci[j])); xr = nr; xi = ni; }
        E[(w * 2 + 0) * 64 + p] = xr; E[(w * 2 + 1) * 64 + p] = xi;
        float sr = ar, si = ai;
#pragma unroll
        for (int q = 0; q < 5; ++q) { const float nr = sr * sr - si * si, ni = 2.f * sr * si; sr = nr; si = ni; }
        __syncthreads();
        xr = 0.f; xi = 0.f;
        for (int v = 0; v < w; ++v) { const float er = E[(v * 2 + 0) * 64 + p], ei = E[(v * 2 + 1) * 64 + p];
            const float nr = fmaf(sr, xr, fmaf(-si, xi, er)), ni = fmaf(sr, xi, fmaf(si, xr, ei)); xr = nr; xi = ni; }
#pragma unroll
        for (int j = 0; j < 32; ++j) {
            ptr[(size_t)j * 8192] = xr; ptr[(size_t)j * 8192 + 64] = xi;
            const float nr = fmaf(ar, xr, fmaf(-ai, xi, cr[j])), ni = fmaf(ar, xi, fmaf(ai, xr, ci[j])); xr = nr; xi = ni;
        }
        __syncthreads();
    }
}

template <bool FINAL, class XT>
__device__ __forceinline__ void phase_moe_combine(const Frame& F, int layer, const XT* xold, const bf16_t* mres, bf16_t* xnew, const float* gamma_next, unsigned char* hnext, float* outp) {
    LAS int* ebase = (LAS int*)F.lds;
    const unsigned* gcnt = (const unsigned*)(F.ws + ZB_MOECNT + layer * 256);
    if (F.tid < 64) {
        const int nt = F.tid < 32 ? (((int)gcnt[F.tid] + 255) >> 8) : 0;
        int incl = nt;
#pragma unroll
        for (int o = 1; o < 32; o <<= 1) { const int y = __shfl_up(incl, o, 64); if (F.lane >= o) incl += y; }
        if (F.tid < 32) ebase[F.tid] = incl - nt;
    }
    __syncthreads();
    const int* pos = (const int*)(F.ws + WS_TOPK); const float* gates = (const float*)(F.ws + WS_TOPK + (size_t)T * 4 * 4);
    const unsigned char* yk = F.ws + WS_YK;
    const int lane = F.lane;
    for (int r0 = F.c * 8 + F.wave; r0 < T; r0 += F.G * 16) {
        const int r1 = (r0 + F.G * 8 < T) ? r0 + F.G * 8 : r0;
        u32x4 pp[2]; f32x4 gg[2];
        pp[0] = *(const u32x4*)(pos + (size_t)r0 * 4); pp[1] = *(const u32x4*)(pos + (size_t)r1 * 4);
        gg[0] = *(const f32x4*)(gates + (size_t)r0 * 4); gg[1] = *(const f32x4*)(gates + (size_t)r1 * 4);
        f32x4 xo[2][4]; u32x2 yv[2][4][2]; u32x4 mv[2][2];
#pragma unroll
        for (int q = 0; q < 2; ++q) { const int r = q ? r1 : r0;
#pragma unroll
            for (int i = 0; i < 2; ++i) { mv[q][i] = *(const u32x4*)(mres + (size_t)r * DM + 512 * i + 8 * lane);
#pragma unroll
                for (int h = 0; h < 2; ++h) xo[q][2 * i + h] = load_x4(xold + (size_t)r * DM + 512 * i + 8 * lane + 4 * h); }
#pragma unroll
            for (int k = 0; k < 4; ++k) { const int pk = (int)pp[q][k], e = pk >> 14, v = pk & 16383; const size_t phys = (size_t)ebase[e] * 256 + v;
#pragma unroll
                for (int i = 0; i < 2; ++i) yv[q][k][i] = *(const u32x2*)(yk + phys * 1024 + 512 * i + 8 * lane); } }
#pragma unroll
        for (int q = 0; q < 2; ++q) {
            const int r = q ? r1 : r0, b = r >> 13;
            const float* g2 = ada_vec(F, layer, b, 5);
            { const float* g1 = ada_vec(F, layer, b, 2);
#pragma unroll
              for (int i = 0; i < 2; ++i) { const f32x4 ga = *(const f32x4*)(g1 + 512 * i + 8 * lane), gb = *(const f32x4*)(g1 + 512 * i + 8 * lane + 4); const u32x4 m = mv[q][i];
                xo[q][2 * i][0] = fmaf(ga[0], bf_lo(m.x), xo[q][2 * i][0]); xo[q][2 * i][1] = fmaf(ga[1], bf_hi(m.x), xo[q][2 * i][1]);
                xo[q][2 * i][2] = fmaf(ga[2], bf_lo(m.y), xo[q][2 * i][2]); xo[q][2 * i][3] = fmaf(ga[3], bf_hi(m.y), xo[q][2 * i][3]);
                xo[q][2 * i + 1][0] = fmaf(gb[0], bf_lo(m.z), xo[q][2 * i + 1][0]); xo[q][2 * i + 1][1] = fmaf(gb[1], bf_hi(m.z), xo[q][2 * i + 1][1]);
                xo[q][2 * i + 1][2] = fmaf(gb[2], bf_lo(m.w), xo[q][2 * i + 1][2]); xo[q][2 * i + 1][3] = fmaf(gb[3], bf_hi(m.w), xo[q][2 * i + 1][3]); } }
            float acc[16];
#pragma unroll
            for (int j = 0; j < 16; ++j) acc[j] = 0.f;
#pragma unroll
            for (int k = 0; k < 4; ++k) { const float gk = gg[q][k] * (1.f / FP8_YSCALE);
#pragma unroll
                for (int i = 0; i < 2; ++i) { const u32x2 w = yv[q][k][i];
                    const f32x2 p0 = __builtin_amdgcn_cvt_pk_f32_fp8((int)w.x, false), p1 = __builtin_amdgcn_cvt_pk_f32_fp8((int)w.x, true);
                    const f32x2 p2 = __builtin_amdgcn_cvt_pk_f32_fp8((int)w.y, false), p3 = __builtin_amdgcn_cvt_pk_f32_fp8((int)w.y, true);
                    acc[8 * i + 0] = fmaf(gk, p0[0], acc[8 * i + 0]); acc[8 * i + 1] = fmaf(gk, p0[1], acc[8 * i + 1]);
                    acc[8 * i + 2] = fmaf(gk, p1[0], acc[8 * i + 2]); acc[8 * i + 3] = fmaf(gk, p1[1], acc[8 * i + 3]);
                    acc[8 * i + 4] = fmaf(gk, p2[0], acc[8 * i + 4]); acc[8 * i + 5] = fmaf(gk, p2[1], acc[8 * i + 5]);
                    acc[8 * i + 6] = fmaf(gk, p3[0], acc[8 * i + 6]); acc[8 * i + 7] = fmaf(gk, p3[1], acc[8 * i + 7]); } }
            float xn[16]; float ss = 0.f;
#pragma unroll
            for (int i = 0; i < 2; ++i)
#pragma unroll
                for (int h = 0; h < 2; ++h) { const int col = 512 * i + 8 * lane + 4 * h;
                    const f32x4 gv = *(const f32x4*)(g2 + col);
                    f32x4 xv;
#pragma unroll
                    for (int j = 0; j < 4; ++j) { xv[j] = xo[q][2 * i + h][j] + gv[j] * acc[8 * i + 4 * h + j]; xn[8 * i + 4 * h + j] = xv[j]; ss += xv[j] * xv[j]; }
                    if (!FINAL) { u32x2 xw; xw.x = cvt_pk_bf16(xv[0], xv[1]); xw.y = cvt_pk_bf16(xv[2], xv[3]); *(u32x2*)(xnew + (size_t)r * DM + col) = xw; } }
            ss = wave_sum(ss);
            const float rs = rsqrtf(ss * (1.f / 1024.f) + 1e-6f);
            if (FINAL) {
#pragma unroll
                for (int i = 0; i < 2; ++i)
#pragma unroll
                    for (int h = 0; h < 2; ++h) { const int col = 512 * i + 8 * lane + 4 * h; const f32x4 g = *(const f32x4*)(gamma_next + col);
                        f32x4 o;
#pragma unroll
                        for (int j = 0; j < 4; ++j) o[j] = xn[8 * i + 4 * h + j] * rs * g[j];
                        *(f32x4*)(outp + (size_t)r * DM + col) = o; }
            } else {
                const float* sh = ada_vec(F, layer + 1, b, 0); const float* sc = ada_vec(F, layer + 1, b, 1);
#pragma unroll
                for (int i = 0; i < 2; ++i) { const int col = 512 * i + 8 * lane;
                    float yv8[8];
#pragma unroll
                    for (int h = 0; h < 2; ++h) { const f32x4 g = *(const f32x4*)(gamma_next + col + 4 * h), s1 = *(const f32x4*)(sc + col + 4 * h), s0 = *(const f32x4*)(sh + col + 4 * h);
#pragma unroll
                        for (int j = 0; j < 4; ++j) yv8[4 * h + j] = xn[8 * i + 4 * h + j] * rs * g[j] * (1.f + s1[j]) + s0[j]; }
                    u32x2 w; w.x = pack_fp8x4(yv8[0], yv8[1], yv8[2], yv8[3]); w.y = pack_fp8x4(yv8[4], yv8[5], yv8[6], yv8[7]);
                    *(u32x2*)(hnext + (size_t)r * DM + col) = w; }
            }
        }
    }
    __syncthreads();
}

__device__ __forceinline__ void phase_kmean(const Frame& F, const bf16_t* __restrict__ K) {
    LAS float* red = (LAS float*)F.lds;
    float* km = (float*)(F.ws + WS_KMEAN);
    for (int u = F.c; u < 512; u += F.G) {
        const int h = u & 7, n = (u >> 3) & 31, b = u >> 8;
        const int colc = F.tid & 15, rg = F.tid >> 4;
        const bf16_t* base = K + ((size_t)(b * SEQ + n * 256 + rg * 8)) * DM + h * 128 + colc * 8;
        float acc[8];
#pragma unroll
        for (int j = 0; j < 8; ++j) acc[j] = 0.f;
#pragma unroll
        for (int r = 0; r < 8; ++r) { const u32x4 w = *(const u32x4*)(base + (size_t)r * DM);
            acc[0] += bf_lo(w.x); acc[1] += bf_hi(w.x); acc[2] += bf_lo(w.y); acc[3] += bf_hi(w.y); acc[4] += bf_lo(w.z); acc[5] += bf_hi(w.z); acc[6] += bf_lo(w.w); acc[7] += bf_hi(w.w); }
#pragma unroll
        for (int j = 0; j < 8; ++j) red[rg * 128 + colc * 8 + j] = acc[j];
        __syncthreads();
        if (F.tid < 128) { float s = 0.f;
#pragma unroll
            for (int q = 0; q < 32; ++q) s += red[q * 128 + F.tid];
            km[((size_t)(b * 8 + h) * 32 + n) * 128 + F.tid] = s * (1.f / 256.f); }
        __syncthreads();
    }
}

__device__ __forceinline__ int alist_base(int n) { return 256 * (31 * n - (n * (n - 1)) / 2); }

__device__ __forceinline__ void phase_gating(const Frame& F, const bf16_t* __restrict__ Q) {
    LAS float* kml = (LAS float*)F.lds;
    LAS int* cntl = (LAS int*)(F.lds + 16384); LAS int* basel = cntl + 32; LAS int* entl = cntl + 64;
    const float* km = (const float*)(F.ws + WS_KMEAN);
    unsigned* gcnt = (unsigned*)(F.ws + ZB_ATTCNT);
    int* alist = (int*)(F.ws + WS_ALIST);
    for (int u = F.c; u < 256; u += F.G) {
        const int jp = u & 15, h = (u >> 4) & 7, b = u >> 7, bh = b * 8 + h;
        for (int i = F.tid; i < 4096; i += NTHREADS) kml[i] = km[(size_t)bh * 4096 + i];
        if (F.tid < 32) cntl[F.tid] = 0;
        __syncthreads();
        const int s = jp * 512 + F.tid, j = __builtin_amdgcn_readfirstlane(s >> 8);
        u32x4 q[16];
        { const bf16_t* qp = Q + (size_t)(b * SEQ + s) * DM + h * 128;
#pragma unroll
          for (int i = 0; i < 16; ++i) q[i] = *(const u32x4*)(qp + 8 * i); }
        float v0 = -INFINITY, v1 = -INFINITY, v2 = -INFINITY; int i0 = 0, i1 = 0, i2 = 0;
#pragma unroll 1
        for (int n = 0; n < j; ++n) {
            float d = 0.f;
#pragma unroll
            for (int i = 0; i < 16; ++i) { const f32x4 ka = *(const LAS f32x4*)(kml + n * 128 + 8 * i), kb = *(const LAS f32x4*)(kml + n * 128 + 8 * i + 4);
                d = fmaf(bf_lo(q[i].x), ka[0], d); d = fmaf(bf_hi(q[i].x), ka[1], d); d = fmaf(bf_lo(q[i].y), ka[2], d); d = fmaf(bf_hi(q[i].y), ka[3], d);
                d = fmaf(bf_lo(q[i].z), kb[0], d); d = fmaf(bf_hi(q[i].z), kb[1], d); d = fmaf(bf_lo(q[i].w), kb[2], d); d = fmaf(bf_hi(q[i].w), kb[3], d); }
            if (d > v0) { v2 = v1; i2 = i1; v1 = v0; i1 = i0; v0 = d; i0 = n; }
            else if (d > v1) { v2 = v1; i2 = i1; v1 = d; i1 = n; }
            else if (d > v2) { v2 = d; i2 = n; }
        }
        const int nsel = j < 3 ? j : 3;
        if (nsel > 0) entl[F.tid * 3 + 0] = (i0 << 16) | __hip_atomic_fetch_add(&cntl[i0], 1, __ATOMIC_RELAXED, __HIP_MEMORY_SCOPE_WORKGROUP);
        if (nsel > 1) entl[F.tid * 3 + 1] = (i1 << 16) | __hip_atomic_fetch_add(&cntl[i1], 1, __ATOMIC_RELAXED, __HIP_MEMORY_SCOPE_WORKGROUP);
        if (nsel > 2) entl[F.tid * 3 + 2] = (i2 << 16) | __hip_atomic_fetch_add(&cntl[i2], 1, __ATOMIC_RELAXED, __HIP_MEMORY_SCOPE_WORKGROUP);
        __syncthreads();
        if (F.tid < 32) basel[F.tid] = cntl[F.tid] ? (int)atomicAdd(&gcnt[bh * 32 + F.tid], (unsigned)cntl[F.tid]) : 0;
        __syncthreads();
#pragma unroll
        for (int k = 0; k < 3; ++k) if (k < nsel) { const int en = entl[F.tid * 3 + k], n = en >> 16, v = basel[n] + (en & 0xffff);
            alist[(size_t)bh * ALIST_PER_BH + alist_base(n) + v] = s | (k << 16); }
        __syncthreads();
    }
}

namespace at {
constexpr int D = 128, NW = 8, QBLK = 32, KVBLK = 64, LDK = 1024, NT = 4;
constexpr float SCALE = 0.088388347648318440f, THR = 8.f, CL2 = SCALE * 1.4426950408889634f;
constexpr int SHM_V = KVBLK * D * 2, SHM_K = KVBLK * D * 2, SHM_WS = NW * 8704  , SHM_ATTN = SHM_WS + NW * 96 * 4;
constexpr int LDS_PRE = 73728;
#define KSWZ(row, colB) ((row) * 256 + ((colB) ^ (((row) & 7) << 4)))
#define SBAR() __builtin_amdgcn_sched_barrier(0)
__device__ __forceinline__ int crow(int r, int hi) { return (r & 3) + 8 * (r >> 2) + 4 * hi; }
__device__ __forceinline__ void partialSM(f32x16& p0, f32x16& p1, float& m_reg, float& mn, float& alpha) {
    float pmax = p0[0];
#pragma unroll
    for (int r = 1; r < 16; ++r) pmax = fmaxf(pmax, p0[r]);
#pragma unroll
    for (int r = 0; r < 16; ++r) pmax = fmaxf(pmax, p1[r]);
    { auto rr = __builtin_amdgcn_permlane32_swap(__float_as_uint(pmax), __float_as_uint(pmax), false, false);
      pmax = fmaxf(__uint_as_float(rr[0]), __uint_as_float(rr[1])); }
    if (__builtin_expect(__all(pmax - m_reg <= THR / SCALE), 1)) { mn = m_reg; alpha = 1.f; }
    else { mn = fmaxf(m_reg, pmax); alpha = __builtin_amdgcn_exp2f((m_reg - mn) * CL2); m_reg = mn; }
    const float mnC = -mn * CL2;
#pragma unroll
    for (int r = 0; r < 16; ++r) p0[r] = fmaf(p0[r], CL2, mnC);
#pragma unroll
    for (int r = 0; r < 16; ++r) p1[r] = fmaf(p1[r], CL2, mnC);
#pragma unroll
    for (int r = 0; r < 16; ++r) p0[r] = __builtin_amdgcn_exp2f(p0[r]);
}
__device__ __forceinline__ void finishSM(f32x16& p0, f32x16& p1, float alpha, float& l_reg, bf16x8& pa0, bf16x8& pa1, bf16x8& pa2, bf16x8& pa3) {
#pragma unroll
    for (int r = 0; r < 16; ++r) p1[r] = __builtin_amdgcn_exp2f(p1[r]);
    float ps = 0;
#pragma unroll
    for (int r = 0; r < 16; ++r) ps += p0[r];
#pragma unroll
    for (int r = 0; r < 16; ++r) ps += p1[r];
    { auto rr = __builtin_amdgcn_permlane32_swap(__float_as_uint(ps), __float_as_uint(ps), false, false);
      ps = __uint_as_float(rr[0]) + __uint_as_float(rr[1]); }
    l_reg = l_reg * alpha + ps;
#define PK4(P, BASE, OUT) do { unsigned a0 = cvt_pk_bf16(P[BASE + 0], P[BASE + 1]), a1 = cvt_pk_bf16(P[BASE + 2], P[BASE + 3]);   \
    unsigned b0 = cvt_pk_bf16(P[BASE + 4], P[BASE + 5]), b1 = cvt_pk_bf16(P[BASE + 6], P[BASE + 7]);                              \
    auto r0 = __builtin_amdgcn_permlane32_swap(a0, b0, false, false); auto r1 = __builtin_amdgcn_permlane32_swap(a1, b1, false, false); \
    u32x4 w = {r0[0], r1[0], r0[1], r1[1]}; OUT = *reinterpret_cast<bf16x8*>(&w); } while (0)
    PK4(p0, 0, pa0); PK4(p0, 8, pa1); PK4(p1, 0, pa2); PK4(p1, 8, pa3);
#undef PK4
}
__device__ __forceinline__ void qkt(f32x16& p0, f32x16& p1, const char* Ks, const bf16x8* qr, int r32, int hi) {
    p0 = f32x16{}; p1 = f32x16{};
#pragma unroll
    for (int d0 = 0; d0 < 8; ++d0) { const int cb = (d0 * 16 + hi * 8) * 2;
        const bf16x8 b0 = *reinterpret_cast<const bf16x8*>(Ks + KSWZ(r32, cb));
        const bf16x8 b1 = *reinterpret_cast<const bf16x8*>(Ks + KSWZ(32 + r32, cb));
        p0 = __builtin_amdgcn_mfma_f32_32x32x16_bf16(b0, qr[d0], p0, 0, 0, 0);
        p1 = __builtin_amdgcn_mfma_f32_32x32x16_bf16(b1, qr[d0], p1, 0, 0, 0); }
}
__device__ __forceinline__ void causal_mask(f32x16& p0, f32x16& p1, int kt, int qrow, int hi) {
#pragma unroll
    for (int r = 0; r < 16; ++r) { const int key = kt * 64 + crow(r, hi); if (key > qrow) p0[r] = -1e30f; if (key + 32 > qrow) p1[r] = -1e30f; }
}
__device__ __forceinline__ int v_st(int k, int c) { const int kk = (k & ~0xC) | ((k & 4) << 1) | ((k & 8) >> 1); return ((kk >> 3) * 4 + (c >> 5)) * 512 + ((kk & 7) * 32 + (c & 31)) * 2; }
__device__ __forceinline__ int v_rd_base(int lane) { return ((lane & 3) << 3) | (((lane >> 2) & 3) << 6) | (((lane >> 4) & 1) << 5) | (((lane >> 5) & 1) << 8); }
constexpr int v_rd_off(int d0, int ks, int half) { return d0 * 512 + ks * 4096 + half * 2048; }
template <int D0> __device__ __forceinline__ void pv_one(f32x16& od, int vb, bf16x8 pa0, bf16x8 pa1, bf16x8 pa2, bf16x8 pa3) {
    const s16x4 l0 = ds_tr_read<v_rd_off(D0, 0, 0)>(vb), h0 = ds_tr_read<v_rd_off(D0, 0, 1)>(vb), l1 = ds_tr_read<v_rd_off(D0, 1, 0)>(vb), h1 = ds_tr_read<v_rd_off(D0, 1, 1)>(vb);
    const s16x4 l2 = ds_tr_read<v_rd_off(D0, 2, 0)>(vb), h2 = ds_tr_read<v_rd_off(D0, 2, 1)>(vb), l3 = ds_tr_read<v_rd_off(D0, 3, 0)>(vb), h3 = ds_tr_read<v_rd_off(D0, 3, 1)>(vb);
    asm volatile("s_waitcnt lgkmcnt(0)" ::: "memory"); SBAR();
#define PK(L, H) (bf16x8){L[0], L[1], L[2], L[3], H[0], H[1], H[2], H[3]}
    od = __builtin_amdgcn_mfma_f32_32x32x16_bf16(pa0, PK(l0, h0), od, 0, 0, 0);
    od = __builtin_amdgcn_mfma_f32_32x32x16_bf16(pa1, PK(l1, h1), od, 0, 0, 0);
    od = __builtin_amdgcn_mfma_f32_32x32x16_bf16(pa2, PK(l2, h2), od, 0, 0, 0);
    od = __builtin_amdgcn_mfma_f32_32x32x16_bf16(pa3, PK(l3, h3), od, 0, 0, 0);
#undef PK
}
__device__ __forceinline__ void pv_d0(f32x16* o, int vb, bf16x8 pa0, bf16x8 pa1, bf16x8 pa2, bf16x8 pa3) {
    pv_one<0>(o[0], vb, pa0, pa1, pa2, pa3); pv_one<1>(o[1], vb, pa0, pa1, pa2, pa3); pv_one<2>(o[2], vb, pa0, pa1, pa2, pa3); pv_one<3>(o[3], vb, pa0, pa1, pa2, pa3);
}

struct AUnit { unsigned qoff; unsigned kv; int dst; bool causal; };
__device__ __forceinline__ bool attn_decode(int u, int total, const bf16_t* Q, const int* alist, const LAS int* pre, const LAS int* cntl, int wid, int r32, AUnit& D) {
    if (u >= total) return false;
    int bh, n;
    if (u < 512) {
        bh = u >> 5; n = u & 31; D.causal = true;
        const int b = bh >> 3, h = bh & 7, s = n * 256 + wid * 32 + r32; const size_t t = (size_t)b * SEQ + s;
        D.qoff = (unsigned)(t * DM + h * 128); D.dst = (int)((t * 8 + h) * 4 + 3);
    } else {
        const int ut = u - 512; int lo = 0, hi_ = 511;
        while (lo < hi_) { const int mid = (lo + hi_ + 1) >> 1; if (pre[mid] <= ut) lo = mid; else hi_ = mid - 1; }
        bh = lo >> 5; n = lo & 31; D.causal = false;
        const int tile = ut - pre[lo], cntv = cntl[lo], idx = tile * 256 + wid * 32 + r32;
        const int b = bh >> 3, h = bh & 7;
        const int en = alist[(size_t)bh * ALIST_PER_BH + alist_base(n) + (idx < cntv ? idx : cntv - 1)];
        const int s = en & 0xffff, k = en >> 16; const size_t t = (size_t)b * SEQ + s;
        D.qoff = (unsigned)(t * DM + h * 128); D.dst = idx < cntv ? (int)((t * 8 + h) * 4 + k) : -1;
    }
    D.kv = (unsigned)(((size_t)(bh >> 3) * SEQ + n * 256) * DM + (bh & 7) * 128);
    return true;
}

__device__ __forceinline__ void attn_stream(const bf16_t* __restrict__ Q, const bf16_t* __restrict__ K, const bf16_t* __restrict__ V, const int* __restrict__ alist,
                                            const LAS int* pre, const LAS int* cntl, int total, int c, int G,
                                            unsigned char* __restrict__ part, float* __restrict__ lse, char* lds) {
    const int tid = threadIdx.x, wid = tid >> 6, lane = tid & 63, r32 = lane & 31, hi = lane >> 5;
    char* V_lds = lds; char* K_lds = lds + 2 * SHM_V;
    float* wsl = (float*)(lds + SHM_WS) + wid * 96; float* li_l = wsl; float* al_l = wsl + 32; int* dst_l = (int*)(wsl + 64);
#define TZ() ({ int _t = threadIdx.x; asm volatile("" : "+v"(_t)); _t; })
#define qrow_i ((TZ() >> 6) * 32 + (TZ() & 31))
#define vb0 ((int)(uintptr_t)V_lds + v_rd_base(TZ() & 63))
    struct { bf16x8 vs0, vs1, ks0, ks1; } sr_[2];
#define SLOAD(i, KP, VP, k0) do { const int _tz = TZ(), sr = _tz >> 4, sc = (_tz & 15) * 8; sr_[i].vs0 = *(const bf16x8*)(&(VP)[(long)((k0) + sr) * LDK + sc]); sr_[i].vs1 = *(const bf16x8*)(&(VP)[(long)((k0) + 32 + sr) * LDK + sc]); \
    sr_[i].ks0 = *(const bf16x8*)(&(KP)[(long)((k0) + sr) * LDK + sc]); sr_[i].ks1 = *(const bf16x8*)(&(KP)[(long)((k0) + 32 + sr) * LDK + sc]); } while (0)
#define SWRITE(b, i) do { const int _tz = TZ(), sr = _tz >> 4, sc = (_tz & 15) * 8, vst0 = v_st(sr, sc), vst1 = v_st(32 + sr, sc); *(bf16x8*)(V_lds + (b) * SHM_V + vst0) = sr_[i].vs0;          \
    *(bf16x8*)(V_lds + (b) * SHM_V + vst1) = sr_[i].vs1; const int kc = sc * 2;          \
    *(bf16x8*)(K_lds + (b) * SHM_K + KSWZ(sr, kc)) = sr_[i].ks0;                          \
    *(bf16x8*)(K_lds + (b) * SHM_K + KSWZ(32 + sr, kc)) = sr_[i].ks1; } while (0)
#define SWAIT() asm volatile("s_waitcnt vmcnt(4)" ::: "memory")
#define RESC(a) do { if (__any((a) < 1.f)) { if (hi == 0) al_l[r32] = (a); asm volatile("s_waitcnt lgkmcnt(0)" ::: "memory"); \
    _Pragma("unroll") for (int d = 0; d < 4; ++d) _Pragma("unroll") for (int r = 0; r < 16; ++r) o[d][r] *= al_l[crow(r, hi)]; } } while (0)
    AUnit cur, nxt;
    int u = c;
    if (!attn_decode(u, total, Q, alist, pre, cntl, wid, r32, cur)) return;
#define stash ((int*)(lds + 81920) + TZ() * 2)
    stash[0] = (int)cur.qoff; stash[1] = cur.dst;
    unsigned ckv = __builtin_amdgcn_readfirstlane(cur.kv); bool ccausal = cur.causal;
    SLOAD(0, K + ckv, V + ckv, 0);
    for (;;) {
        bf16x8 qr[8];
        { const bf16_t* Qw = Q + (unsigned)stash[0] + hi * 8;
#pragma unroll
          for (int d0 = 0; d0 < 8; ++d0) qr[d0] = *reinterpret_cast<const bf16x8*>(Qw + d0 * 16); }
        u += G;
        const bool has_next = attn_decode(u, total, Q, alist, pre, cntl, wid, r32, nxt);
        const int dst0 = stash[1];
        if (hi == 0) dst_l[r32] = dst0;
        asm volatile("s_waitcnt lgkmcnt(0)" ::: "memory");
        if (has_next) { stash[0] = (int)nxt.qoff; stash[1] = nxt.dst; }
        const unsigned nkv = __builtin_amdgcn_readfirstlane(nxt.kv); const bool ncausal = nxt.causal;
        const bf16_t* Kh = K + ckv; const bf16_t* Vh = V + ckv; const bool causal = ccausal;
        float m_reg = -1e30f, l_reg = 0; f32x16 o[4] = {};
        f32x16 pA0, pA1, pB0, pB1; float mnA, mnB, alA, alB; bf16x8 pa0, pa1, pa2, pa3;
        asm volatile("s_waitcnt vmcnt(0)" ::: "memory"); SWRITE(0, 0); __syncthreads();
        qkt(pA0, pA1, K_lds, qr, r32, hi); if (causal) causal_mask(pA0, pA1, 0, qrow_i, hi); partialSM(pA0, pA1, m_reg, mnA, alA);
        SLOAD(1, Kh, Vh, KVBLK); SLOAD(0, Kh, Vh, 2 * KVBLK);
        SWAIT(); SWRITE(1, 1); __syncthreads();
        {
            SBAR(); qkt(pB0, pB1, K_lds + SHM_K, qr, r32, hi); if (causal) causal_mask(pB0, pB1, 1, qrow_i, hi);
            finishSM(pA0, pA1, alA, l_reg, pa0, pa1, pa2, pa3); SBAR();
            SLOAD(1, Kh, Vh, 3 * KVBLK); SBAR();
            pv_d0(o, vb0, pa0, pa1, pa2, pa3); partialSM(pB0, pB1, m_reg, mnB, alB);
            __syncthreads(); SWAIT(); SWRITE(0, 0);
            RESC(alB); __syncthreads();
            SBAR(); qkt(pA0, pA1, K_lds, qr, r32, hi); if (causal) causal_mask(pA0, pA1, 2, qrow_i, hi);
            finishSM(pB0, pB1, alB, l_reg, pa0, pa1, pa2, pa3); SBAR();
            pv_d0(o, vb0 + SHM_V, pa0, pa1, pa2, pa3); partialSM(pA0, pA1, m_reg, mnA, alA);
            __syncthreads(); asm volatile("s_waitcnt vmcnt(0)" ::: "memory"); SWRITE(1, 1);
            RESC(alA); __syncthreads();
        }
        SBAR(); qkt(pB0, pB1, K_lds + SHM_K, qr, r32, hi); if (causal) causal_mask(pB0, pB1, 3, qrow_i, hi);
        finishSM(pA0, pA1, alA, l_reg, pa0, pa1, pa2, pa3); SBAR();
        pv_d0(o, vb0, pa0, pa1, pa2, pa3); partialSM(pB0, pB1, m_reg, mnB, alB);
        __syncthreads(); RESC(alB);
        finishSM(pB0, pB1, alB, l_reg, pa0, pa1, pa2, pa3); SBAR();
        pv_d0(o, vb0 + SHM_V, pa0, pa1, pa2, pa3);
        SBAR();
        if (has_next) {
            SLOAD(0, K + nkv, V + nkv, 0);
        }
        SBAR();
        if (hi == 0) li_l[r32] = l_reg; asm volatile("s_waitcnt lgkmcnt(0)" ::: "memory");
        { const int dst = dst_l[r32]; if (hi == 0 && dst >= 0) lse[dst] = m_reg * CL2 + __builtin_amdgcn_logf(l_reg); }
        __syncthreads();
        char* ost = lds + wid * 8704;
#pragma unroll
        for (int r = 0; r < 16; ++r) { const int orow = crow(r, hi); const float rl = __builtin_amdgcn_rcpf(li_l[orow]);
#pragma unroll
            for (int d0 = 0; d0 < 4; ++d0) *(bf16_t*)(ost + orow * 272 + (d0 * 32 + r32) * 2) = f2bf(o[d0][r] * rl); }
#pragma unroll
        for (int j = 0; j < 8; ++j) { const int cidx = lane + 64 * j, row = cidx >> 4, ch = cidx & 15; const int dd = dst_l[row];
            const u32x4 w = *(const u32x4*)(ost + row * 272 + ch * 16);
            u32x2 f; f.x = pack_fp8x4(bf_lo(w.x) * FP8_OSCALE, bf_hi(w.x) * FP8_OSCALE, bf_lo(w.y) * FP8_OSCALE, bf_hi(w.y) * FP8_OSCALE);
            f.y = pack_fp8x4(bf_lo(w.z) * FP8_OSCALE, bf_hi(w.z) * FP8_OSCALE, bf_lo(w.w) * FP8_OSCALE, bf_hi(w.w) * FP8_OSCALE);
            if (dd >= 0) *(u32x2*)(part + (size_t)dd * 128 + ch * 8) = f; }
        __syncthreads();
        if (!has_next) break;
        ckv = nkv; ccausal = ncausal;
    }
#undef SLOAD
#undef stash
#undef TZ
#undef qrow_i
#undef vb0
#undef SWRITE
#undef SWAIT
#undef RESC
}
#undef KSWZ
#undef SBAR
}

__device__ __forceinline__ void phase_attn(const Frame& F, const bf16_t* Q, const bf16_t* K, const bf16_t* V, unsigned char* part, float* lse, int wi, int wn) {
    LAS int* pre = (LAS int*)(F.lds + at::LDS_PRE);
    LAS int* wtot = pre + 520; LAS int* cntl = pre + 536;
    const unsigned* gcnt = (const unsigned*)(F.ws + ZB_ATTCNT);
    const int* alist = (const int*)(F.ws + WS_ALIST);
    {
        const int cntv = (int)gcnt[F.tid]; const int v = (cntv + 255) >> 8;
        cntl[F.tid] = cntv;
        int incl = v;
#pragma unroll
        for (int o = 1; o < 64; o <<= 1) { const int y = __shfl_up(incl, o, 64); if (F.lane >= o) incl += y; }
        if (F.lane == 63) wtot[F.wave] = incl;
        __syncthreads();
        int off = 0;
        for (int w = 0; w < F.wave; ++w) off += wtot[w];
        pre[F.tid + 1] = off + incl; if (F.tid == 0) pre[0] = 0;
        __syncthreads();
    }
    const int total = 512 + pre[512];
    at::attn_stream(Q, K, V, alist, pre, cntl, total, wi, wn, part, lse, (char*)F.lds);
}

__device__ __forceinline__ void phase_attn_combine(const Frame& F, const unsigned char* part, const float* lse, unsigned char* O) {
    for (size_t idx = (size_t)F.c * NTHREADS + F.tid; idx < (size_t)T * 128; idx += (size_t)F.G * NTHREADS) {
        const int dc = (int)(idx & 15), h = (int)((idx >> 4) & 7); const size_t t = idx >> 7;
        const int s = (int)(t & (SEQ - 1)), j = s >> 8, nsel = j < 3 ? j : 3;
        const size_t base = (t * 8 + h) * 4;
        const f32x4 l4 = *(const f32x4*)(lse + base);
        float lk[4]; lk[0] = nsel > 0 ? l4[0] : -INFINITY; lk[1] = nsel > 1 ? l4[1] : -INFINITY; lk[2] = nsel > 2 ? l4[2] : -INFINITY; lk[3] = l4[3];
        const float mx = fmaxf(fmaxf(lk[0], lk[1]), fmaxf(lk[2], lk[3]));
        float acc[8] = {0.f, 0.f, 0.f, 0.f, 0.f, 0.f, 0.f, 0.f}; float wsum = 0.f;
#pragma unroll
        for (int k = 0; k < 4; ++k) if (k == 3 || k < nsel) {
            const float w = __builtin_amdgcn_exp2f(lk[k] - mx); wsum += w;
            const u32x2 p = *(const u32x2*)(part + (base + k) * 128 + dc * 8);
            const f32x2 p0 = __builtin_amdgcn_cvt_pk_f32_fp8((int)p.x, false), p1 = __builtin_amdgcn_cvt_pk_f32_fp8((int)p.x, true);
            const f32x2 p2 = __builtin_amdgcn_cvt_pk_f32_fp8((int)p.y, false), p3 = __builtin_amdgcn_cvt_pk_f32_fp8((int)p.y, true);
            acc[0] = fmaf(w, p0[0], acc[0]); acc[1] = fmaf(w, p0[1], acc[1]); acc[2] = fmaf(w, p1[0], acc[2]); acc[3] = fmaf(w, p1[1], acc[3]);
            acc[4] = fmaf(w, p2[0], acc[4]); acc[5] = fmaf(w, p2[1], acc[5]); acc[6] = fmaf(w, p3[0], acc[6]); acc[7] = fmaf(w, p3[1], acc[7]); }
        const float inv = 1.f / wsum;
        u32x2 w; w.x = pack_fp8x4(acc[0] * inv, acc[1] * inv, acc[2] * inv, acc[3] * inv); w.y = pack_fp8x4(acc[4] * inv, acc[5] * inv, acc[6] * inv, acc[7] * inv);
        *(u32x2*)(O + t * DM + h * 128 + dc * 8) = w;
    }
}

constexpr int N_PHASES = 22;
__global__ void __launch_bounds__(NTHREADS, 2) mk_fwd(Args a) {
    extern __shared__ __attribute__((aligned(16))) unsigned char lds_raw[];
    Frame F; F.lds = (LAS unsigned char*)lds_raw; F.tid = threadIdx.x; F.lane = F.tid & 63; F.wave = __builtin_amdgcn_readfirstlane(F.tid >> 6);
    F.G = gridDim.x; F.c = blockIdx.x; F.in = a.in; F.out = a.out; F.ws = a.ws;
    const int lo = a.ph_lo, hi = a.ph_hi;
    if (F.tid == 0) *(LAS u32x4*)(F.lds + LDS_BARW) = (u32x4){0u, 0u, 0u, 0u};
    __syncthreads();
    XcdBarrier bar; bar.bar = (unsigned*)(F.ws + ZB_BAR); bar.x = 0; bar.st = (volatile LAS unsigned*)(F.lds + LDS_BARW);
    if (hi - lo > 1) bar = xcd_barrier_post((unsigned*)(F.ws + ZB_BAR), (volatile LAS unsigned*)(F.lds + LDS_BARW));
#ifndef MK_ONLY
#define MK_ONLY -1
#endif
#define IN(k) ((MK_ONLY < 0 || MK_ONLY == (k)) && lo <= (k) && (k) < hi)
#define SEAM(k) do { if ((k) + 1 < hi) xcd_barrier(bar); { int _t = threadIdx.x; asm volatile("" : "+v"(_t)); F.tid = _t; F.lane = _t & 63; } } while (0)
#define PHASE_WS() unsigned char* ws; { unsigned long long w_ = (unsigned long long)a.ws; asm volatile("" : "+s"(w_)); ws = (unsigned char*)(__attribute__((address_space(1))) unsigned char*)w_; F.ws = ws; }     \
    bf16_t* actA = (bf16_t*)(ws + WS_ACTA); bf16_t* actB = (bf16_t*)(ws + WS_ACTB); bf16_t* actC = (bf16_t*)(ws + WS_ACTC); bf16_t* actD = (bf16_t*)(ws + WS_ACTD); \
    bf16_t* XB = (bf16_t*)(ws + WS_XB); bf16_t* actg = (bf16_t*)(ws + WS_ACTG); bf16_t* yk = (bf16_t*)(ws + WS_YK); \
    (void)actA; (void)actB; (void)actC; (void)actD; (void)XB; (void)actg; (void)yk;
    if (IN(0)) { PHASE_WS(); phase_prologue(F); SEAM(0); }
    if (IN(1)) { PHASE_WS(); phase_norm_mod(F, F.in[IN_X], F.in[L0_NORM1], 0, 0, actA); SEAM(1); }
    if (IN(2)) { PHASE_WS(); pg::Dense<pg::EpiBf16> S{actA, (const bf16_t*)(ws + WS_WIN), T / 256, 4, F.G, F.c, pg::EpiBf16{actB, 1.f}}; pg::gemm_phase(F.lds, S); SEAM(2); }
    if (IN(3)) { PHASE_WS(); phase_s5<false>(F, actB, actA, nullptr); SEAM(3); }
    if (IN(4)) { PHASE_WS(); phase_s5_carry(F); SEAM(4); }
    if (IN(5)) { PHASE_WS(); phase_s5<true>(F, actB, actA, (unsigned char*)actC); SEAM(5); }
    if (IN(6)) { PHASE_WS(); pg::Dense<pg::EpiGlu, true> S{actC, ws + WS_WGLU, T / 256, 4, F.G, F.c, pg::EpiGlu{actA, actB, 1.f / FP8_WSCALE}}; pg::gemm_phase(F.lds, S); SEAM(6); }
    if (IN(7)) { PHASE_WS(); pg::Dense<pg::EpiBf16> S{actB, (const bf16_t*)(ws + WS_WOUT), T / 256, 4, F.G, F.c, pg::EpiBf16{actC, 1.f}}; pg::gemm_phase(F.lds, S); SEAM(7); }
    if (IN(8)) { PHASE_WS(); phase_norm_router(F, F.in[IN_X], actC, F.in[L0_NORM2], 0, (unsigned char*)actA); SEAM(8); }
    const bool has_cv = (F.G == 256); const bool is_cv = has_cv && (F.c >> 3) >= 28; const int cvi = ((F.c >> 3) - 28) * 8 + (F.c & 7);
    const pg::MoeGeo geo0 = pg::moe_geo(F.G, F.c, has_cv ? 28 : 32), geo1 = pg::moe_geo(F.G, F.c, 32);
    if (IN(9)) { PHASE_WS(); if (is_cv) moe_conv_stream(F, CONV_L0DN_BEG, CONV_L1GU_BEG, cvi, 32);
        else { pg::MoeTabs M = pg::moe_setup<8>(F, 0, true, geo0);
            pg::MoeGateUp S{(const unsigned char*)actA, ws + WS_WGU0, F.in[L0_BGU], (unsigned char*)actg, M, geo0}; pg::gemm_phase(F.lds, S); }
        SEAM(9); }
    if (IN(10)) { PHASE_WS(); if (is_cv) moe_conv_stream(F, CONV_P10_BEG, CONV_P15_BEG, cvi, 32);
        else { pg::MoeTabs M = pg::moe_tabs_reuse(F, 0, geo0);
            pg::MoeDown S{(const unsigned char*)actg, ws + WS_WDN0, F.in[L0_BDN], (unsigned char*)yk, M, geo0}; pg::gemm_phase(F.lds, S); }
        SEAM(10); }
    if (IN(11)) { PHASE_WS(); phase_moe_combine<false, float>(F, 0, F.in[IN_X], actC, XB, F.in[L1_NORM1], (unsigned char*)actA, nullptr); SEAM(11); }
    if (IN(12)) { PHASE_WS(); pg::Dense<pg::EpiQkv, true> S{actA, ws + WS_WQKV, T / 256, 12, F.G, F.c,
                    pg::EpiQkv{actB, (const float*)(ws + WS_ROPE), (const float*)(ws + WS_ROPE) + (size_t)T * 64, 1.f / FP8_WSCALE, (float*)(ws + WS_KMEAN)}}; pg::gemm_phase(F.lds, S); SEAM(12); }
    if (IN(14)) { PHASE_WS(); phase_gating(F, actB); SEAM(14); }
    if (IN(15)) { PHASE_WS(); if (is_cv) moe_conv_stream(F, CONV_P15_BEG, CONV_L1DN_BEG, cvi, 32);
        else phase_attn(F, actB, actC, actD, (unsigned char*)actg, (float*)(ws + WS_LSE), has_cv ? (F.c >> 3) * 8 + (F.c & 7) : F.c, has_cv ? 224 : F.G);
        SEAM(15); }
    if (IN(16)) { PHASE_WS(); phase_attn_combine(F, (const unsigned char*)actg, (const float*)(ws + WS_LSE), (unsigned char*)actA); SEAM(16); }
    if (IN(17)) { PHASE_WS(); pg::Dense<pg::EpiBf16, true> S{actA, ws + WS_WO, T / 256, 4, F.G, F.c, pg::EpiBf16{actC, 1.f / (FP8_WSCALE * FP8_OSCALE)}}; pg::gemm_phase(F.lds, S); SEAM(17); }
    if (IN(18)) { PHASE_WS(); phase_norm_router(F, XB, actC, F.in[L1_NORM2], 1, (unsigned char*)actB); SEAM(18); }
    if (IN(19)) { PHASE_WS(); if (is_cv) moe_conv_stream(F, CONV_L1DN_BEG, CONV_END, cvi, 32);
        else { pg::MoeTabs M = pg::moe_setup<8>(F, 1, true, geo0);
            pg::MoeGateUp S{(const unsigned char*)actB, ws + WS_WGU1, F.in[L1_BGU], (unsigned char*)actg, M, geo0}; pg::gemm_phase(F.lds, S); }
        SEAM(19); }
    if (IN(20)) { PHASE_WS(); if (!is_cv) { pg::MoeTabs M = pg::moe_tabs_reuse(F, 1, geo0);
            pg::MoeDown S{(const unsigned char*)actg, ws + WS_WDN1, F.in[L1_BDN], (unsigned char*)yk, M, geo0}; pg::gemm_phase(F.lds, S); }
        SEAM(20); }
    if (IN(21)) { PHASE_WS(); phase_moe_combine<true, bf16_t>(F, 1, XB, actC, nullptr, F.in[IN_FNORM], nullptr, F.out); }
#undef IN
#undef SEAM
}

extern "C" void kernel_launch(void* const* d_in, const int* in_sizes, int n_in, void* d_out, int out_size, void* d_ws, size_t ws_size, hipStream_t stream) {
    static int grid = 0;
    if (grid == 0) {
        if (n_in != 37 || in_sizes[0] != T * DM || out_size != T * DM || ws_size < WS_END) {
            fprintf(stderr, "kernel_launch: built for 37 inputs, x/out of %d floats, >= %zu bytes of workspace; got n_in %d, in0 %d, out %d, ws %zu\n", T * DM, (size_t)WS_END, n_in, n_in > 0 ? in_sizes[0] : -1, out_size, ws_size);
            grid = -1; return; }
        int dev = 0, cus = 0, per_cu = 0;
        if (hipGetDevice(&dev) != hipSuccess || hipDeviceGetAttribute(&cus, hipDeviceAttributeMultiprocessorCount, dev) != hipSuccess) { grid = -1; return; }
        if (hipFuncSetAttribute((const void*)mk_fwd, hipFuncAttributeMaxDynamicSharedMemorySize, LDS_BYTES) != hipSuccess) { fprintf(stderr, "kernel_launch: hipFuncSetAttribute failed\n"); grid = -1; return; }
        if (hipOccupancyMaxActiveBlocksPerMultiprocessor(&per_cu, (const void*)mk_fwd, NTHREADS, LDS_BYTES) != hipSuccess || per_cu < 1)
            fprintf(stderr, "kernel_launch: occupancy query reports %d workgroups per CU\n", per_cu);
        (void)hipGetLastError();
        grid = cus;
    }
    if (grid < 0) return;
    if (hipMemsetAsync(d_ws, 0, ZERO_BYTES, stream) != hipSuccess) { fprintf(stderr, "kernel_launch: memset failed\n"); return; }
    Args a{};
    for (int i = 0; i < 37; ++i) a.in[i] = (const float*)d_in[i];
    a.out = (float*)d_out; a.ws = (unsigned char*)d_ws;
#if MK_MULTI
    for (int k = 0; k < MK_EMPTY; ++k) { a.ph_lo = N_PHASES; a.ph_hi = N_PHASES + 1; hipLaunchKernelGGL(mk_fwd, dim3(grid), dim3(NTHREADS), LDS_BYTES, stream, a); }
    for (int k = 0; k < N_PHASES; ++k) { a.ph_lo = k; a.ph_hi = k + 1;
        for (int rep = 0; rep < 1 + (int)((MK_DUP >> k) & 1u); ++rep) {
            if (rep && k == 8) hipMemsetAsync((char*)d_ws + ZB_MOECNT, 0, 256, stream);
            if (rep && k == 18) hipMemsetAsync((char*)d_ws + ZB_MOECNT + 256, 0, 256, stream);
            if (rep && k == 14) hipMemsetAsync((char*)d_ws + ZB_ATTCNT, 0, 2048, stream);
            hipLaunchKernelGGL(mk_fwd, dim3(grid), dim3(NTHREADS), LDS_BYTES, stream, a); } }
#else
    a.ph_lo = 0; a.ph_hi = N_PHASES;
    hipLaunchKernelGGL(mk_fwd, dim3(grid), dim3(NTHREADS), LDS_BYTES, stream, a);
#endif
    const hipError_t le = hipPeekAtLastError();
    if (le != hipSuccess) fprintf(stderr, "kernel_launch: launch failed: %s\n", hipGetErrorName(le));
}
```

```cpp
#include <hip/hip_runtime.h>
#include <cstdio>
#include <cstdint>

#ifndef MK_DUP
#define MK_DUP 0u
#endif
#ifndef MK_EMPTY
#define MK_EMPTY 0
#endif
#ifndef MK_KREP
#define MK_KREP 1
#endif
#ifndef MK_PREFETCH
#define MK_PREFETCH 0
#endif
#ifndef MK_EREP_GU
#define MK_EREP_GU 1
#endif
#ifndef MK_EREP_DN
#define MK_EREP_DN 1
#endif
#ifndef MK_CONVPROBE
#define MK_CONVPROBE 0
#endif
#ifndef MK_CV0
#define MK_CV0 1536
#endif
#ifndef MK_CV9
#define MK_CV9 2048
#endif
#ifndef MK_CVD0
#define MK_CVD0 0
#endif
#ifndef MK_CVD1
#define MK_CVD1 0
#endif
#ifndef MK_CVS3
#define MK_CVS3 2048
#endif
#ifndef MK_CVS5
#define MK_CVS5 2048
#endif
#ifndef MK_CV10
#define MK_CV10 1024
#endif
#ifndef MK_MULTI
#define MK_MULTI 0
#endif

typedef unsigned short bf16_t;
typedef short bf16x8 __attribute__((ext_vector_type(8)));
typedef short s16x4 __attribute__((ext_vector_type(4)));
typedef float f32x2 __attribute__((ext_vector_type(2)));
typedef float f32x4 __attribute__((ext_vector_type(4)));
typedef float f32x16 __attribute__((ext_vector_type(16)));
typedef unsigned u32x2 __attribute__((ext_vector_type(2)));
typedef unsigned u32x4 __attribute__((ext_vector_type(4)));
typedef int v4i __attribute__((ext_vector_type(4)));
typedef int v8i __attribute__((ext_vector_type(8)));
#define LAS __attribute__((address_space(3)))

constexpr int DM = 1024, NB = 2, SEQ = 8192, T = NB * SEQ;
constexpr int NH = 8, HD = 128, MBLK = 256, NBLK = SEQ / MBLK;
constexpr int NE = 32, TOPK = 4, DFF = 1024;
constexpr int S5G = 64, S5P = 64, S5C = 16;
constexpr int NTHREADS = 512;
constexpr int LDS_BYTES = 163840;
constexpr int PF_LDS = 145152;
constexpr int LDS_BARW = LDS_BYTES - 16;
constexpr int MOE_CAP = T;
constexpr int MOE_MAXROWS = T * TOPK + NE * 256;
constexpr int MOE_MAXTILES = MOE_MAXROWS / 256;

constexpr size_t al256(size_t x) { return (x + 255) / 256 * 256; }
constexpr size_t WS_ZERO = 0;
constexpr size_t   ZB_BAR = 0;
constexpr size_t   ZB_MOECNT = 16384;
constexpr size_t   ZB_ATTCNT = 20480;
constexpr size_t   ZB_ADAFLAG = 24576;
constexpr size_t ZERO_BYTES = 32768;
constexpr size_t WS_ADA = ZERO_BYTES;
constexpr size_t WS_S5A = WS_ADA + al256(2 * 2 * 6 * 1024 * 4);
constexpr size_t WS_BOP = WS_S5A + 4 * 64 * 64 * 4;
constexpr size_t WS_COP = WS_BOP + 64 * 128 * 16 * 2;
constexpr size_t WS_ROPE = WS_COP + 64 * 16 * 128 * 2;
constexpr size_t WS_WRB = WS_ROPE + 2 * (size_t)T * 64 * 4;
constexpr size_t WS_KMEAN = WS_WRB + 2 * 32 * 1024 * 2;
constexpr size_t WS_TOPK = WS_KMEAN + 2 * 8 * 32 * 128 * 4;
constexpr size_t WS_VTOK = WS_TOPK + 2 * (size_t)T * 4 * 4;
constexpr size_t ALIST_PER_BH = 256 * 496;
constexpr size_t WS_ALIST = WS_VTOK + (size_t)NE * MOE_CAP * 4;
constexpr size_t WS_LSE = WS_ALIST + 16 * ALIST_PER_BH * 4;
constexpr size_t WS_CARRY = WS_LSE + (size_t)T * 8 * 4 * 4;
constexpr size_t WS_WIN = WS_CARRY + (size_t)2 * 256 * 64 * 128 * 4;
constexpr size_t WS_WGLU = WS_WIN + 2097152, WS_WOUT = WS_WGLU + 2097152, WS_WQKV = WS_WOUT + 2097152, WS_WO = WS_WQKV + 3 * 2097152;
constexpr size_t WS_WGU0 = WS_WO + 2097152;
constexpr size_t WS_WGU1 = WS_WGU0 + (size_t)NE * 2048 * 1024 * 2;
constexpr size_t WS_WDN0 = WS_WGU1 + (size_t)NE * 2048 * 1024 * 2;
constexpr size_t WS_WDN1 = WS_WDN0 + (size_t)NE * 1024 * 1024 * 2;
constexpr size_t WS_ACTA = WS_WDN1 + (size_t)NE * 1024 * 1024 * 2;
constexpr size_t ACT_BYTES = (size_t)T * DM * 2;
constexpr size_t WS_ACTB = WS_ACTA + ACT_BYTES, WS_ACTC = WS_ACTB + ACT_BYTES, WS_ACTD = WS_ACTC + ACT_BYTES;
constexpr size_t WS_XA = WS_ACTD + ACT_BYTES;
constexpr size_t WS_XB = WS_XA + (size_t)T * DM * 4;
constexpr size_t WS_ACTG = WS_XB + (size_t)T * DM * 4;
constexpr size_t WS_YK = WS_ACTG + (size_t)MOE_MAXROWS * 1024 * 2;
constexpr size_t WS_END = WS_YK + (size_t)MOE_MAXROWS * 1024 * 2;

__device__ __forceinline__ unsigned cvt_pk_bf16(float lo, float hi) { unsigned r; asm volatile("v_cvt_pk_bf16_f32 %0, %1, %2" : "=v"(r) : "v"(lo), "v"(hi)); return r; }
__device__ __forceinline__ float bf_lo(unsigned w) { return __uint_as_float(w << 16); }
__device__ __forceinline__ float bf_hi(unsigned w) { return __uint_as_float(w & 0xffff0000u); }
__device__ __forceinline__ bf16_t f2bf(float f) { return (bf16_t)(cvt_pk_bf16(f, 0.f) & 0xffffu); }
__device__ __forceinline__ unsigned pack_fp8x4(float a, float b, float c, float d) {
    a = fminf(fmaxf(a, -448.f), 448.f); b = fminf(fmaxf(b, -448.f), 448.f); c = fminf(fmaxf(c, -448.f), 448.f); d = fminf(fmaxf(d, -448.f), 448.f);
    int w = 0; w = __builtin_amdgcn_cvt_pk_fp8_f32(a, b, w, false); w = __builtin_amdgcn_cvt_pk_fp8_f32(c, d, w, true); return (unsigned)w;
}
__device__ __forceinline__ unsigned pack_fp8x4_nc(float a, float b, float c, float d) {
    int w = 0; w = __builtin_amdgcn_cvt_pk_fp8_f32(a, b, w, false); w = __builtin_amdgcn_cvt_pk_fp8_f32(c, d, w, true); return (unsigned)w;
}
constexpr float FP8_WSCALE = 64.f, FP8_ASCALE = 4.f, FP8_OSCALE = 64.f, FP8_YSCALE = 8.f, FP8_ZSCALE = 4.f, FP8_MSCALE = 8.f;
__device__ __forceinline__ f32x4 load_x4(const float* p) { return *(const f32x4*)p; }
__device__ __forceinline__ f32x4 load_x4(const bf16_t* p) { const u32x2 w = *(const u32x2*)p; return (f32x4){bf_lo(w.x), bf_hi(w.x), bf_lo(w.y), bf_hi(w.y)}; }
template <int CTRL> __device__ __forceinline__ float dpp_f(float v) { return __builtin_bit_cast(float, __builtin_amdgcn_update_dpp(0, __builtin_bit_cast(int, v), CTRL, 0xF, 0xF, false)); }
template <int CTRL> __device__ __forceinline__ int dpp_i(int v) { return __builtin_amdgcn_update_dpp(0, v, CTRL, 0xF, 0xF, false); }
__device__ __forceinline__ float row16_sum(float v) { v += dpp_f<0xB1>(v); v += dpp_f<0x4E>(v); v += dpp_f<0x124>(v); v += dpp_f<0x128>(v); return v; }
__device__ __forceinline__ float row16_max(float v) { v = fmaxf(v, dpp_f<0xB1>(v)); v = fmaxf(v, dpp_f<0x4E>(v)); v = fmaxf(v, dpp_f<0x124>(v)); v = fmaxf(v, dpp_f<0x128>(v)); return v; }
__device__ __forceinline__ int row16_min(int v) { v = min(v, dpp_i<0xB1>(v)); v = min(v, dpp_i<0x4E>(v)); v = min(v, dpp_i<0x124>(v)); v = min(v, dpp_i<0x128>(v)); return v; }
__device__ __forceinline__ float wave_sum(float v) {
    const int r = __builtin_bit_cast(int, row16_sum(v));
    return (__builtin_bit_cast(float, __builtin_amdgcn_readlane(r, 0)) + __builtin_bit_cast(float, __builtin_amdgcn_readlane(r, 16)))
         + (__builtin_bit_cast(float, __builtin_amdgcn_readlane(r, 32)) + __builtin_bit_cast(float, __builtin_amdgcn_readlane(r, 48)));
}
__device__ __forceinline__ float wave_max(float v) {
    const int r = __builtin_bit_cast(int, row16_max(v));
    return fmaxf(fmaxf(__builtin_bit_cast(float, __builtin_amdgcn_readlane(r, 0)), __builtin_bit_cast(float, __builtin_amdgcn_readlane(r, 16))),
                 fmaxf(__builtin_bit_cast(float, __builtin_amdgcn_readlane(r, 32)), __builtin_bit_cast(float, __builtin_amdgcn_readlane(r, 48))));
}
__device__ __forceinline__ float sigmoidf_fast(float x) { return __builtin_amdgcn_rcpf(1.f + __builtin_amdgcn_exp2f(-1.4426950408889634f * x)); }
__device__ __forceinline__ float gelu_tanh(float y) {
    const float u = 1.5957691216057308f * (y + 0.044715f * y * y * y);
    return y * sigmoidf_fast(u);
}

#define XB_TMO      128
#define XB_XCNT(j)  (256  + 64 * (j))
#define XB_XSUB(j)  (1280 + 64 * (j))
#define XB_XGEN(j)  (2304 + 64 * (j))
#define XB_TOP      3328
#define XB_TOPGEN   3392
#define XCD_BAR_WORDS 3456
#define XB_SPIN_CAP (1u << 18)

__device__ __forceinline__ unsigned xb_ld(unsigned* p)              { return __hip_atomic_load(p, __ATOMIC_RELAXED, __HIP_MEMORY_SCOPE_AGENT); }
__device__ __forceinline__ unsigned xb_add(unsigned* p, unsigned v) { return __hip_atomic_fetch_add(p, v, __ATOMIC_RELAXED, __HIP_MEMORY_SCOPE_AGENT); }
__device__ __forceinline__ unsigned xb_xcc_id() { return (unsigned)__builtin_amdgcn_s_getreg((3 << 11) | 20) & 0xFu; }
#define XB_SPIN(cond, bar) do { unsigned _sp = 0; while (cond) { __builtin_amdgcn_s_sleep(1); \
    if ((++_sp & 255u) == 0u) { if (xb_ld(&(bar)[XB_TMO])) break; if (_sp > XB_SPIN_CAP) { atomicAdd(&(bar)[XB_TMO], 1u); break; } } } } while (0)

struct XcdBarrier { unsigned* bar; unsigned x; volatile LAS unsigned* st; };

__device__ __forceinline__ XcdBarrier xcd_barrier_post(unsigned* bar, volatile LAS unsigned* st) {
    XcdBarrier b; b.bar = bar; b.x = xb_xcc_id(); b.st = st;
    if (threadIdx.x == 0) (void)xb_add(&bar[XB_XCNT(b.x)], 1u);
    return b;
}
__device__ __forceinline__ void xcd_barrier_complete(unsigned* bar, unsigned x, unsigned& nloc, unsigned& nx) {
    const unsigned G = gridDim.x * gridDim.y * gridDim.z;
    unsigned sum, cnt, mine, sp = 0u;
    for (;;) {
        sum = 0u; cnt = 0u; mine = 0u;
#pragma unroll
        for (unsigned j = 0; j < 16; ++j) { const unsigned c = xb_ld(&bar[XB_XCNT(j)]); sum += c; cnt += (c > 0u) ? 1u : 0u; mine = (j == x) ? c : mine; }
        if (sum == G) break;
        __builtin_amdgcn_s_sleep(1);
        if ((++sp & 255u) == 0u) { if (xb_ld(&bar[XB_TMO])) break; if (sp > XB_SPIN_CAP) { atomicAdd(&bar[XB_TMO], 1u); break; } }
    }
    nloc = mine > 0u ? mine : 1u; nx = cnt > 0u ? cnt : 1u;
}
__device__ __forceinline__ void xcd_barrier(const XcdBarrier& b) {
    asm volatile("s_waitcnt vmcnt(0)" ::: "memory");
    __syncthreads();
    if (threadIdx.x == 0) {
        unsigned* bar = b.bar;
        __builtin_amdgcn_s_waitcnt(0);
        unsigned nloc = b.st[0], nx = b.st[1];
        if (nloc == 0u) { xcd_barrier_complete(bar, b.x, nloc, nx); b.st[0] = nloc; b.st[1] = nx; }
        const unsigned old = xb_add(&bar[XB_XSUB(b.x)], 1u);
        const unsigned gen = old / nloc;
        if (old + 1u == (gen + 1u) * nloc) {
            __builtin_amdgcn_fence(__ATOMIC_RELEASE, "agent");
            asm volatile("s_waitcnt vmcnt(0)" ::: "memory");
            const unsigned og = xb_add(&bar[XB_TOP], 1u);
            const unsigned tg = og / nx;
            if (og + 1u == (tg + 1u) * nx) xb_add(&bar[XB_TOPGEN], 1u);
            else XB_SPIN(xb_ld(&bar[XB_TOPGEN]) == tg, bar);
            __builtin_amdgcn_fence(__ATOMIC_ACQUIRE, "agent");
            xb_add(&bar[XB_XGEN(b.x)], 1u);
            asm volatile("s_waitcnt vmcnt(0)" ::: "memory");
        } else {
            XB_SPIN(xb_ld(&bar[XB_XGEN(b.x)]) == gen, bar);
            __builtin_amdgcn_fence(__ATOMIC_ACQUIRE, "agent");
            asm volatile("s_waitcnt vmcnt(0)" ::: "memory");
        }
    }
    __syncthreads();
}

struct Args { const float* in[37]; float* out; unsigned char* ws; int ph_lo, ph_hi; };

struct Frame {
    LAS unsigned char* lds;
    int tid, lane, wave, G, c;
    const float* const* in; float* out; unsigned char* ws;
};

enum { IN_X = 0, IN_C = 1, IN_POS = 2,
       L0_NORM1 = 3, L0_ADAW = 4, L0_ADAB = 5, L0_WIN = 6, L0_BRE = 7, L0_BIM = 8, L0_CRE = 9, L0_CIM = 10, L0_LRE = 11, L0_LIM = 12, L0_LOGDT = 13, L0_D = 14, L0_WGLU = 15, L0_WOUT = 16,
       L0_NORM2 = 17, L0_WR = 18, L0_BR = 19, L0_WGU = 20, L0_BGU = 21, L0_WDN = 22, L0_BDN = 23,
       L1_NORM1 = 24, L1_ADAW = 25, L1_ADAB = 26, L1_WQKV = 27, L1_WO = 28, L1_NORM2 = 29, L1_WR = 30, L1_BR = 31, L1_WGU = 32, L1_BGU = 33, L1_WDN = 34, L1_BDN = 35, IN_FNORM = 36 };

__device__ __forceinline__ const float* ada_vec(const Frame& F, int layer, int b, int which) { return (const float*)(F.ws + WS_ADA) + ((layer * 2 + b) * 6 + which) * 1024; }

__device__ __forceinline__ void conv_unit(const Frame& F, const float* __restrict__ src, bf16_t* __restrict__ dst, int N, int kt, int ntile, bool qkperm) {
    LAS unsigned* L = (LAS unsigned*)F.lds;
    const int k0 = kt * 64, n0 = ntile * 256, lane = F.lane, w = F.wave;
#pragma unroll
    for (int j = 0; j < 4; ++j) {
        const float* sp = src + (size_t)(k0 + 2 * w) * N + n0 + lane + 64 * j;
        float a[4], b[4];
#pragma unroll
        for (int i = 0; i < 4; ++i) { a[i] = sp[(size_t)(16 * i) * N]; b[i] = sp[(size_t)(16 * i + 1) * N]; }
#pragma unroll
        for (int i = 0; i < 4; ++i) L[(lane + 64 * j) * 33 + 8 * i + w] = cvt_pk_bf16(a[i], b[i]);
    }
    __syncthreads();
    const int row = F.tid >> 1, half = F.tid & 1;
    int n = n0 + row;
    if (qkperm && n < 2048) { const int d = n & 127; n = (n & ~127) | (d < 64 ? 2 * d : 2 * (d - 64) + 1); }
    bf16_t* dp = dst + (size_t)n * 1024 + k0 + half * 32;
#pragma unroll
    for (int q = 0; q < 4; ++q) {
        u32x4 v; v.x = L[row * 33 + half * 16 + 4 * q + 0]; v.y = L[row * 33 + half * 16 + 4 * q + 1]; v.z = L[row * 33 + half * 16 + 4 * q + 2]; v.w = L[row * 33 + half * 16 + 4 * q + 3];
        *(u32x4*)(dp + 8 * q) = v;
    }
    __syncthreads();
}

__device__ __forceinline__ void conv_unit8(const Frame& F, const float* __restrict__ src, unsigned char* __restrict__ dst, int N, int kt, int ntile, bool qkperm = false) {
    LAS unsigned* L = (LAS unsigned*)F.lds;
    const int k0 = kt * 128, n0 = ntile * 128, lane = F.lane, w = F.wave;
#pragma unroll
    for (int j = 0; j < 2; ++j) {
        const float* sp = src + (size_t)(k0 + 4 * w) * N + n0 + lane + 64 * j;
        float f[4][4];
#pragma unroll
        for (int i = 0; i < 4; ++i)
#pragma unroll
            for (int q = 0; q < 4; ++q) f[i][q] = sp[(size_t)(32 * i + q) * N];
#pragma unroll
        for (int i = 0; i < 4; ++i) L[(lane + 64 * j) * 33 + w + 8 * i] = pack_fp8x4(f[i][0] * FP8_WSCALE, f[i][1] * FP8_WSCALE, f[i][2] * FP8_WSCALE, f[i][3] * FP8_WSCALE);
    }
    __syncthreads();
    const int row = F.tid >> 2, qtr = F.tid & 3;
    int n = n0 + row;
    if (qkperm && n < 2048) { const int d = n & 127; n = (n & ~127) | (d < 64 ? 2 * d : 2 * (d - 64) + 1); }
    unsigned char* dp = dst + (size_t)n * 1024 + k0 + qtr * 32;
#pragma unroll
    for (int q = 0; q < 2; ++q) {
        u32x4 v; v.x = L[row * 33 + qtr * 8 + 4 * q + 0]; v.y = L[row * 33 + qtr * 8 + 4 * q + 1]; v.z = L[row * 33 + qtr * 8 + 4 * q + 2]; v.w = L[row * 33 + qtr * 8 + 4 * q + 3];
        *(u32x4*)(dp + 16 * q) = v;
    }
    __syncthreads();
}

__device__ __forceinline__ void ada_unit(const Frame& F, int layer, int cg) {
    LAS float* ca = (LAS float*)F.lds;
    const float* cin = F.in[IN_C];
    for (int i = F.tid; i < 2048; i += NTHREADS) { const float c = cin[i]; ca[i] = c * sigmoidf_fast(c); }
    __syncthreads();
    const float* w = F.in[layer ? L1_ADAW : L0_ADAW]; const float* bias = F.in[layer ? L1_ADAB : L0_ADAB];
    const int kq = F.wave, col = cg * 64 + F.lane;
    float a0 = 0.f, a1 = 0.f;
#pragma unroll 8
    for (int k = kq * 128; k < kq * 128 + 128; ++k) { const float wv = w[(size_t)k * 6144 + col]; a0 = fmaf(ca[k], wv, a0); a1 = fmaf(ca[1024 + k], wv, a1); }
    LAS float* red = ca + 2048;
    red[(kq * 2 + 0) * 64 + F.lane] = a0; red[(kq * 2 + 1) * 64 + F.lane] = a1;
    __syncthreads();
    if (F.tid < 128) { const int b = F.tid >> 6, l = F.tid & 63; float s = bias[cg * 64 + l];
#pragma unroll
        for (int q = 0; q < 8; ++q) s += red[(q * 2 + b) * 64 + l];
        float* dp = (float*)(F.ws + WS_ADA) + (layer * 2 + b) * 6144 + cg * 64 + l;
        if (layer == 0 && cg < 32) { __hip_atomic_store(dp, s, __ATOMIC_RELAXED, __HIP_MEMORY_SCOPE_AGENT); asm volatile("s_waitcnt vmcnt(0)" ::: "memory"); }
        else *dp = s; }
    __syncthreads();
    if (layer == 0 && cg < 32 && F.tid == 0) (void)__hip_atomic_fetch_add((unsigned*)(F.ws + ZB_ADAFLAG), 1u, __ATOMIC_RELAXED, __HIP_MEMORY_SCOPE_AGENT);
}
__device__ __forceinline__ void ada_flag_wait(const Frame& F) {
    if (F.tid == 0) { unsigned* fl = (unsigned*)(F.ws + ZB_ADAFLAG); unsigned sp = 0u;
        while (__hip_atomic_load(fl, __ATOMIC_RELAXED, __HIP_MEMORY_SCOPE_AGENT) < 32u) { __builtin_amdgcn_s_sleep(1); if (++sp > (1u << 24)) break; }
        __builtin_amdgcn_fence(__ATOMIC_ACQUIRE, "agent"); }
    __syncthreads();
}

__device__ __forceinline__ void s5tab_unit(const Frame& F, int unit) {
    const int idx = unit * NTHREADS + F.tid, g = idx >> 6, p = idx & 63;
    const double dt = exp((double)F.in[L0_LOGDT][g]);
    const double lr = (double)F.in[L0_LRE][idx], li = (double)F.in[L0_LIM][idx];
    const double mag = exp(lr * dt), ar = mag * cos(li * dt), ai = mag * sin(li * dt);
    const double den = lr * lr + li * li;
    const double fr = ((ar - 1.0) * lr + ai * li) / den, fi = (ai * lr - (ar - 1.0) * li) / den;
    const double mag32 = exp(32.0 * lr * dt), a32r = mag32 * cos(32.0 * li * dt), a32i = mag32 * sin(32.0 * li * dt);
    float* tab = (float*)(F.ws + WS_S5A);
    tab[idx] = (float)ar; tab[4096 + idx] = (float)ai; tab[8192 + idx] = (float)a32r; tab[12288 + idx] = (float)a32i;
    bf16_t* bop = (bf16_t*)(F.ws + WS_BOP); bf16_t* cop = (bf16_t*)(F.ws + WS_COP);
    const float* bre = F.in[L0_BRE] + (size_t)idx * 16; const float* bim = F.in[L0_BIM] + (size_t)idx * 16;
#pragma unroll
    for (int ch = 0; ch < 16; ++ch) {
        const double br = bre[ch], bi = bim[ch];
        bop[(g * 128 + p) * 16 + ch] = f2bf((float)(fr * br - fi * bi));
        bop[(g * 128 + 64 + p) * 16 + ch] = f2bf((float)(fr * bi + fi * br));
        cop[(g * 16 + ch) * 128 + p] = f2bf(F.in[L0_CRE][(g * 16 + ch) * 64 + p]);
        cop[(g * 16 + ch) * 128 + 64 + p] = f2bf(-F.in[L0_CIM][(g * 16 + ch) * 64 + p]);
    }
}

__device__ __forceinline__ void rope_unit(const Frame& F, int unit) {
    LAS float* invl = (LAS float*)F.lds;
    if (F.tid < 64) invl[F.tid] = (float)exp2(-(double)F.tid * (13.287712379549449 / 64.0));
    __syncthreads();
    const int idx = (unit * NTHREADS + F.tid) * 4, t = idx >> 6, i0 = idx & 63;
    const float pos = (float)((const int*)F.in[IN_POS])[t];
    f32x4 c, s;
#pragma unroll
    for (int e = 0; e < 4; ++e) {
        const float ang = pos * invl[i0 + e];
        const float k = rintf(ang * 0.15915494309189535f);
        float r = fmaf(-k, 6.28125f, ang); r = fmaf(-k, 1.9353071693331003e-3f, r); r = fmaf(-k, 1.0253131677018246e-11f, r);
        c[e] = __cosf(r); s[e] = __sinf(r);
    }
    *(f32x4*)((float*)(F.ws + WS_ROPE) + idx) = c;
    *(f32x4*)((float*)(F.ws + WS_ROPE) + (size_t)T * 64 + idx) = s;
    __syncthreads();
}

constexpr int CONV_L0DN_BEG = 4096, CONV_L1GU_BEG = 6144, CONV_L1DN_BEG = 10240, CONV_END = 12288;
constexpr int CONV_P10_BEG = CONV_L1GU_BEG + MK_CV0, CONV_P15_BEG = CONV_P10_BEG + MK_CV10;
constexpr int P0_CONV0 = 64, P0_CONV1 = 128, P0_CONV2 = 192, P0_CONV3 = 384, P0_CONV4 = 448, P0_CONV5 = 4544, P0_CONV6 = 6592, P0_CONV7 = 10688, P0_CONV8 = 12736;
constexpr int P0_ADA = P0_CONV8 + 192, P0_S5 = P0_ADA + 8, P0_ROPE = P0_S5 + 512, P0_WRB = P0_ROPE + 128, P0_END = P0_WRB + 32;

__device__ __forceinline__ void conv_batched(const Frame& F, int u, const float* src, size_t dst_off, int N) {
    const int per = 16 * (N / 256), e = u / per, r = u % per, kt = r / (N / 256), nt = r % (N / 256);
    conv_unit(F, src + (size_t)e * 1024 * N, (bf16_t*)(F.ws + dst_off) + (size_t)e * N * 1024, N, kt, nt, false);
}

__device__ __forceinline__ void conv_batched8(const Frame& F, int u, const float* src, size_t dst_off, int N) {
    const int per = 8 * (N / 128), e = u / per, r = u % per, kt = r / (N / 128), nt = r % (N / 128);
    conv_unit8(F, src + (size_t)e * 1024 * N, F.ws + dst_off + (size_t)e * N * 1024, N, kt, nt);
}

__device__ __forceinline__ bool moe_conv_decode(const Frame& F, int u, const float*& src, unsigned char*& dst, int& N) {
    if (u >= 12288) return false;
    const int fam = u < 4096 ? 0 : (u < 6144 ? 1 : (u < 10240 ? 2 : 3));
    const int base = fam == 0 ? 0 : (fam == 1 ? 4096 : (fam == 2 ? 6144 : 10240));
    N = (fam & 1) ? 1024 : 2048;
    const float* sp = fam == 0 ? F.in[L0_WGU] : (fam == 1 ? F.in[L0_WDN] : (fam == 2 ? F.in[L1_WGU] : F.in[L1_WDN]));
    const size_t doff = fam == 0 ? WS_WGU0 : (fam == 1 ? WS_WDN0 : (fam == 2 ? WS_WGU1 : WS_WDN1));
    const int r0 = u - base, per = 8 * (N / 128), e = r0 / per, r = r0 % per, kt = r / (N / 128), nt = r % (N / 128);
    src = sp + (size_t)e * 1024 * N + (size_t)(kt * 128 + 16 * F.wave + 8 * (F.lane >> 5)) * N + nt * 128 + 4 * (F.lane & 31);
    dst = F.ws + doff + (size_t)e * N * 1024 + (size_t)(nt * 128 + (F.tid >> 2)) * 1024 + kt * 128 + (F.tid & 3) * 32;
    return true;
}
__device__ __forceinline__ void moe_conv_stream(const Frame& F, int ubeg, int uend, int ci, int cn) {
    LAS unsigned* L = (LAS unsigned*)F.lds;
    const int nq = F.lane & 31, kd0 = 4 * F.wave + 2 * (F.lane >> 5), row = F.tid >> 2, qtr = F.tid & 3;
    const float* src; unsigned char* dst; int N;
    int u = ubeg + ci;
    if (u >= uend || !moe_conv_decode(F, u, src, dst, N)) return;
    f32x4 fa[8], fb[8]; unsigned char* da = dst; unsigned char* db = nullptr;
#define CV_LOAD(f) do { _Pragma("unroll") for (int i = 0; i < 8; ++i) f[i] = __builtin_nontemporal_load((const f32x4*)(src + (size_t)i * N)); } while (0)
#define CV_EMIT(f, d) do { unsigned pk[4][2]; \
        _Pragma("unroll") for (int c = 0; c < 4; ++c) { pk[c][0] = pack_fp8x4(f[0][c] * FP8_WSCALE, f[1][c] * FP8_WSCALE, f[2][c] * FP8_WSCALE, f[3][c] * FP8_WSCALE); \
                                                         pk[c][1] = pack_fp8x4(f[4][c] * FP8_WSCALE, f[5][c] * FP8_WSCALE, f[6][c] * FP8_WSCALE, f[7][c] * FP8_WSCALE); } \
        u += cn; more = u < uend && moe_conv_decode(F, u, src, dst, N); if (more) CV_LOAD(f); \
        _Pragma("unroll") for (int c = 0; c < 4; ++c) { L[(4 * nq + c) * 33 + kd0] = pk[c][0]; L[(4 * nq + c) * 33 + kd0 + 1] = pk[c][1]; } \
        asm volatile("s_waitcnt lgkmcnt(0)" ::: "memory"); __builtin_amdgcn_s_barrier(); asm volatile("" ::: "memory");     \
        _Pragma("unroll") for (int q = 0; q < 2; ++q) { u32x4 v; v.x = L[row * 33 + qtr * 8 + 4 * q + 0]; v.y = L[row * 33 + qtr * 8 + 4 * q + 1]; v.z = L[row * 33 + qtr * 8 + 4 * q + 2]; v.w = L[row * 33 + qtr * 8 + 4 * q + 3]; \
            *(u32x4*)((d) + 16 * q) = v; } \
        asm volatile("s_waitcnt lgkmcnt(0)" ::: "memory"); __builtin_amdgcn_s_barrier(); asm volatile("" ::: "memory"); } while (0)
    bool more;
    CV_LOAD(fa);
    u += cn; bool have_b = u < uend && moe_conv_decode(F, u, src, dst, N);
    if (have_b) { db = dst; CV_LOAD(fb); }
    for (;;) {
        unsigned char* d0 = da;
        CV_EMIT(fa, d0);
        const bool have_a = more; if (have_a) da = dst;
        if (!have_b) break;
        unsigned char* d1 = db;
        CV_EMIT(fb, d1);
        have_b = more; if (have_b) db = dst;
        if (!have_a) break;
    }
#undef CV_LOAD
#undef CV_EMIT
}

struct ConvTicket { f32x4 f[8]; unsigned char* dst; bool have; };
__device__ __forceinline__ void conv_issue(const Frame& F, int u, int uend, ConvTicket& t) {
    (void)uend; const float* src = nullptr; int N = 0; t.dst = nullptr; moe_conv_decode(F, u, src, t.dst, N); t.have = true;
#pragma unroll
    for (int i = 0; i < 8; ++i) t.f[i] = __builtin_nontemporal_load((const f32x4*)(src + (size_t)i * N));
}
__device__ __forceinline__ void conv_emit(const Frame& F, const ConvTicket& t, LAS unsigned* L) {
    if (!t.have) return;
    const int nq = F.lane & 31, kd0 = 4 * F.wave + 2 * (F.lane >> 5), row = F.tid >> 2, qtr = F.tid & 3;
    unsigned pk[4][2];
#pragma unroll
    for (int c = 0; c < 4; ++c) { pk[c][0] = pack_fp8x4(t.f[0][c] * FP8_WSCALE, t.f[1][c] * FP8_WSCALE, t.f[2][c] * FP8_WSCALE, t.f[3][c] * FP8_WSCALE);
                                  pk[c][1] = pack_fp8x4(t.f[4][c] * FP8_WSCALE, t.f[5][c] * FP8_WSCALE, t.f[6][c] * FP8_WSCALE, t.f[7][c] * FP8_WSCALE); }
#pragma unroll
    for (int c = 0; c < 4; ++c) { L[(4 * nq + c) * 33 + kd0] = pk[c][0]; L[(4 * nq + c) * 33 + kd0 + 1] = pk[c][1]; }
    asm volatile("s_waitcnt lgkmcnt(0)" ::: "memory"); __builtin_amdgcn_s_barrier(); asm volatile("" ::: "memory");
#pragma unroll
    for (int q = 0; q < 2; ++q) { u32x4 v; v.x = L[row * 33 + qtr * 8 + 4 * q + 0]; v.y = L[row * 33 + qtr * 8 + 4 * q + 1]; v.z = L[row * 33 + qtr * 8 + 4 * q + 2]; v.w = L[row * 33 + qtr * 8 + 4 * q + 3];
        *(u32x4*)(t.dst + 16 * q) = v; }
    asm volatile("s_waitcnt lgkmcnt(0)" ::: "memory"); __builtin_amdgcn_s_barrier(); asm volatile("" ::: "memory");
}
struct CvBoth { static constexpr bool emit = true, issue = true; }; struct CvEmit { static constexpr bool emit = true, issue = false; }; struct CvNone { static constexpr bool emit = false, issue = false; };
constexpr int CONV_S5_LDS = 139264;

__device__ __forceinline__ void phase_prologue(const Frame& F) {
#if MK_CONVPROBE
    if ((F.c >> 3) >= 28) moe_conv_stream(F, 0, 12288, ((F.c >> 3) - 28) * 8 + (F.c & 7), 32);
#else
    moe_conv_stream(F, MK_CVS3 + MK_CVS5, CONV_L0DN_BEG, F.c, F.G);
    moe_conv_stream(F, CONV_L1GU_BEG, CONV_P10_BEG, F.c, F.G);
    moe_conv_stream(F, CONV_L0DN_BEG, CONV_L0DN_BEG + MK_CVD0, F.c, F.G);
    moe_conv_stream(F, CONV_L1DN_BEG, CONV_L1DN_BEG + MK_CVD1, F.c, F.G);
#endif
    for (int u = F.c; u < P0_END; u += F.G) {
        if (u >= P0_CONV4 && u < P0_CONV8) continue;
        if (u < P0_CONV0) conv_batched8(F, u, F.in[L0_WIN], WS_WIN, 1024);
        else if (u < P0_CONV1) conv_batched8(F, u - P0_CONV0, F.in[L0_WGLU], WS_WGLU, 1024);
        else if (u < P0_CONV2) conv_batched8(F, u - P0_CONV1, F.in[L0_WOUT], WS_WOUT, 1024);
        else if (u < P0_CONV3) { const int r = u - P0_CONV2; conv_unit8(F, F.in[L1_WQKV], F.ws + WS_WQKV, 3072, r / 24, r % 24, true); }
        else if (u < P0_CONV4) conv_batched8(F, u - P0_CONV3, F.in[L1_WO], WS_WO, 1024);
        else if (u < P0_CONV5) conv_batched8(F, u - P0_CONV4, F.in[L0_WGU], WS_WGU0, 2048);
        else if (u < P0_CONV6) conv_batched8(F, u - P0_CONV5, F.in[L0_WDN], WS_WDN0, 1024);
        else if (u < P0_CONV7) conv_batched8(F, u - P0_CONV6, F.in[L1_WGU], WS_WGU1, 2048);
        else if (u < P0_CONV8) conv_batched8(F, u - P0_CONV7, F.in[L1_WDN], WS_WDN1, 1024);
        else if (u < P0_ADA) { const int r = u - P0_CONV8; ada_unit(F, r / 96, r % 96); }
        else if (u < P0_S5) s5tab_unit(F, u - P0_ADA);
        else if (u < P0_ROPE) rope_unit(F, u - P0_S5);
        else if (u < P0_WRB) { const int idx = (u - P0_ROPE) * NTHREADS + F.tid, layer = idx >> 15, e = (idx >> 10) & 31, k = idx & 1023;
               ((bf16_t*)(F.ws + WS_WRB))[idx] = f2bf(F.in[layer ? L1_WR : L0_WR][k * 32 + e]); }
        else *(f32x4*)((float*)(F.ws + WS_KMEAN) + ((u - P0_WRB) * NTHREADS + F.tid) * 4) = (f32x4){0.f, 0.f, 0.f, 0.f};
    }
}

__device__ __forceinline__ void norm_mod_row(const float* __restrict__ xr, const float* __restrict__ gamma, const float* __restrict__ sh, const float* __restrict__ sc, bf16_t* __restrict__ hr, int lane) {
    f32x4 v[4]; float ss = 0.f;
#pragma unroll
    for (int i = 0; i < 4; ++i) { v[i] = *(const f32x4*)(xr + 256 * i + 4 * lane); ss += v[i][0] * v[i][0] + v[i][1] * v[i][1] + v[i][2] * v[i][2] + v[i][3] * v[i][3]; }
    ss = wave_sum(ss);
    const float rs = rsqrtf(ss * (1.f / 1024.f) + 1e-6f);
#pragma unroll
    for (int i = 0; i < 4; ++i) {
        const int col = 256 * i + 4 * lane;
        const f32x4 g = *(const f32x4*)(gamma + col), s1 = *(const f32x4*)(sc + col), s0 = *(const f32x4*)(sh + col);
        f32x4 y;
#pragma unroll
        for (int e = 0; e < 4; ++e) y[e] = v[i][e] * rs * g[e] * (1.f + s1[e]) + s0[e];
        u32x2 o; o.x = cvt_pk_bf16(y[0], y[1]); o.y = cvt_pk_bf16(y[2], y[3]);
        *(u32x2*)(hr + col) = o;
    }
}
template <bool F8>
__device__ __forceinline__ void phase_norm_mod(const Frame& F, const float* xin, const float* gamma, int layer, int which, bf16_t* hout) {
    const int lane = F.lane;
    int pb = -1; f32x4 A[4], S0[4];
    for (int r = F.c * 8 + F.wave; r < T; r += F.G * 16) {
        const int r2 = r + F.G * 8; const bool two = r2 < T; const int rb = two ? r2 : r;
        f32x4 v[2][4];
#pragma unroll
        for (int i = 0; i < 4; ++i) { v[0][i] = *(const f32x4*)(xin + (size_t)r * DM + 256 * i + 4 * lane); v[1][i] = *(const f32x4*)(xin + (size_t)rb * DM + 256 * i + 4 * lane); }
#pragma unroll
        for (int q = 0; q < 2; ++q) {
            if (q == 1 && !two) break;
            const int rr = q ? rb : r, b = rr >> 13;
            if (b != pb) { pb = b; const float* sh = ada_vec(F, layer, b, which); const float* sc = ada_vec(F, layer, b, which + 1);
#pragma unroll
                for (int i = 0; i < 4; ++i) { const int col = 256 * i + 4 * lane; const f32x4 g = *(const f32x4*)(gamma + col), s1 = *(const f32x4*)(sc + col); S0[i] = *(const f32x4*)(sh + col);
#pragma unroll
                    for (int e = 0; e < 4; ++e) A[i][e] = g[e] * (1.f + s1[e]); } }
            float ss = 0.f;
#pragma unroll
            for (int i = 0; i < 4; ++i) ss += v[q][i][0] * v[q][i][0] + v[q][i][1] * v[q][i][1] + v[q][i][2] * v[q][i][2] + v[q][i][3] * v[q][i][3];
            ss = wave_sum(ss);
            const float rs = rsqrtf(ss * (1.f / 1024.f) + 1e-6f);
#pragma unroll
            for (int i = 0; i < 4; ++i) {
                const int col = 256 * i + 4 * lane;
                f32x4 y;
#pragma unroll
                for (int e = 0; e < 4; ++e) y[e] = v[q][i][e] * rs * A[i][e] + S0[i][e];
                if constexpr (F8) *(unsigned*)((unsigned char*)hout + (size_t)rr * DM + col) = pack_fp8x4(y[0], y[1], y[2], y[3]);
                else { u32x2 o; o.x = cvt_pk_bf16(y[0], y[1]); o.y = cvt_pk_bf16(y[2], y[3]);
                       *(u32x2*)(hout + (size_t)rr * DM + col) = o; }
            }
        }
    }
}

template <class XT>
__device__ __forceinline__ void phase_norm_router(const Frame& F, const XT* xin, const bf16_t* mres, const float* gamma, int layer, unsigned char* hout) {
    const bf16_t* wrb = (const bf16_t*)(F.ws + WS_WRB) + (size_t)layer * 32 * 1024; const float* br = F.in[layer ? L1_BR : L0_BR];
    LAS unsigned char* hb = F.lds + F.wave * 16640;
    LAS int* cntl = (LAS int*)(F.lds + 133120);
    LAS int* basel = cntl + 32; LAS int* entl = cntl + 64;
    unsigned* gcnt = (unsigned*)(F.ws + ZB_MOECNT + layer * 256);
    int* pos = (int*)(F.ws + WS_TOPK); float* gates = (float*)(F.ws + WS_TOPK + (size_t)T * 4 * 4); int* vtok = (int*)(F.ws + WS_VTOK);
    const int lane = F.lane, e16 = lane & 15, kg = lane >> 4;
    for (int r0 = F.c * 64; r0 < T; r0 += F.G * 64) {
        if (F.tid < 32) cntl[F.tid] = 0;
        __syncthreads();
        const int rw = r0 + F.wave * 8;
        const int b = rw >> 13;
        bf16x8 wb[8];
        { const bf16_t* bp = wrb + (size_t)(lane & 31) * 1024 + 128 * F.wave + (lane >> 5) * 8;
#pragma unroll
          for (int ks = 0; ks < 8; ++ks) wb[ks] = *(const bf16x8*)(bp + ks * 16); }
        f32x4 A[4], S0[4], G1[4];
        { const float* sh = ada_vec(F, layer, b, 3); const float* sc = ada_vec(F, layer, b, 4); const float* g1 = ada_vec(F, layer, b, 2);
#pragma unroll
          for (int i = 0; i < 4; ++i) { const int col = 256 * i + 4 * lane; const f32x4 g = *(const f32x4*)(gamma + col), s1 = *(const f32x4*)(sc + col); S0[i] = *(const f32x4*)(sh + col); G1[i] = *(const f32x4*)(g1 + col);
#pragma unroll
            for (int k = 0; k < 4; ++k) A[i][k] = g[k] * (1.f + s1[k]); } }
#pragma unroll 1
        for (int half = 0; half < 2; ++half) {
            f32x4 v[4][4]; unsigned mr[4][4];
#pragma unroll
            for (int q = 0; q < 4; ++q)
#pragma unroll
                for (int i = 0; i < 4; ++i) { v[q][i] = load_x4(xin + (size_t)(rw + half * 4 + q) * DM + 256 * i + 4 * lane);
                                              mr[q][i] = *(const unsigned*)((const unsigned char*)mres + (size_t)(rw + half * 4 + q) * DM + 256 * i + 4 * lane); }
            {
#pragma unroll
              for (int i = 0; i < 4; ++i) { const f32x4 gv = G1[i] * (1.f / FP8_MSCALE);
#pragma unroll
                for (int q = 0; q < 4; ++q) { const f32x2 m01 = __builtin_amdgcn_cvt_pk_f32_fp8((int)mr[q][i], false), m23 = __builtin_amdgcn_cvt_pk_f32_fp8((int)mr[q][i], true);
                                              v[q][i][0] = fmaf(gv[0], m01[0], v[q][i][0]); v[q][i][1] = fmaf(gv[1], m01[1], v[q][i][1]);
                                              v[q][i][2] = fmaf(gv[2], m23[0], v[q][i][2]); v[q][i][3] = fmaf(gv[3], m23[1], v[q][i][3]); } } }
#pragma unroll
            for (int q = 0; q < 4; ++q) {
                const int r = rw + half * 4 + q;
                float ss = 0.f;
#pragma unroll
                for (int i = 0; i < 4; ++i) ss += v[q][i][0] * v[q][i][0] + v[q][i][1] * v[q][i][1] + v[q][i][2] * v[q][i][2] + v[q][i][3] * v[q][i][3];
                ss = wave_sum(ss);
                const float rs = rsqrtf(ss * (1.f / 1024.f) + 1e-6f);
#pragma unroll
                for (int i = 0; i < 4; ++i) {
                    const int col = 256 * i + 4 * lane;
                    f32x4 y;
#pragma unroll
                    for (int k = 0; k < 4; ++k) y[k] = v[q][i][k] * rs * A[i][k] + S0[i][k];
                    *(unsigned*)(hout + (size_t)r * DM + col) = pack_fp8x4(y[0], y[1], y[2], y[3]);
                    u32x2 o; o.x = cvt_pk_bf16(y[0], y[1]); o.y = cvt_pk_bf16(y[2], y[3]);
                    *(LAS u32x2*)(hb + (half * 4 + q) * 2080 + col * 2) = o;
                }
            }
        }
        __syncthreads();
        f32x16 pa = {}, pb = {};
        { const int rl = lane & 31, hi2 = lane >> 5;
          const LAS unsigned char* ap0 = F.lds + (rl >> 3) * 16640 + (rl & 7) * 2080 + (128 * F.wave + hi2 * 8) * 2;
#pragma unroll
          for (int ks = 0; ks < 8; ++ks) {
              const bf16x8 a0 = *(const LAS bf16x8*)(ap0 + ks * 32), a1 = *(const LAS bf16x8*)(ap0 + 4 * 16640 + ks * 32);
              pa = __builtin_amdgcn_mfma_f32_32x32x16_bf16(a0, wb[ks], pa, 0, 0, 0);
              pb = __builtin_amdgcn_mfma_f32_32x32x16_bf16(a1, wb[ks], pb, 0, 0, 0); }
          __syncthreads();
          LAS float* P = (LAS float*)F.lds + F.wave * 2048;
#pragma unroll
          for (int i = 0; i < 16; ++i) { const int row = (i >> 2) * 8 + hi2 * 4 + (i & 3); P[row * 32 + rl] = pa[i]; P[(32 + row) * 32 + rl] = pb[i]; } }
        __syncthreads();
        f32x4 acc0 = {0.f, 0.f, 0.f, 0.f}, acc1 = {0.f, 0.f, 0.f, 0.f};
#pragma unroll
        for (int reg = 0; reg < 4; ++reg) { const LAS float* P = (const LAS float*)F.lds + (F.wave * 8 + ((4 * kg + reg) & 7)) * 32 + e16;
#pragma unroll
            for (int w = 0; w < 8; ++w) { acc0[reg] += P[w * 2048]; acc1[reg] += P[w * 2048 + 16]; } }
        const float bias0 = br[e16], bias1 = br[16 + e16];
#pragma unroll
        for (int reg = 0; reg < 4; ++reg) {
            float v0 = acc0[reg] + bias0, v1 = acc1[reg] + bias1;
            const int r = rw + ((4 * kg + reg) & 7);
            int ek[4]; float vk[4];
#pragma unroll
            for (int k = 0; k < 4; ++k) {
                const float m = row16_max(fmaxf(v0, v1));
                const int cand = row16_min((v0 == m) ? e16 : ((v1 == m) ? 16 + e16 : 99));
                ek[k] = cand; vk[k] = m;
                if (cand == e16) v0 = -INFINITY; else if (cand == 16 + e16) v1 = -INFINITY;
            }
            const float e1 = __expf(vk[1] - vk[0]), e2 = __expf(vk[2] - vk[0]), e3 = __expf(vk[3] - vk[0]);
            const float inv = 1.f / (1.f + e1 + e2 + e3);
            if (kg < 2 && e16 < 4) {
                const int ee = e16 == 0 ? ek[0] : e16 == 1 ? ek[1] : e16 == 2 ? ek[2] : ek[3];
                const float gg = (e16 == 0 ? 1.f : e16 == 1 ? e1 : e16 == 2 ? e2 : e3) * inv;
                const int rank = __hip_atomic_fetch_add(&cntl[ee], 1, __ATOMIC_RELAXED, __HIP_MEMORY_SCOPE_WORKGROUP);
                entl[(r - r0) * 4 + e16] = (ee << 16) | rank;
                gates[(size_t)r * 4 + e16] = gg;
            }
        }
        __syncthreads();
        if (F.tid < 32) basel[F.tid] = (int)atomicAdd(&gcnt[F.tid], (unsigned)cntl[F.tid]);
        __syncthreads();
        if (F.tid < 256) {
            const int en = entl[F.tid], ee = en >> 16, v = basel[ee] + (en & 0xffff), tk = r0 * 4 + F.tid;
            vtok[ee * MOE_CAP + v] = tk; pos[tk] = ee * MOE_CAP + v;
        }
        __syncthreads();
    }
}

namespace pg {
constexpr int BM = 256, BK = 64, HALF = 128, HTB = HALF * BK * 2, STAGE_BYTES = 8 * HTB, NXCD = 8, WGM = 8, KD = 1024, NKT = KD / BK;
__device__ __forceinline__ int lds_byte(int r, int c) { const int st = (r >> 4) * 2 + (c >> 5), rr = r & 15, cc = c & 31, ob = rr * 64 + cc * 2; return st * 1024 + (ob ^ (((ob >> 9) & 1) << 5)); }
__device__ __forceinline__ void stage_rc(int b, int& R, int& C) { const int st = b / 1024, sb = b % 1024, swz = sb ^ (((sb >> 9) & 1) << 5); R = (st >> 1) * 16 + swz / 64; C = (st & 1) * 32 + (swz % 64) / 2; }
__device__ __forceinline__ int perm32(int rho) { const int n = rho >> 4, i = rho & 15; return 8 * (i >> 2) + 4 * n + (i & 3); }

struct Unit { int rt, pn, e, ui; };

template <class P>
__device__ __forceinline__ void gemm_phase(LAS unsigned char* lds, const P& S) {
    const int tid = threadIdx.x, wid = __builtin_amdgcn_readfirstlane(tid >> 6), lane = tid & 63, wr = wid >> 2, wc = wid & 3, fr = lane & 15, fq = lane >> 4;
    int R0, C0; stage_rc(tid * 16, R0, C0);
    constexpr int ROWB = P::FP8 ? 1024 : 2048, NKT_ = ROWB / 128, KREP = P::KREP;
    unsigned voffB[2];
#pragma unroll
    for (int i = 0; i < 2; ++i) { const int R = R0 + 64 * i, Rb = P::PERM ? ((R & ~31) + perm32(R & 31)) : R; voffB[i] = (unsigned)(Rb * ROWB + C0 * 2); }
    const unsigned cofs = (unsigned)C0 * 2u;
    const unsigned ldsw = (unsigned)wid * 1024u;
    const int aoff = lds_byte(wr * 64 + fr, fq * 8), boff = lds_byte(wc * 32 + fr, fq * 8);
#define PG_SA(b, h) (((b) * 2 + (h)) * HTB)
#define PG_SB(b, h) ((4 + (b) * 2 + (h)) * HTB)
#define PG_STA(bufoff, kptr, V0, V1) do { \
        __builtin_amdgcn_global_load_lds((const unsigned*)((kptr) + (V0)), (LAS unsigned*)(lds + (bufoff) + ldsw), 16, 0, 0); \
        __builtin_amdgcn_global_load_lds((const unsigned*)((kptr) + (V1)), (LAS unsigned*)(lds + (bufoff) + ldsw + 8192), 16, 0, 0); } while (0)
#define PG_STB(bufoff, bptr) PG_STA(bufoff, bptr, voffB[0], voffB[1])
#define PG_LDA(dst, b, h) do { _Pragma("unroll") for (int m = 0; m < 4; ++m) dst[m] = __builtin_shufflevector(*(const LAS v4i*)(lds + PG_SA(b, h) + aoff + m * 2048), *(const LAS v4i*)(lds + PG_SA(b, h) + aoff + m * 2048 + 1024), 0, 1, 2, 3, 4, 5, 6, 7); } while (0)
#define PG_LDB(dst, b, h) do { _Pragma("unroll") for (int n = 0; n < 2; ++n) dst[n] = __builtin_shufflevector(*(const LAS v4i*)(lds + PG_SB(b, h) + boff + n * 2048), *(const LAS v4i*)(lds + PG_SB(b, h) + boff + n * 2048 + 1024), 0, 1, 2, 3, 4, 5, 6, 7); } while (0)
#define PG_LO(X) __builtin_bit_cast(bf16x8, __builtin_shufflevector(X, X, 0, 1, 2, 3))
#define PG_HI(X) __builtin_bit_cast(bf16x8, __builtin_shufflevector(X, X, 4, 5, 6, 7))
#define PG_MMA(ai, bj, At, Bt) do { __builtin_amdgcn_s_setprio(1); _Pragma("unroll") for (int m = 0; m < 4; ++m) _Pragma("unroll") for (int n = 0; n < 2; ++n) { \
        if constexpr (P::FP8) asm volatile("v_mfma_scale_f32_16x16x128_f8f6f4 %0, %1, %2, %0, %3, %3 op_sel_hi:[0,0,0]" : "+v"(acc[ai][bj][m][n]) : "v"(Bt[n]), "v"(At[m]), "v"(fp8_one)); \
        else { acc[ai][bj][m][n] = __builtin_amdgcn_mfma_f32_16x16x32_bf16(PG_LO(Bt[n]), PG_LO(At[m]), acc[ai][bj][m][n], 0, 0, 0); \
               acc[ai][bj][m][n] = __builtin_amdgcn_mfma_f32_16x16x32_bf16(PG_HI(Bt[n]), PG_HI(At[m]), acc[ai][bj][m][n], 0, 0, 0); } } \
        __builtin_amdgcn_s_setprio(0); } while (0)
#define PG_WAIT_V(n) asm volatile("s_waitcnt vmcnt(" #n ")" ::: "memory")
#define PG_WAIT_L(n) asm volatile("s_waitcnt lgkmcnt(" #n ")" ::: "memory")
#define PG_BAR __builtin_amdgcn_s_barrier()
#define PG_SCHED __builtin_amdgcn_sched_barrier(0)
    Unit cur, nxt; int ui = 0;
    if (!S.next(0, cur)) return;
    f32x4 acc[2][2][4][2];
    {   f32x4 bi[2][2]; S.binit(cur, wc, fq, bi);
#pragma unroll
        for (int a = 0; a < 2; ++a)
#pragma unroll
            for (int b = 0; b < 2; ++b)
#pragma unroll
                for (int m = 0; m < 4; ++m)
#pragma unroll
                    for (int n = 0; n < 2; ++n) acc[a][b][m][n] = bi[b][n] * P::BIAS_SCALE; }
    v8i At[4], B0[2], B1[2];
    int fp8_one = 0x7F7F7F7F; asm volatile("" : "+v"(fp8_one));
    unsigned va0, va1, va2, va3, vn0, vn1, vn2, vn3;
    S.arows(cur, R0, cofs, va0, va1, va2, va3);
    const char* cb0; const char* cb1; S.bptr(cur, cb0, cb1);
    const char* const A0 = S.abase();
    PG_STB(PG_SB(0, 0), cb0); PG_STA(PG_SA(0, 0), A0, va0, va1); PG_STB(PG_SB(0, 1), cb1); PG_STA(PG_SA(0, 1), A0, va2, va3);
    if (wr == 1) PG_BAR;
    PG_WAIT_V(4); PG_BAR;
    PG_STB(PG_SB(1, 0), cb0 + 128); PG_STA(PG_SA(1, 0), A0 + 128, va0, va1); PG_STB(PG_SB(1, 1), cb1 + 128);
    PG_WAIT_V(6); PG_BAR;
    for (;;) {
        const bool has_next = S.next(ui + 1, nxt);
        const char* nb0 = cb0; const char* nb1 = cb1; vn0 = va0; vn1 = va1; vn2 = va2; vn3 = va3;
        if (has_next) { S.arows(nxt, R0, cofs, vn0, vn1, vn2, vn3); S.bptr(nxt, nb0, nb1); }
#pragma unroll 1
        for (int tt = 0; tt < NKT_ * KREP; tt += 2) {
            const int t = tt % NKT_;
            const bool wrap = (t == NKT_ - 2), last = wrap && (tt == NKT_ * KREP - 2);
            const int kt2 = wrap ? 0 : t + 2;
            const char* a1 = A0 + (size_t)(t + 1) * 128; const char* a2 = A0 + (size_t)kt2 * 128; const char* a3 = a2 + 128;
            const char* b20 = (last ? nb0 : cb0) + (size_t)kt2 * 128; const char* b21 = (last ? nb1 : cb1) + (size_t)kt2 * 128;
            const unsigned w0 = last ? vn0 : va0, w1 = last ? vn1 : va1, w2 = last ? vn2 : va2, w3 = last ? vn3 : va3;
            PG_LDB(B0, 0, 0); PG_SCHED; PG_LDA(At, 0, 0); PG_STA(PG_SA(1, 1), a1, va2, va3);
            PG_WAIT_L(8); PG_BAR; PG_WAIT_L(0); PG_MMA(0, 0, At, B0); PG_BAR; PG_SCHED;
            PG_LDB(B1, 0, 1); PG_STB(PG_SB(0, 0), b20);
            PG_BAR; PG_WAIT_L(0); PG_MMA(0, 1, At, B1); PG_BAR;
            PG_LDA(At, 0, 1); PG_STA(PG_SA(0, 0), a2, w0, w1);
            PG_BAR; PG_WAIT_L(0); PG_MMA(1, 0, At, B0); PG_BAR; PG_SCHED;
            PG_STB(PG_SB(0, 1), b21);
            PG_WAIT_V(6); PG_BAR; PG_MMA(1, 1, At, B1); PG_BAR;
            PG_LDB(B0, 1, 0); PG_SCHED; PG_LDA(At, 1, 0); PG_STA(PG_SA(0, 1), a2, w2, w3);
            PG_WAIT_L(8); PG_BAR; PG_WAIT_L(0); PG_MMA(0, 0, At, B0); PG_BAR; PG_SCHED;
            PG_LDB(B1, 1, 1); PG_STB(PG_SB(1, 0), b20 + 128);
            PG_BAR; PG_WAIT_L(0); PG_MMA(0, 1, At, B1); PG_BAR;
            PG_LDA(At, 1, 1); PG_STA(PG_SA(1, 0), a3, w0, w1);
            PG_BAR; PG_WAIT_L(0); PG_MMA(1, 0, At, B0); PG_BAR; PG_SCHED;
            PG_STB(PG_SB(1, 1), b21 + 128);
            PG_WAIT_V(6); PG_BAR; PG_MMA(1, 1, At, B1); PG_BAR;
        }
        if (has_next) S.prefetch(nxt, tid, (LAS unsigned*)(lds + PF_LDS + ldsw / 4));
        f32x4 bn[2][2];
        if (has_next) S.binit(nxt, wc, fq, bn);
        if constexpr (P::FP8) asm volatile("s_nop 15\n\ts_nop 15" ::: "memory");
        S.epi(acc, cur, wr, wc, fr, fq);
        if (!has_next) break;
#pragma unroll
        for (int a = 0; a < 2; ++a)
#pragma unroll
            for (int b = 0; b < 2; ++b)
#pragma unroll
                for (int m = 0; m < 4; ++m)
#pragma unroll
                    for (int n = 0; n < 2; ++n) acc[a][b][m][n] = bn[b][n] * P::BIAS_SCALE;
        cur = nxt; cb0 = nb0; cb1 = nb1; va0 = vn0; va1 = vn1; va2 = vn2; va3 = vn3; ++ui;
    }
    PG_WAIT_V(0);
    if (wr == 0) PG_BAR;
    PG_BAR;
#undef PG_SA
#undef PG_SB
#undef PG_STA
#undef PG_STB
#undef PG_LDA
#undef PG_LDB
#undef PG_MMA
#undef PG_LO
#undef PG_HI
#undef PG_WAIT_V
#undef PG_WAIT_L
#undef PG_BAR
#undef PG_SCHED
}

template <class Epi, bool FP8_ = false> struct Dense {
    static constexpr bool PERM = Epi::PERM, FP8 = FP8_; static constexpr int KREP = 1; static constexpr float BIAS_SCALE = 0.f;
    static constexpr unsigned ROWB = FP8_ ? 1024u : 2048u;
    const void* A; const void* Bt; int nM, nN, G, c; Epi E;
    __device__ __forceinline__ bool next(int i, Unit& u) const {
        const int nwg = nM * nN; const long L = (long)i * G + c; if (L >= nwg) return false;
        int wgid = (int)L; { const int q = nwg / NXCD, r = nwg % NXCD, xcd = wgid % NXCD, off = wgid / NXCD; wgid = (xcd < r ? xcd * (q + 1) : r * (q + 1) + (xcd - r) * q) + off; }
        const int nig = WGM * nN, gid = wgid / nig, fm = gid * WGM, gsz = (nM - fm) < WGM ? (nM - fm) : WGM;
        u.rt = fm + ((wgid % nig) % gsz); u.pn = (wgid % nig) / gsz; u.e = 0; u.ui = i; return true;
    }
    __device__ __forceinline__ void arows(const Unit& u, int R0, unsigned cofs, unsigned& v0, unsigned& v1, unsigned& v2, unsigned& v3) const {
        const unsigned base = (unsigned)(u.rt * 256 + R0) * ROWB + cofs; v0 = base; v1 = base + 64u * ROWB; v2 = base + 128u * ROWB; v3 = base + 192u * ROWB;
    }
    __device__ __forceinline__ const char* abase() const { return (const char*)A; }
    __device__ __forceinline__ void bptr(const Unit& u, const char*& b0, const char*& b1) const { b0 = (const char*)Bt + (size_t)u.pn * 256 * ROWB; b1 = b0 + (size_t)128 * ROWB; }
    __device__ __forceinline__ void epi(const f32x4 (&acc)[2][2][4][2], const Unit& u, int wr, int wc, int fr, int fq) const { E(acc, u, wr, wc, fr, fq); }
    __device__ __forceinline__ void binit(const Unit&, int, int, f32x4 (&bi)[2][2]) const { bi[0][0] = bi[0][1] = bi[1][0] = bi[1][1] = (f32x4){0.f, 0.f, 0.f, 0.f}; }
    __device__ __forceinline__ void prefetch(const Unit&, int, LAS unsigned*) const {}
};

struct EpiBf16 {
    static constexpr bool PERM = true;
    bf16_t* O; float sc;
    __device__ __forceinline__ void operator()(const f32x4 (&acc)[2][2][4][2], const Unit& u, int wr, int wc, int fr, int fq) const {
        const int row0 = u.rt * 256 + wr * 64 + fr, col0 = u.pn * 256 + wc * 32 + 8 * fq;
#pragma unroll
        for (int ai = 0; ai < 2; ++ai)
#pragma unroll
            for (int m = 0; m < 4; ++m) { bf16_t* rowp = O + (size_t)(row0 + ai * 128 + m * 16) * 1024 + col0;
#pragma unroll
                for (int bj = 0; bj < 2; ++bj) { const f32x4 v0 = acc[ai][bj][m][0] * sc, v1 = acc[ai][bj][m][1] * sc;
                    u32x4 w; w.x = cvt_pk_bf16(v0[0], v0[1]); w.y = cvt_pk_bf16(v0[2], v0[3]); w.z = cvt_pk_bf16(v1[0], v1[1]); w.w = cvt_pk_bf16(v1[2], v1[3]);
                    *(u32x4*)(rowp + bj * 128) = w; } }
    }
};
struct EpiF8 {
    static constexpr bool PERM = true;
    unsigned char* O; float sc;
    __device__ __forceinline__ void operator()(const f32x4 (&acc)[2][2][4][2], const Unit& u, int wr, int wc, int fr, int fq) const {
        const int row0 = u.rt * 256 + wr * 64 + fr, col0 = u.pn * 256 + wc * 32 + 8 * fq;
#pragma unroll
        for (int ai = 0; ai < 2; ++ai)
#pragma unroll
            for (int m = 0; m < 4; ++m) { unsigned char* rowp = O + (size_t)(row0 + ai * 128 + m * 16) * 1024 + col0;
#pragma unroll
                for (int bj = 0; bj < 2; ++bj) { const f32x4 v0 = acc[ai][bj][m][0] * sc, v1 = acc[ai][bj][m][1] * sc;
                    u32x2 w; w.x = pack_fp8x4(v0[0], v0[1], v0[2], v0[3]); w.y = pack_fp8x4(v1[0], v1[1], v1[2], v1[3]);
                    *(u32x2*)(rowp + bj * 128) = w; } }
    }
};
struct EpiGlu {
    static constexpr bool PERM = true;
    const unsigned char* Z; unsigned char* O; float sc;
    __device__ __forceinline__ void operator()(const f32x4 (&acc)[2][2][4][2], const Unit& u, int wr, int wc, int fr, int fq) const {
        const int row0 = u.rt * 256 + wr * 64 + fr, col0 = u.pn * 256 + wc * 32 + 8 * fq;
#pragma unroll
        for (int ai = 0; ai < 2; ++ai)
#pragma unroll
            for (int m = 0; m < 4; ++m) { const size_t ro = (size_t)(row0 + ai * 128 + m * 16) * 1024 + col0;
#pragma unroll
                for (int bj = 0; bj < 2; ++bj) { const f32x4 v0 = acc[ai][bj][m][0] * sc, v1 = acc[ai][bj][m][1] * sc;
                    const u32x2 z = *(const u32x2*)(Z + ro + bj * 128);
                    const f32x2 z0 = __builtin_amdgcn_cvt_pk_f32_fp8((int)z.x, false), z1 = __builtin_amdgcn_cvt_pk_f32_fp8((int)z.x, true);
                    const f32x2 z2 = __builtin_amdgcn_cvt_pk_f32_fp8((int)z.y, false), z3 = __builtin_amdgcn_cvt_pk_f32_fp8((int)z.y, true);
                    u32x2 w;
                    w.x = pack_fp8x4(FP8_ZSCALE * z0[0] * sigmoidf_fast(v0[0]), FP8_ZSCALE * z0[1] * sigmoidf_fast(v0[1]), FP8_ZSCALE * z1[0] * sigmoidf_fast(v0[2]), FP8_ZSCALE * z1[1] * sigmoidf_fast(v0[3]));
                    w.y = pack_fp8x4(FP8_ZSCALE * z2[0] * sigmoidf_fast(v1[0]), FP8_ZSCALE * z2[1] * sigmoidf_fast(v1[1]), FP8_ZSCALE * z3[0] * sigmoidf_fast(v1[2]), FP8_ZSCALE * z3[1] * sigmoidf_fast(v1[3]));
                    *(u32x2*)(O + ro + bj * 128) = w; } }
    }
};
struct EpiResid {
    static constexpr bool PERM = false;
    const float* Xi; float* Xo; const float* gate0; const float* gate1; float sc;
    __device__ __forceinline__ void operator()(const f32x4 (&acc)[2][2][4][2], const Unit& u, int wr, int wc, int fr, int fq) const {
        const int row0 = u.rt * 256 + wr * 64 + fr, col0 = u.pn * 256 + wc * 32 + 4 * fq;
        const float* gate = (u.rt * 256 >= SEQ) ? gate1 : gate0;
        f32x4 gv[2][2];
#pragma unroll
        for (int bj = 0; bj < 2; ++bj)
#pragma unroll
            for (int n = 0; n < 2; ++n) gv[bj][n] = *(const f32x4*)(gate + col0 + bj * 128 + n * 16) * sc;
#pragma unroll
        for (int ai = 0; ai < 2; ++ai)
#pragma unroll
            for (int m = 0; m < 4; ++m) { const size_t ro = (size_t)(row0 + ai * 128 + m * 16) * 1024 + col0;
#pragma unroll
                for (int bj = 0; bj < 2; ++bj)
#pragma unroll
                    for (int n = 0; n < 2; ++n) { const f32x4 xi = *(const f32x4*)(Xi + ro + bj * 128 + n * 16); *(f32x4*)(Xo + ro + bj * 128 + n * 16) = xi + gv[bj][n] * acc[ai][bj][m][n]; } }
    }
};
struct EpiQkv {
    static constexpr bool PERM = true;
    bf16_t* Q; const float* cs; const float* sn; float sc; float* km;
    __device__ __forceinline__ void operator()(const f32x4 (&acc)[2][2][4][2], const Unit& u, int wr, int wc, int fr, int fq) const {
        const int sec = u.pn >> 2, row0 = u.rt * 256 + wr * 64 + fr, col0 = (u.pn & 3) * 256 + wc * 32 + 8 * fq, d0 = 16 * wc + 4 * fq;
        bf16_t* O = Q + (size_t)sec * T * DM;
        if (sec == 2) {
#pragma unroll
            for (int ai = 0; ai < 2; ++ai)
#pragma unroll
                for (int m = 0; m < 4; ++m) { bf16_t* rowp = O + (size_t)(row0 + ai * 128 + m * 16) * 1024 + col0;
#pragma unroll
                    for (int bj = 0; bj < 2; ++bj) { const f32x4 v0 = acc[ai][bj][m][0] * sc, v1 = acc[ai][bj][m][1] * sc;
                        u32x4 w; w.x = cvt_pk_bf16(v0[0], v0[1]); w.y = cvt_pk_bf16(v0[2], v0[3]); w.z = cvt_pk_bf16(v1[0], v1[1]); w.w = cvt_pk_bf16(v1[2], v1[3]);
                        *(u32x4*)(rowp + bj * 128) = w; } }
            return;
        }
        float ks[2][8];
#pragma unroll
        for (int bj = 0; bj < 2; ++bj)
#pragma unroll
            for (int j = 0; j < 8; ++j) ks[bj][j] = 0.f;
        f32x4 cN, sN, cM, sM;
        { const size_t ro = (size_t)row0 * 64 + d0; cN = *(const f32x4*)(cs + ro); sN = *(const f32x4*)(sn + ro); }
        { const size_t ro = (size_t)(row0 + 16) * 64 + d0; cM = *(const f32x4*)(cs + ro); sM = *(const f32x4*)(sn + ro); }
#pragma unroll
        for (int i = 0; i < 8; ++i) { const int ai = i >> 2, m = i & 3;
            bf16_t* rowp = O + (size_t)(row0 + ai * 128 + m * 16) * 1024 + col0;
            const f32x4 c = cN, s = sN; cN = cM; sN = sM;
            if (i + 2 < 8) { const size_t ro = (size_t)(row0 + ((i + 2) >> 2) * 128 + ((i + 2) & 3) * 16) * 64 + d0; cM = *(const f32x4*)(cs + ro); sM = *(const f32x4*)(sn + ro); }
            asm volatile("" ::: "memory");
#pragma unroll
            for (int bj = 0; bj < 2; ++bj) { const f32x4 v0 = acc[ai][bj][m][0] * sc, v1 = acc[ai][bj][m][1] * sc;
                float r[8];
                r[0] = v0[0] * c[0] - v0[1] * s[0]; r[1] = v0[1] * c[0] + v0[0] * s[0];
                r[2] = v0[2] * c[1] - v0[3] * s[1]; r[3] = v0[3] * c[1] + v0[2] * s[1];
                r[4] = v1[0] * c[2] - v1[1] * s[2]; r[5] = v1[1] * c[2] + v1[0] * s[2];
                r[6] = v1[2] * c[3] - v1[3] * s[3]; r[7] = v1[3] * c[3] + v1[2] * s[3];
#pragma unroll
                for (int j = 0; j < 8; ++j) { ks[bj][j] += r[j]; asm volatile("" : "+v"(ks[bj][j])); }
                u32x4 w; w.x = cvt_pk_bf16(r[0], r[1]); w.y = cvt_pk_bf16(r[2], r[3]); w.z = cvt_pk_bf16(r[4], r[5]); w.w = cvt_pk_bf16(r[6], r[7]);
                *(u32x4*)(rowp + bj * 128) = w; }
            asm volatile("" ::: "memory"); }
        if (sec == 1) {
            const int b = (u.rt * 256) >> 13, n = (u.rt & 31);
#pragma unroll
            for (int bj = 0; bj < 2; ++bj) {
                const int h = (u.pn & 3) * 2 + bj;
#pragma unroll
                for (int j = 0; j < 8; ++j) ks[bj][j] = row16_sum(ks[bj][j]);
                if (fr == 0) { float* kp = km + ((size_t)(b * 8 + h) * 32 + n) * 128 + wc * 32 + 8 * fq;
#pragma unroll
                    for (int j = 0; j < 8; ++j) atomicAdd(kp + j, ks[bj][j] * (1.f / 256.f)); }
            }
        }
    }
};

constexpr int MOE_LDS_IDX = STAGE_BYTES;
constexpr int MOE_LDS_TILE_E = STAGE_BYTES + 12 * 1024;
constexpr int MOE_LDS_EBASE = MOE_LDS_TILE_E + 1280;
constexpr int MOE_LDS_ECNT = MOE_LDS_EBASE + 256;
struct MoeTabs { LAS int* idx; LAS int* tile_e; LAS int* ebase; LAS int* ecnt; int R; };
struct MoeGeo { int W, x, s, G, c; bool xcd; };
__device__ __forceinline__ MoeGeo moe_geo(int G, int c, int W) { MoeGeo g; g.xcd = (G == 256); g.W = W; g.x = c & 7; g.s = c >> 3; g.G = G; g.c = c; return g; }
template <int NPN>
__device__ __forceinline__ bool moe_unit(int i, const MoeGeo& g, int R, int& rt, int& pn) {
    if (g.xcd) {
        const int total = R * NPN, quota = (total + 7) >> 3, local = i * g.W + g.s, U = g.x * quota + local;
        rt = U / NPN; pn = U % NPN; return local < quota && U < total; }
    const long L = (long)i * g.G + g.c; rt = (int)(L / NPN); pn = (int)(L % NPN); return rt < R;
}
template <int NPN>
__device__ __forceinline__ MoeTabs moe_setup(const Frame& F, int layer, bool want_idx, const MoeGeo& geo) {
    MoeTabs M; M.idx = (LAS int*)(F.lds + MOE_LDS_IDX); M.tile_e = (LAS int*)(F.lds + MOE_LDS_TILE_E); M.ebase = (LAS int*)(F.lds + MOE_LDS_EBASE); M.ecnt = (LAS int*)(F.lds + MOE_LDS_ECNT);
    const unsigned* gcnt = (const unsigned*)(F.ws + ZB_MOECNT + layer * 256);
    if (F.tid < 64) {
        const int cnt = F.tid < 32 ? (int)gcnt[F.tid] : 0, nt = (cnt + 255) >> 8;
        int incl = nt;
#pragma unroll
        for (int o = 1; o < 32; o <<= 1) { const int y = __shfl_up(incl, o, 64); if (F.lane >= o) incl += y; }
        if (F.tid < 32) { M.ecnt[F.tid] = cnt; M.ebase[F.tid] = incl - nt; }
        if (F.tid == 31) M.ebase[32] = incl;
    }
    __syncthreads();
    M.R = M.ebase[32];
    if (F.tid < M.R) { int lo = 0, hi = 31;
        while (lo < hi) { const int mid = (lo + hi + 1) >> 1; if (M.ebase[mid] <= F.tid) lo = mid; else hi = mid - 1; }
        M.tile_e[F.tid] = lo; }
    __syncthreads();
    if (want_idx) {
        const int* vtok = (const int*)(F.ws + WS_VTOK);
        int tk[12];
#pragma unroll
        for (int i = 0; i < 12; ++i) { int rt, pn; tk[i] = 0;
            if (F.tid < 256 && moe_unit<NPN>(i, geo, M.R, rt, pn)) { const int e = M.tile_e[rt], v = (rt - M.ebase[e]) * 256 + F.tid; if (v < M.ecnt[e]) tk[i] = vtok[e * MOE_CAP + v]; } }
        if (F.tid < 256) {
#pragma unroll
            for (int i = 0; i < 12; ++i) M.idx[i * 256 + F.tid] = tk[i] >> 2; }
        __syncthreads();
    }
    return M;
}

template <int NPN>
__device__ __forceinline__ MoeTabs moe_setup(const Frame& F, int layer, bool want_idx, const MoeGeo& geo);
__device__ __forceinline__ MoeTabs moe_tabs_reuse(const Frame& F, int layer, const MoeGeo& geo) {
#if MK_MULTI
    return moe_setup<4>(F, layer, false, geo);
#endif
    MoeTabs M; M.idx = (LAS int*)(F.lds + MOE_LDS_IDX); M.tile_e = (LAS int*)(F.lds + MOE_LDS_TILE_E); M.ebase = (LAS int*)(F.lds + MOE_LDS_EBASE); M.ecnt = (LAS int*)(F.lds + MOE_LDS_ECNT);
    M.R = M.ebase[32]; return M;
}
struct MoeGateUp {
    static constexpr bool PERM = true, FP8 = true; static constexpr int KREP = MK_KREP; static constexpr float BIAS_SCALE = FP8_WSCALE * MK_KREP;
    const unsigned char* A; const unsigned char* W; const float* bias; unsigned char* O; MoeTabs M; MoeGeo geo;
    __device__ __forceinline__ bool next(int i, Unit& u) const {
        if (!moe_unit<8>(i, geo, M.R, u.rt, u.pn)) return false;
        u.e = __builtin_amdgcn_readfirstlane(M.tile_e[u.rt]); u.ui = i; return true;
    }
    __device__ __forceinline__ void arows(const Unit& u, int R0, unsigned cofs, unsigned& v0, unsigned& v1, unsigned& v2, unsigned& v3) const {
        const LAS int* ip = M.idx + u.ui * 256 + R0;
        v0 = (unsigned)ip[0] * 1024u + cofs; v1 = (unsigned)ip[64] * 1024u + cofs; v2 = (unsigned)ip[128] * 1024u + cofs; v3 = (unsigned)ip[192] * 1024u + cofs;
    }
    __device__ __forceinline__ const char* abase() const { return (const char*)A; }
    __device__ __forceinline__ void bptr(const Unit& u, const char*& b0, const char*& b1) const {
        const unsigned char* w = W + (size_t)u.e * 2048 * KD; b0 = (const char*)(w + (size_t)(u.pn * 128) * KD); b1 = (const char*)(w + (size_t)(1024 + u.pn * 128) * KD);
    }
    __device__ __forceinline__ void binit(const Unit& u, int wc, int fq, f32x4 (&bi)[2][2]) const {
        const float* bp = bias + (size_t)u.e * 2048 + u.pn * 128 + wc * 32 + 8 * fq;
        bi[0][0] = *(const f32x4*)bp; bi[0][1] = *(const f32x4*)(bp + 4); bi[1][0] = *(const f32x4*)(bp + 1024); bi[1][1] = *(const f32x4*)(bp + 1028);
    }
    __device__ __forceinline__ void prefetch(const Unit& n, int tid, LAS unsigned* sink) const {
#if MK_PREFETCH
        if (tid < 256 && n.pn < 6) { const char* a = (const char*)A + (size_t)M.idx[n.ui * 256 + tid] * 1024 + (2 + n.pn) * 128;
            __builtin_amdgcn_global_load_lds((const unsigned*)a, sink, 4, 0, 0); }
        if (n.rt - M.ebase[n.e] < 4) { const int row = tid & 255, kt = 2 + 2 * (n.rt % 3) + (tid >> 8);
            const char* b = (const char*)(W + (size_t)n.e * 2048 * KD + (size_t)((row < 128 ? 0 : 1024 - 128) + n.pn * 128 + row) * KD) + kt * 128;
            __builtin_amdgcn_global_load_lds((const unsigned*)b, sink, 4, 0, 0); }
#endif
    }
    __device__ __forceinline__ void epi(const f32x4 (&acc)[2][2][4][2], const Unit& u, int wr, int wc, int fr, int fq) const {
        const int row0 = u.rt * 256 + wr * 64 + fr, col0 = u.pn * 128 + wc * 32 + 8 * fq;
        constexpr float SC = 1.f / (FP8_WSCALE * MK_KREP);
#pragma unroll 1
        for (int er = 0; er < MK_EREP_GU; ++er) { asm volatile("" ::: "memory");
#pragma unroll
        for (int ai = 0; ai < 2; ++ai)
#pragma unroll
            for (int m = 0; m < 4; ++m) {
                unsigned wq[2];
#pragma unroll
                for (int n = 0; n < 2; ++n) {
                    f32x4 g = acc[ai][0][m][n] * SC, uu = acc[ai][1][m][n] * SC;
#pragma unroll
                    for (int j = 0; j < 4; ++j) { g[j] = fminf(g[j], 7.f); uu[j] = __builtin_amdgcn_fmed3f(uu[j], -7.f, 7.f); }
                    f32x4 t = g * (-1.702f * 1.4426950408889634f);
#pragma unroll
                    for (int j = 0; j < 4; ++j) t[j] = __builtin_amdgcn_exp2f(t[j]);
                    f32x4 d = t * (1.f / FP8_ASCALE) + (1.f / FP8_ASCALE);
#pragma unroll
                    for (int j = 0; j < 4; ++j) d[j] = __builtin_amdgcn_rcpf(d[j]);
                    const f32x4 o = (uu * g + g) * d;
                    wq[n] = pack_fp8x4_nc(o[0], o[1], o[2], o[3]);
                }
                u32x2 w; w.x = wq[0]; w.y = wq[1];
                *(u32x2*)(O + (size_t)(row0 + ai * 128 + m * 16) * 1024 + col0) = w;
            } }
    }
};
struct MoeDown {
    static constexpr bool PERM = true, FP8 = true; static constexpr int KREP = MK_KREP; static constexpr float BIAS_SCALE = FP8_WSCALE * FP8_ASCALE * MK_KREP;
    const unsigned char* A; const unsigned char* W; const float* bias; unsigned char* O; MoeTabs M; MoeGeo geo;
    __device__ __forceinline__ bool next(int i, Unit& u) const {
        if (!moe_unit<4>(i, geo, M.R, u.rt, u.pn)) return false;
        u.e = __builtin_amdgcn_readfirstlane(M.tile_e[u.rt]); u.ui = i; return true;
    }
    __device__ __forceinline__ void arows(const Unit& u, int R0, unsigned cofs, unsigned& v0, unsigned& v1, unsigned& v2, unsigned& v3) const {
        const unsigned base = (unsigned)(u.rt * 256 + R0) * 1024u + cofs; v0 = base; v1 = base + 64u * 1024u; v2 = base + 128u * 1024u; v3 = base + 192u * 1024u;
    }
    __device__ __forceinline__ const char* abase() const { return (const char*)A; }
    __device__ __forceinline__ void bptr(const Unit& u, const char*& b0, const char*& b1) const { b0 = (const char*)(W + (size_t)u.e * 1024 * KD + (size_t)u.pn * 256 * KD); b1 = b0 + (size_t)128 * KD; }
    __device__ __forceinline__ void binit(const Unit& u, int wc, int fq, f32x4 (&bi)[2][2]) const {
        const float* bp = bias + (size_t)u.e * 1024 + u.pn * 256 + wc * 32 + 8 * fq;
#pragma unroll
        for (int bj = 0; bj < 2; ++bj) { bi[bj][0] = *(const f32x4*)(bp + bj * 128); bi[bj][1] = *(const f32x4*)(bp + bj * 128 + 4); }
    }
    __device__ __forceinline__ void prefetch(const Unit& n, int tid, LAS unsigned* sink) const {
#if MK_PREFETCH
        { const int kt = tid < 256 ? 2 + n.pn : 6 + (n.pn & 1); const char* a = (const char*)A + (size_t)(n.rt * 256 + (tid & 255)) * 1024 + kt * 128;
            __builtin_amdgcn_global_load_lds((const unsigned*)a, sink, 4, 0, 0); }
        if (n.rt - M.ebase[n.e] < 7) { const int row = tid & 255, kt = 2 + 2 * (n.rt % 3) + (tid >> 8);
            const char* b = (const char*)(W + (size_t)n.e * 1024 * KD + (size_t)(n.pn * 256 + row) * KD) + kt * 128;
            __builtin_amdgcn_global_load_lds((const unsigned*)b, sink, 4, 0, 0); }
#endif
    }
    __device__ __forceinline__ void epi(const f32x4 (&acc)[2][2][4][2], const Unit& u, int wr, int wc, int fr, int fq) const {
        const int row0 = u.rt * 256 + wr * 64 + fr, col0 = u.pn * 256 + wc * 32 + 8 * fq;
        constexpr float SC = FP8_YSCALE / (FP8_WSCALE * FP8_ASCALE * MK_KREP);
#pragma unroll 1
        for (int er = 0; er < MK_EREP_DN; ++er) { asm volatile("" ::: "memory");
#pragma unroll
        for (int ai = 0; ai < 2; ++ai)
#pragma unroll
            for (int m = 0; m < 4; ++m) { unsigned char* rowp = O + (size_t)(row0 + ai * 128 + m * 16) * 1024 + col0;
#pragma unroll
                for (int bj = 0; bj < 2; ++bj) { f32x4 v0 = acc[ai][bj][m][0] * SC, v1 = acc[ai][bj][m][1] * SC;
#pragma unroll
                    for (int j = 0; j < 4; ++j) { v0[j] = __builtin_amdgcn_fmed3f(v0[j], -448.f, 448.f); v1[j] = __builtin_amdgcn_fmed3f(v1[j], -448.f, 448.f); }
                    u32x2 w; w.x = pack_fp8x4_nc(v0[0], v0[1], v0[2], v0[3]); w.y = pack_fp8x4_nc(v1[0], v1[1], v1[2], v1[3]);
                    *(u32x2*)(rowp + bj * 128) = w; } } }
    }
};
}

template <int OFF> __device__ __forceinline__ s16x4 ds_tr_read(int vb) {
    s16x4 r; asm volatile("ds_read_b64_tr_b16 %0, %1 offset:%2" : "=&v"(r) : "v"(vb), "i"(OFF) : "memory"); return r;
}
constexpr int S5_PITCH = 136, S5_IMG = 128 * S5_PITCH;

template <bool FULL>
__device__ __forceinline__ void phase_s5(const Frame& F, const bf16_t* __restrict__ U, bf16_t* __restrict__ Z, unsigned char* __restrict__ Z8, int cvu, int cvend) {
    const int lane = F.lane, n = lane & 31, h = lane >> 5;
    const float* tab = (const float*)(F.ws + WS_S5A);
    const bf16_t* bop = (const bf16_t*)(F.ws + WS_BOP); const bf16_t* cop = (const bf16_t*)(F.ws + WS_COP);
    float* carry = (float*)(F.ws + WS_CARRY);
    const float* dsk = F.in[L0_D];
    LAS unsigned char* xt = F.lds + F.wave * S5_IMG;
    int pg = -1; bf16x8 Bop[4], Cf[4]; float a0r = 0.f, a0i = 0.f, a1r = 0.f, a1i = 0.f; f32x4 dv = {0.f, 0.f, 0.f, 0.f};
    const int ch = lane & 15, kg = lane >> 4;
    LAS unsigned* cvL = (LAS unsigned*)(F.lds + CONV_S5_LDS);
    cvu += F.c;
    auto body = [&](const int w, auto cv_tag, ConvTicket& tcur, ConvTicket& tnxt) __attribute__((always_inline)) {
        constexpr bool EMIT = decltype(cv_tag)::emit, ISSUE = decltype(cv_tag)::issue;
        const int g = (w & 7) * 8 + F.wave, chunk = (w >> 3) & 127, b = w >> 10;
        const int tok0 = b * SEQ + chunk * 64;
        bf16x8 Aop[2];
#pragma unroll
        for (int mt = 0; mt < 2; ++mt) { const int time = 32 * ((n >> 2) & 1) + 16 * mt + 4 * (n >> 3) + (n & 3);
            Aop[mt] = *(const bf16x8*)(U + (size_t)(tok0 + time) * DM + g * 16 + 8 * h); }
        if (g != pg) { pg = g;
#pragma unroll
            for (int nt = 0; nt < 4; ++nt) Bop[nt] = *(const bf16x8*)(bop + (size_t)((g * 128 + nt * 32 + n) * 16 + 8 * h));
            a0r = tab[g * 64 + n]; a0i = tab[4096 + g * 64 + n]; a1r = tab[g * 64 + 32 + n]; a1i = tab[4096 + g * 64 + 32 + n];
            if (FULL) { dv = *(const f32x4*)(dsk + g * 16 + 4 * kg);
#pragma unroll
                for (int ks = 0; ks < 4; ++ks) Cf[ks] = *(const bf16x8*)(cop + (size_t)((g * 16 + ch) * 128 + 32 * ks + 8 * kg)); } }
        f32x16 acc[2][4];
#pragma unroll
        for (int mt = 0; mt < 2; ++mt)
#pragma unroll
            for (int nt = 0; nt < 4; ++nt) { f32x16 z = {}; acc[mt][nt] = __builtin_amdgcn_mfma_f32_32x32x16_bf16(Aop[mt], Bop[nt], z, 0, 0, 0); }
        float* cp = carry + ((size_t)(b * 256 + chunk * 2 + h) * 64 + g) * 128;
        float x0r = 0.f, x0i = 0.f, x1r = 0.f, x1i = 0.f;
        if (FULL) { x0r = cp[n]; x0i = cp[64 + n]; x1r = cp[32 + n]; x1i = cp[96 + n]; }
        if constexpr (ISSUE) { conv_issue(F, cvu, cvu + 1, tnxt); cvu += F.G; }
#pragma unroll
        for (int mt = 0; mt < 2; ++mt)
#pragma unroll
            for (int r = 0; r < 16; ++r) {
                const float n0r = fmaf(a0r, x0r, fmaf(-a0i, x0i, acc[mt][0][r])), n0i = fmaf(a0r, x0i, fmaf(a0i, x0r, acc[mt][2][r]));
                const float n1r = fmaf(a1r, x1r, fmaf(-a1i, x1i, acc[mt][1][r])), n1i = fmaf(a1r, x1i, fmaf(a1i, x1r, acc[mt][3][r]));
                x0r = n0r; x0i = n0i; x1r = n1r; x1i = n1i;
                acc[mt][0][r] = x0r; acc[mt][2][r] = x0i; acc[mt][1][r] = x1r; acc[mt][3][r] = x1i;
            }
        if (!FULL) { cp[n] = x0r; cp[64 + n] = x0i; cp[32 + n] = x1r; cp[96 + n] = x1i; if constexpr (EMIT) conv_emit(F, tcur, cvL); return; }
#pragma unroll
        for (int mt = 0; mt < 2; ++mt)
#pragma unroll
            for (int nt = 0; nt < 4; ++nt)
#pragma unroll
                for (int q = 0; q < 4; ++q) {
                    u32x2 pk; pk.x = cvt_pk_bf16(acc[mt][nt][4 * q + 0], acc[mt][nt][4 * q + 1]); pk.y = cvt_pk_bf16(acc[mt][nt][4 * q + 2], acc[mt][nt][4 * q + 3]);
                    *(LAS u32x2*)(xt + (nt * 32 + n) * S5_PITCH + (32 * h + 16 * mt + 4 * q) * 2) = pk;
                }
        const int trb = (int)(uintptr_t)xt + (8 * kg + (ch >> 2)) * S5_PITCH + (4 * (ch & 3)) * 2;
        f32x4 y[4];
#pragma unroll
        for (int tb = 0; tb < 4; ++tb) y[tb] = (f32x4){0.f, 0.f, 0.f, 0.f};
        asm volatile("s_waitcnt lgkmcnt(0)" ::: "memory");
#define S5_TR(tb, ks, hi4) ds_tr_read<(32 * (ks) + 4 * (hi4)) * S5_PITCH + 32 * (tb)>(trb)
#define S5_STEP(tb, ks) do { const s16x4 lo = S5_TR(tb, ks, 0), hi = S5_TR(tb, ks, 1); asm volatile("s_waitcnt lgkmcnt(0)" ::: "memory"); __builtin_amdgcn_sched_barrier(0); \
            const bf16x8 bf = (bf16x8){lo[0], lo[1], lo[2], lo[3], hi[0], hi[1], hi[2], hi[3]}; y[tb] = __builtin_amdgcn_mfma_f32_16x16x32_bf16(Cf[ks], bf, y[tb], 0, 0, 0); } while (0)
        S5_STEP(0, 0); S5_STEP(0, 1); S5_STEP(0, 2); S5_STEP(0, 3);
        S5_STEP(1, 0); S5_STEP(1, 1); S5_STEP(1, 2); S5_STEP(1, 3);
        S5_STEP(2, 0); S5_STEP(2, 1); S5_STEP(2, 2); S5_STEP(2, 3);
        S5_STEP(3, 0); S5_STEP(3, 1); S5_STEP(3, 2); S5_STEP(3, 3);
#undef S5_STEP
#undef S5_TR
#pragma unroll
        for (int tb = 0; tb < 4; ++tb) {
            const size_t o = (size_t)(tok0 + 16 * tb + ch) * DM + g * 16 + 4 * kg;
            const u32x2 uu = *(const u32x2*)(U + o);
            const float y0 = y[tb][0] + dv[0] * bf_lo(uu.x), y1 = y[tb][1] + dv[1] * bf_hi(uu.x), y2 = y[tb][2] + dv[2] * bf_lo(uu.y), y3 = y[tb][3] + dv[3] * bf_hi(uu.y);
            const float z0 = gelu_tanh(y0), z1 = gelu_tanh(y1), z2 = gelu_tanh(y2), z3 = gelu_tanh(y3);
            *(unsigned*)(Z8 + o) = pack_fp8x4(z0, z1, z2, z3);
        }
        if constexpr (EMIT) conv_emit(F, tcur, cvL);
    };
    ConvTicket tA, tB; tA.have = tB.have = false;
    int w = F.c, nconv = 0;
    { int cu = cvu; while (cu < cvend && w + nconv * F.G < 2048) { ++nconv; cu += F.G; } }
    if constexpr (FULL) {
        for (int i = 0; i < nconv; ++i) { body(w, CvBoth{}, tA, tA); w += F.G; }
    } else {
        if (nconv > 0) { conv_issue(F, cvu, cvu + 1, tA); cvu += F.G; }
        int i = 0;
        for (; i + 2 <= nconv - 1; i += 2) { body(w, CvBoth{}, tA, tB); w += F.G; body(w, CvBoth{}, tB, tA); w += F.G; }
        if (i < nconv - 1) { body(w, CvBoth{}, tA, tB); w += F.G; body(w, CvEmit{}, tB, tA); w += F.G; }
        else if (i < nconv) { body(w, CvEmit{}, tA, tB); w += F.G; }
    }
    for (; w < 2048; w += F.G) body(w, CvNone{}, tA, tB);
}

__device__ __forceinline__ void phase_s5_carry(const Frame& F) {
    const float* tab = (const float*)(F.ws + WS_S5A);
    float* carry = (float*)(F.ws + WS_CARRY);
    LAS float* E = (LAS float*)F.lds;
    for (int pair = F.c; pair < 128; pair += F.G) {
        const int b = pair >> 6, g = pair & 63, p = F.lane, w = F.wave;
        const float ar = tab[8192 + g * 64 + p], ai = tab[12288 + g * 64 + p];
        float* ptr = carry + ((size_t)(b * 256 + 32 * w) * 64 + g) * 128 + p;
        float cr[32], ci[32];
#pragma unroll
        for (int j = 0; j < 32; ++j) { cr[j] = ptr[(size_t)j * 8192]; ci[j] = ptr[(size_t)j * 8192 + 64]; }
        float xr = 0.f, xi = 0.f;
#pragma unroll
        for (int j = 0; j < 32; ++j) { const float nr = fmaf(ar, xr, fmaf(-ai, xi, cr[j])), ni = fmaf(ar, xi, fmaf(ai, xr, ci[j])); xr = nr; xi = ni; }
        E[(w * 2 + 0) * 64 + p] = xr; E[(w * 2 + 1) * 64 + p] = xi;
        float sr = ar, si = ai;
#pragma unroll
        for (int q = 0; q < 5; ++q) { const float nr = sr * sr - si * si, ni = 2.f * sr * si; sr = nr; si = ni; }
        __syncthreads();
        xr = 0.f; xi = 0.f;
        for (int v = 0; v < w; ++v) { const float er = E[(v * 2 + 0) * 64 + p], ei = E[(v * 2 + 1) * 64 + p];
            const float nr = fmaf(sr, xr, fmaf(-si, xi, er)), ni = fmaf(sr, xi, fmaf(si, xr, ei)); xr = nr; xi = ni; }
#pragma unroll
        for (int j = 0; j < 32; ++j) {
            ptr[(size_t)j * 8192] = xr; ptr[(size_t)j * 8192 + 64] = xi;
            const float nr = fmaf(ar, xr, fmaf(-ai, xi, cr[j])), ni = fmaf(ar, xi, fmaf(ai, xr, ci[j])); xr = nr; xi = ni;
        }
        __syncthreads();
    }
}

template <bool FINAL, class XT>
__device__ __forceinline__ void phase_moe_combine(const Frame& F, int layer, const XT* xold, const bf16_t* mres, bf16_t* xnew, const float* gamma_next, unsigned char* hnext, float* outp) {
    LAS int* ebase = (LAS int*)F.lds;
    const unsigned* gcnt = (const unsigned*)(F.ws + ZB_MOECNT + layer * 256);
    if (F.tid < 64) {
        const int nt = F.tid < 32 ? (((int)gcnt[F.tid] + 255) >> 8) : 0;
        int incl = nt;
#pragma unroll
        for (int o = 1; o < 32; o <<= 1) { const int y = __shfl_up(incl, o, 64); if (F.lane >= o) incl += y; }
        if (F.tid < 32) ebase[F.tid] = incl - nt;
    }
    __syncthreads();
    const int* pos = (const int*)(F.ws + WS_TOPK); const float* gates = (const float*)(F.ws + WS_TOPK + (size_t)T * 4 * 4);
    const unsigned char* yk = F.ws + WS_YK;
    const int lane = F.lane;
    int pb = -1; f32x4 G1[4], G2[4], GA[4], S0[4];
    for (int r0 = F.c * 8 + F.wave; r0 < T; r0 += F.G * 16) {
        const int r1 = (r0 + F.G * 8 < T) ? r0 + F.G * 8 : r0;
        u32x4 pp[2]; f32x4 gg[2];
        pp[0] = *(const u32x4*)(pos + (size_t)r0 * 4); pp[1] = *(const u32x4*)(pos + (size_t)r1 * 4);
        gg[0] = *(const f32x4*)(gates + (size_t)r0 * 4); gg[1] = *(const f32x4*)(gates + (size_t)r1 * 4);
        f32x4 xo[2][4]; u32x2 yv[2][4][2]; u32x2 mv[2][2];
#pragma unroll
        for (int q = 0; q < 2; ++q) { const int r = q ? r1 : r0;
#pragma unroll
            for (int i = 0; i < 2; ++i) { mv[q][i] = *(const u32x2*)((const unsigned char*)mres + (size_t)r * DM + 512 * i + 8 * lane);
#pragma unroll
                for (int h = 0; h < 2; ++h) xo[q][2 * i + h] = load_x4(xold + (size_t)r * DM + 512 * i + 8 * lane + 4 * h); }
#pragma unroll
            for (int k = 0; k < 4; ++k) { const int pk = (int)pp[q][k], e = pk >> 14, v = pk & 16383; const size_t phys = (size_t)ebase[e] * 256 + v;
#pragma unroll
                for (int i = 0; i < 2; ++i) yv[q][k][i] = *(const u32x2*)(yk + phys * 1024 + 512 * i + 8 * lane); } }
#pragma unroll
        for (int q = 0; q < 2; ++q) {
            const int r = q ? r1 : r0, b = r >> 13;
            if (b != pb) { pb = b; const float* g1 = ada_vec(F, layer, b, 2); const float* g2 = ada_vec(F, layer, b, 5);
#pragma unroll
                for (int ih = 0; ih < 4; ++ih) { const int col = 512 * (ih >> 1) + 8 * lane + 4 * (ih & 1);
                    G1[ih] = *(const f32x4*)(g1 + col); G2[ih] = *(const f32x4*)(g2 + col); GA[ih] = *(const f32x4*)(gamma_next + col);
                    if (!FINAL) { const f32x4 s1 = *(const f32x4*)(ada_vec(F, layer + 1, b, 1) + col); S0[ih] = *(const f32x4*)(ada_vec(F, layer + 1, b, 0) + col);
#pragma unroll
                        for (int j = 0; j < 4; ++j) GA[ih][j] *= 1.f + s1[j]; } } }
            {
#pragma unroll
              for (int i = 0; i < 2; ++i) { const f32x4 ga = G1[2 * i] * (1.f / FP8_MSCALE), gb = G1[2 * i + 1] * (1.f / FP8_MSCALE); const u32x2 m = mv[q][i];
                const f32x2 m0 = __builtin_amdgcn_cvt_pk_f32_fp8((int)m.x, false), m1 = __builtin_amdgcn_cvt_pk_f32_fp8((int)m.x, true);
                const f32x2 m2 = __builtin_amdgcn_cvt_pk_f32_fp8((int)m.y, false), m3 = __builtin_amdgcn_cvt_pk_f32_fp8((int)m.y, true);
                xo[q][2 * i][0] = fmaf(ga[0], m0[0], xo[q][2 * i][0]); xo[q][2 * i][1] = fmaf(ga[1], m0[1], xo[q][2 * i][1]);
                xo[q][2 * i][2] = fmaf(ga[2], m1[0], xo[q][2 * i][2]); xo[q][2 * i][3] = fmaf(ga[3], m1[1], xo[q][2 * i][3]);
                xo[q][2 * i + 1][0] = fmaf(gb[0], m2[0], xo[q][2 * i + 1][0]); xo[q][2 * i + 1][1] = fmaf(gb[1], m2[1], xo[q][2 * i + 1][1]);
                xo[q][2 * i + 1][2] = fmaf(gb[2], m3[0], xo[q][2 * i + 1][2]); xo[q][2 * i + 1][3] = fmaf(gb[3], m3[1], xo[q][2 * i + 1][3]); } }
            float acc[16];
#pragma unroll
            for (int j = 0; j < 16; ++j) acc[j] = 0.f;
#pragma unroll
            for (int k = 0; k < 4; ++k) { const float gk = gg[q][k] * (1.f / FP8_YSCALE);
#pragma unroll
                for (int i = 0; i < 2; ++i) { const u32x2 w = yv[q][k][i];
                    const f32x2 p0 = __builtin_amdgcn_cvt_pk_f32_fp8((int)w.x, false), p1 = __builtin_amdgcn_cvt_pk_f32_fp8((int)w.x, true);
                    const f32x2 p2 = __builtin_amdgcn_cvt_pk_f32_fp8((int)w.y, false), p3 = __builtin_amdgcn_cvt_pk_f32_fp8((int)w.y, true);
                    acc[8 * i + 0] = fmaf(gk, p0[0], acc[8 * i + 0]); acc[8 * i + 1] = fmaf(gk, p0[1], acc[8 * i + 1]);
                    acc[8 * i + 2] = fmaf(gk, p1[0], acc[8 * i + 2]); acc[8 * i + 3] = fmaf(gk, p1[1], acc[8 * i + 3]);
                    acc[8 * i + 4] = fmaf(gk, p2[0], acc[8 * i + 4]); acc[8 * i + 5] = fmaf(gk, p2[1], acc[8 * i + 5]);
                    acc[8 * i + 6] = fmaf(gk, p3[0], acc[8 * i + 6]); acc[8 * i + 7] = fmaf(gk, p3[1], acc[8 * i + 7]); } }
            float xn[16]; float ss = 0.f;
#pragma unroll
            for (int i = 0; i < 2; ++i)
#pragma unroll
                for (int h = 0; h < 2; ++h) { const int col = 512 * i + 8 * lane + 4 * h;
                    const f32x4 gv = G2[2 * i + h];
                    f32x4 xv;
#pragma unroll
                    for (int j = 0; j < 4; ++j) { xv[j] = xo[q][2 * i + h][j] + gv[j] * acc[8 * i + 4 * h + j]; xn[8 * i + 4 * h + j] = xv[j]; ss += xv[j] * xv[j]; }
                    if (!FINAL) { u32x2 xw; xw.x = cvt_pk_bf16(xv[0], xv[1]); xw.y = cvt_pk_bf16(xv[2], xv[3]); *(u32x2*)(xnew + (size_t)r * DM + col) = xw; } }
            ss = wave_sum(ss);
            const float rs = rsqrtf(ss * (1.f / 1024.f) + 1e-6f);
            if (FINAL) {
#pragma unroll
                for (int i = 0; i < 2; ++i)
#pragma unroll
                    for (int h = 0; h < 2; ++h) { const int col = 512 * i + 8 * lane + 4 * h; const f32x4 g = GA[2 * i + h];
                        f32x4 o;
#pragma unroll
                        for (int j = 0; j < 4; ++j) o[j] = xn[8 * i + 4 * h + j] * rs * g[j];
                        *(f32x4*)(outp + (size_t)r * DM + col) = o; }
            } else {
#pragma unroll
                for (int i = 0; i < 2; ++i) { const int col = 512 * i + 8 * lane;
                    float yv8[8];
#pragma unroll
                    for (int h = 0; h < 2; ++h) {
#pragma unroll
                        for (int j = 0; j < 4; ++j) yv8[4 * h + j] = xn[8 * i + 4 * h + j] * rs * GA[2 * i + h][j] + S0[2 * i + h][j]; }
                    u32x2 w; w.x = pack_fp8x4(yv8[0], yv8[1], yv8[2], yv8[3]); w.y = pack_fp8x4(yv8[4], yv8[5], yv8[6], yv8[7]);
                    *(u32x2*)(hnext + (size_t)r * DM + col) = w; }
            }
        }
    }
    __syncthreads();
}

__device__ __forceinline__ void phase_kmean(const Frame& F, const bf16_t* __restrict__ K) {
    LAS float* red = (LAS float*)F.lds;
    float* km = (float*)(F.ws + WS_KMEAN);
    for (int u = F.c; u < 512; u += F.G) {
        const int h = u & 7, n = (u >> 3) & 31, b = u >> 8;
        const int colc = F.tid & 15, rg = F.tid >> 4;
        const bf16_t* base = K + ((size_t)(b * SEQ + n * 256 + rg * 8)) * DM + h * 128 + colc * 8;
        float acc[8];
#pragma unroll
        for (int j = 0; j < 8; ++j) acc[j] = 0.f;
#pragma unroll
        for (int r = 0; r < 8; ++r) { const u32x4 w = *(const u32x4*)(base + (size_t)r * DM);
            acc[0] += bf_lo(w.x); acc[1] += bf_hi(w.x); acc[2] += bf_lo(w.y); acc[3] += bf_hi(w.y); acc[4] += bf_lo(w.z); acc[5] += bf_hi(w.z); acc[6] += bf_lo(w.w); acc[7] += bf_hi(w.w); }
#pragma unroll
        for (int j = 0; j < 8; ++j) red[rg * 128 + colc * 8 + j] = acc[j];
        __syncthreads();
        if (F.tid < 128) { float s = 0.f;
#pragma unroll
            for (int q = 0; q < 32; ++q) s += red[q * 128 + F.tid];
            km[((size_t)(b * 8 + h) * 32 + n) * 128 + F.tid] = s * (1.f / 256.f); }
        __syncthreads();
    }
}

__device__ __forceinline__ int alist_base(int n) { return 256 * (31 * n - (n * (n - 1)) / 2); }

__device__ __forceinline__ void phase_gating(const Frame& F, const bf16_t* __restrict__ Q) {
    LAS float* kml = (LAS float*)F.lds;
    LAS int* cntl = (LAS int*)(F.lds + 17408); LAS int* basel = cntl + 32; LAS int* entl = cntl + 64;
    const float* km = (const float*)(F.ws + WS_KMEAN);
    unsigned* gcnt = (unsigned*)(F.ws + ZB_ATTCNT);
    int* alist = (int*)(F.ws + WS_ALIST);
    const int lane = F.lane, l31 = lane & 31, hi = lane >> 5;
    for (int u = F.c; u < 256; u += F.G) {
        const int jp = u & 15, h = (u >> 4) & 7, b = u >> 7, bh = b * 8 + h;
        for (int i = F.tid; i < 4096; i += NTHREADS) kml[(i >> 7) * 132 + (i & 127)] = km[(size_t)bh * 4096 + i];
        if (F.tid < 32) cntl[F.tid] = 0;
        __syncthreads();
        const int j = __builtin_amdgcn_readfirstlane(F.wave < 4 ? jp : 31 - jp), s = j * 256 + (F.tid & 255);
        bf16x8 Ah[8], Al[8];
        { const LAS float* kr = kml + l31 * 132 + hi * 8;
#pragma unroll
          for (int ks = 0; ks < 8; ++ks) { const f32x4 x0 = *(const LAS f32x4*)(kr + ks * 16), x1 = *(const LAS f32x4*)(kr + ks * 16 + 4);
              u32x4 ph, pl; ph.x = cvt_pk_bf16(x0[0], x0[1]); ph.y = cvt_pk_bf16(x0[2], x0[3]); ph.z = cvt_pk_bf16(x1[0], x1[1]); ph.w = cvt_pk_bf16(x1[2], x1[3]);
              pl.x = cvt_pk_bf16(x0[0] - bf_lo(ph.x), x0[1] - bf_hi(ph.x)); pl.y = cvt_pk_bf16(x0[2] - bf_lo(ph.y), x0[3] - bf_hi(ph.y));
              pl.z = cvt_pk_bf16(x1[0] - bf_lo(ph.z), x1[1] - bf_hi(ph.z)); pl.w = cvt_pk_bf16(x1[2] - bf_lo(ph.w), x1[3] - bf_hi(ph.w));
              Ah[ks] = __builtin_bit_cast(bf16x8, ph); Al[ks] = __builtin_bit_cast(bf16x8, pl); } }
        float v0 = -INFINITY, v1 = -INFINITY, v2 = -INFINITY; int i0 = 0, i1 = 0, i2 = 0;
#define GT_INS(V, N) do { const float _v = (V); const int _n = (N); \
            if (_v > c0 || (_v == c0 && _n < d0)) { c2 = c1; d2 = d1; c1 = c0; d1 = d0; c0 = _v; d0 = _n; } \
            else if (_v > c1 || (_v == c1 && _n < d1)) { c2 = c1; d2 = d1; c1 = _v; d1 = _n; } \
            else if (_v > c2 || (_v == c2 && _n < d2)) { c2 = _v; d2 = _n; } } while (0)
#pragma unroll
        for (int rb = 0; rb < 2; ++rb) {
            const bf16_t* qp = Q + (size_t)(b * SEQ + j * 256 + (F.wave & 3) * 64 + rb * 32 + l31) * DM + h * 128 + hi * 8;
            bf16x8 qf[8];
#pragma unroll
            for (int ks = 0; ks < 8; ++ks) qf[ks] = *(const bf16x8*)(qp + ks * 16);
            f32x16 acc = {};
#pragma unroll
            for (int ks = 0; ks < 8; ++ks) { acc = __builtin_amdgcn_mfma_f32_32x32x16_bf16(Ah[ks], qf[ks], acc, 0, 0, 0); acc = __builtin_amdgcn_mfma_f32_32x32x16_bf16(Al[ks], qf[ks], acc, 0, 0, 0); }
            float c0 = -INFINITY, c1 = -INFINITY, c2 = -INFINITY; int d0 = 99, d1 = 99, d2 = 99;
#pragma unroll
            for (int i = 0; i < 16; ++i) { const int n = (i >> 2) * 8 + hi * 4 + (i & 3); if (n < j) GT_INS(acc[i], n); }
            const float e0 = __shfl_xor(c0, 32, 64), e1 = __shfl_xor(c1, 32, 64), e2 = __shfl_xor(c2, 32, 64);
            const int f0 = __shfl_xor(d0, 32, 64), f1 = __shfl_xor(d1, 32, 64), f2 = __shfl_xor(d2, 32, 64);
            if (f0 < 99) GT_INS(e0, f0);
            if (f1 < 99) GT_INS(e1, f1);
            if (f2 < 99) GT_INS(e2, f2);
            if (hi == rb) { v0 = c0; v1 = c1; v2 = c2; i0 = d0; i1 = d1; i2 = d2; }
        }
#undef GT_INS
        (void)v0; (void)v1; (void)v2;
        const int nsel = j < 3 ? j : 3;
        if (nsel > 0) entl[F.tid * 3 + 0] = (i0 << 16) | __hip_atomic_fetch_add(&cntl[i0], 1, __ATOMIC_RELAXED, __HIP_MEMORY_SCOPE_WORKGROUP);
        if (nsel > 1) entl[F.tid * 3 + 1] = (i1 << 16) | __hip_atomic_fetch_add(&cntl[i1], 1, __ATOMIC_RELAXED, __HIP_MEMORY_SCOPE_WORKGROUP);
        if (nsel > 2) entl[F.tid * 3 + 2] = (i2 << 16) | __hip_atomic_fetch_add(&cntl[i2], 1, __ATOMIC_RELAXED, __HIP_MEMORY_SCOPE_WORKGROUP);
        __syncthreads();
        if (F.tid < 32) basel[F.tid] = cntl[F.tid] ? (int)atomicAdd(&gcnt[bh * 32 + F.tid], (unsigned)cntl[F.tid]) : 0;
        __syncthreads();
#pragma unroll
        for (int k = 0; k < 3; ++k) if (k < nsel) { const int en = entl[F.tid * 3 + k], n = en >> 16, v = basel[n] + (en & 0xffff);
            alist[(size_t)bh * ALIST_PER_BH + alist_base(n) + v] = s | (k << 16); }
        __syncthreads();
    }
}

namespace at {
constexpr int D = 128, NW = 8, QBLK = 32, KVBLK = 64, LDK = 1024, NT = 4;
constexpr float SCALE = 0.088388347648318440f, THR = 8.f, CL2 = SCALE * 1.4426950408889634f;
constexpr int SHM_V = KVBLK * D * 2, SHM_K = KVBLK * D * 2, SHM_WS = NW * 8704  , SHM_ATTN = SHM_WS + NW * 96 * 4;
constexpr int LDS_PRE = 73728;
#define KSWZ(row, colB) ((row) * 256 + ((colB) ^ (((row) & 7) << 4)))
#define SBAR() __builtin_amdgcn_sched_barrier(0)
__device__ __forceinline__ int crow(int r, int hi) { return (r & 3) + 8 * (r >> 2) + 4 * hi; }
__device__ __forceinline__ void partialSM(f32x16& p0, f32x16& p1, float& m_reg, float& mn, float& alpha) {
    float pmax = p0[0];
#pragma unroll
    for (int r = 1; r < 16; ++r) pmax = fmaxf(pmax, p0[r]);
#pragma unroll
    for (int r = 0; r < 16; ++r) pmax = fmaxf(pmax, p1[r]);
    { auto rr = __builtin_amdgcn_permlane32_swap(__float_as_uint(pmax), __float_as_uint(pmax), false, false);
      pmax = fmaxf(__uint_as_float(rr[0]), __uint_as_float(rr[1])); }
    if (__builtin_expect(__all(pmax - m_reg <= THR / SCALE), 1)) { mn = m_reg; alpha = 1.f; }
    else { mn = fmaxf(m_reg, pmax); alpha = __builtin_amdgcn_exp2f((m_reg - mn) * CL2); m_reg = mn; }
    const float mnC = -mn * CL2;
#pragma unroll
    for (int r = 0; r < 16; ++r) p0[r] = fmaf(p0[r], CL2, mnC);
#pragma unroll
    for (int r = 0; r < 16; ++r) p1[r] = fmaf(p1[r], CL2, mnC);
#pragma unroll
    for (int r = 0; r < 16; ++r) p0[r] = __builtin_amdgcn_exp2f(p0[r]);
}
__device__ __forceinline__ void finishSM(f32x16& p0, f32x16& p1, float alpha, float& l_reg, bf16x8& pa0, bf16x8& pa1, bf16x8& pa2, bf16x8& pa3) {
#pragma unroll
    for (int r = 0; r < 16; ++r) p1[r] = __builtin_amdgcn_exp2f(p1[r]);
    float ps = 0;
#pragma unroll
    for (int r = 0; r < 16; ++r) ps += p0[r];
#pragma unroll
    for (int r = 0; r < 16; ++r) ps += p1[r];
    { auto rr = __builtin_amdgcn_permlane32_swap(__float_as_uint(ps), __float_as_uint(ps), false, false);
      ps = __uint_as_float(rr[0]) + __uint_as_float(rr[1]); }
    l_reg = l_reg * alpha + ps;
#define PK4(P, BASE, OUT) do { unsigned a0 = cvt_pk_bf16(P[BASE + 0], P[BASE + 1]), a1 = cvt_pk_bf16(P[BASE + 2], P[BASE + 3]);   \
    unsigned b0 = cvt_pk_bf16(P[BASE + 4], P[BASE + 5]), b1 = cvt_pk_bf16(P[BASE + 6], P[BASE + 7]);                              \
    auto r0 = __builtin_amdgcn_permlane32_swap(a0, b0, false, false); auto r1 = __builtin_amdgcn_permlane32_swap(a1, b1, false, false); \
    u32x4 w = {r0[0], r1[0], r0[1], r1[1]}; OUT = *reinterpret_cast<bf16x8*>(&w); } while (0)
    PK4(p0, 0, pa0); PK4(p0, 8, pa1); PK4(p1, 0, pa2); PK4(p1, 8, pa3);
#undef PK4
}
__device__ __forceinline__ void qkt(f32x16& p0, f32x16& p1, const char* Ks, const bf16x8* qr, int r32, int hi) {
    p0 = f32x16{}; p1 = f32x16{};
#pragma unroll
    for (int d0 = 0; d0 < 8; ++d0) { const int cb = (d0 * 16 + hi * 8) * 2;
        const bf16x8 b0 = *reinterpret_cast<const bf16x8*>(Ks + KSWZ(r32, cb));
        const bf16x8 b1 = *reinterpret_cast<const bf16x8*>(Ks + KSWZ(32 + r32, cb));
        p0 = __builtin_amdgcn_mfma_f32_32x32x16_bf16(b0, qr[d0], p0, 0, 0, 0);
        p1 = __builtin_amdgcn_mfma_f32_32x32x16_bf16(b1, qr[d0], p1, 0, 0, 0); }
}
__device__ __forceinline__ void causal_mask(f32x16& p0, f32x16& p1, int kt, int qrow, int hi) {
#pragma unroll
    for (int r = 0; r < 16; ++r) { const int key = kt * 64 + crow(r, hi); if (key > qrow) p0[r] = -1e30f; if (key + 32 > qrow) p1[r] = -1e30f; }
}
__device__ __forceinline__ int v_st(int k, int c) { const int kk = (k & ~0xC) | ((k & 4) << 1) | ((k & 8) >> 1); return ((kk >> 3) * 4 + (c >> 5)) * 512 + ((kk & 7) * 32 + (c & 31)) * 2; }
__device__ __forceinline__ int v_rd_base(int lane) { return ((lane & 3) << 3) | (((lane >> 2) & 3) << 6) | (((lane >> 4) & 1) << 5) | (((lane >> 5) & 1) << 8); }
constexpr int v_rd_off(int d0, int ks, int half) { return d0 * 512 + ks * 4096 + half * 2048; }
template <int D0> __device__ __forceinline__ void pv_one(f32x16& od, int vb, bf16x8 pa0, bf16x8 pa1, bf16x8 pa2, bf16x8 pa3) {
    const s16x4 l0 = ds_tr_read<v_rd_off(D0, 0, 0)>(vb), h0 = ds_tr_read<v_rd_off(D0, 0, 1)>(vb), l1 = ds_tr_read<v_rd_off(D0, 1, 0)>(vb), h1 = ds_tr_read<v_rd_off(D0, 1, 1)>(vb);
    const s16x4 l2 = ds_tr_read<v_rd_off(D0, 2, 0)>(vb), h2 = ds_tr_read<v_rd_off(D0, 2, 1)>(vb), l3 = ds_tr_read<v_rd_off(D0, 3, 0)>(vb), h3 = ds_tr_read<v_rd_off(D0, 3, 1)>(vb);
    asm volatile("s_waitcnt lgkmcnt(0)" ::: "memory"); SBAR();
#define PK(L, H) (bf16x8){L[0], L[1], L[2], L[3], H[0], H[1], H[2], H[3]}
    od = __builtin_amdgcn_mfma_f32_32x32x16_bf16(pa0, PK(l0, h0), od, 0, 0, 0);
    od = __builtin_amdgcn_mfma_f32_32x32x16_bf16(pa1, PK(l1, h1), od, 0, 0, 0);
    od = __builtin_amdgcn_mfma_f32_32x32x16_bf16(pa2, PK(l2, h2), od, 0, 0, 0);
    od = __builtin_amdgcn_mfma_f32_32x32x16_bf16(pa3, PK(l3, h3), od, 0, 0, 0);
#undef PK
}
__device__ __forceinline__ void pv_d0(f32x16* o, int vb, bf16x8 pa0, bf16x8 pa1, bf16x8 pa2, bf16x8 pa3) {
    pv_one<0>(o[0], vb, pa0, pa1, pa2, pa3); pv_one<1>(o[1], vb, pa0, pa1, pa2, pa3); pv_one<2>(o[2], vb, pa0, pa1, pa2, pa3); pv_one<3>(o[3], vb, pa0, pa1, pa2, pa3);
}

struct AUnit { unsigned qoff; unsigned kv; int dst; bool causal; };
__device__ __forceinline__ bool attn_decode(int u, int total, const bf16_t* Q, const int* alist, const LAS int* pre, const LAS int* cntl, int wid, int r32, AUnit& D) {
    if (u >= total) return false;
    int bh, n;
    if (u < 512) {
        bh = u >> 5; n = u & 31; D.causal = true;
        const int b = bh >> 3, h = bh & 7, s = n * 256 + wid * 32 + r32; const size_t t = (size_t)b * SEQ + s;
        D.qoff = (unsigned)(t * DM + h * 128); D.dst = (int)((t * 8 + h) * 4 + 3);
    } else {
        const int ut = u - 512; int lo = 0, hi_ = 511;
        while (lo < hi_) { const int mid = (lo + hi_ + 1) >> 1; if (pre[mid] <= ut) lo = mid; else hi_ = mid - 1; }
        bh = lo >> 5; n = lo & 31; D.causal = false;
        const int tile = ut - pre[lo], cntv = cntl[lo], idx = tile * 256 + wid * 32 + r32;
        const int b = bh >> 3, h = bh & 7;
        const int en = alist[(size_t)bh * ALIST_PER_BH + alist_base(n) + (idx < cntv ? idx : cntv - 1)];
        const int s = en & 0xffff, k = en >> 16; const size_t t = (size_t)b * SEQ + s;
        D.qoff = (unsigned)(t * DM + h * 128); D.dst = idx < cntv ? (int)((t * 8 + h) * 4 + k) : -1;
    }
    D.kv = (unsigned)(((size_t)(bh >> 3) * SEQ + n * 256) * DM + (bh & 7) * 128);
    return true;
}

__device__ __forceinline__ void attn_stream(const bf16_t* __restrict__ Q, const bf16_t* __restrict__ K, const bf16_t* __restrict__ V, const int* __restrict__ alist,
                                            const LAS int* pre, const LAS int* cntl, int total, int c, int G,
                                            unsigned char* __restrict__ part, float* __restrict__ lse, char* lds) {
    const int tid = threadIdx.x, wid = tid >> 6, lane = tid & 63, r32 = lane & 31, hi = lane >> 5;
    char* V_lds = lds; char* K_lds = lds + 2 * SHM_V;
    float* wsl = (float*)(lds + SHM_WS) + wid * 96; float* li_l = wsl; float* al_l = wsl + 32; int* dst_l = (int*)(wsl + 64);
#define TZ() ({ int _t = threadIdx.x; asm volatile("" : "+v"(_t)); _t; })
#define qrow_i ((TZ() >> 6) * 32 + (TZ() & 31))
#define vb0 ((int)(uintptr_t)V_lds + v_rd_base(TZ() & 63))
    struct { bf16x8 vs0, vs1, ks0, ks1; } sr_[2];
#define SLOAD(i, KP, VP, k0) do { const int _tz = TZ(), sr = _tz >> 4, sc = (_tz & 15) * 8; sr_[i].vs0 = *(const bf16x8*)(&(VP)[(long)((k0) + sr) * LDK + sc]); sr_[i].vs1 = *(const bf16x8*)(&(VP)[(long)((k0) + 32 + sr) * LDK + sc]); \
    sr_[i].ks0 = *(const bf16x8*)(&(KP)[(long)((k0) + sr) * LDK + sc]); sr_[i].ks1 = *(const bf16x8*)(&(KP)[(long)((k0) + 32 + sr) * LDK + sc]); } while (0)
#define SWRITE(b, i) do { const int _tz = TZ(), sr = _tz >> 4, sc = (_tz & 15) * 8, vst0 = v_st(sr, sc), vst1 = v_st(32 + sr, sc); *(bf16x8*)(V_lds + (b) * SHM_V + vst0) = sr_[i].vs0;          \
    *(bf16x8*)(V_lds + (b) * SHM_V + vst1) = sr_[i].vs1; const int kc = sc * 2;          \
    *(bf16x8*)(K_lds + (b) * SHM_K + KSWZ(sr, kc)) = sr_[i].ks0;                          \
    *(bf16x8*)(K_lds + (b) * SHM_K + KSWZ(32 + sr, kc)) = sr_[i].ks1; } while (0)
#define SWAIT() asm volatile("s_waitcnt vmcnt(4)" ::: "memory")
#define RESC(a) do { if (__any((a) < 1.f)) { if (hi == 0) al_l[r32] = (a); asm volatile("s_waitcnt lgkmcnt(0)" ::: "memory"); \
    _Pragma("unroll") for (int d = 0; d < 4; ++d) _Pragma("unroll") for (int r = 0; r < 16; ++r) o[d][r] *= al_l[crow(r, hi)]; } } while (0)
    AUnit cur, nxt;
    int u = c;
    if (!attn_decode(u, total, Q, alist, pre, cntl, wid, r32, cur)) return;
#define stash ((int*)(lds + 81920) + TZ() * 2)
    stash[0] = (int)cur.qoff; stash[1] = cur.dst;
    unsigned ckv = __builtin_amdgcn_readfirstlane(cur.kv); bool ccausal = cur.causal;
    SLOAD(0, K + ckv, V + ckv, 0);
    for (;;) {
        bf16x8 qr[8];
        { const bf16_t* Qw = Q + (unsigned)stash[0] + hi * 8;
#pragma unroll
          for (int d0 = 0; d0 < 8; ++d0) qr[d0] = *reinterpret_cast<const bf16x8*>(Qw + d0 * 16); }
        u += G;
        const bool has_next = attn_decode(u, total, Q, alist, pre, cntl, wid, r32, nxt);
        const int dst0 = stash[1];
        if (hi == 0) dst_l[r32] = dst0;
        asm volatile("s_waitcnt lgkmcnt(0)" ::: "memory");
        if (has_next) { stash[0] = (int)nxt.qoff; stash[1] = nxt.dst; }
        const unsigned nkv = __builtin_amdgcn_readfirstlane(nxt.kv); const bool ncausal = nxt.causal;
        const bf16_t* Kh = K + ckv; const bf16_t* Vh = V + ckv; const bool causal = ccausal;
        float m_reg = -1e30f, l_reg = 0; f32x16 o[4] = {};
        f32x16 pA0, pA1, pB0, pB1; float mnA, mnB, alA, alB; bf16x8 pa0, pa1, pa2, pa3;
        asm volatile("s_waitcnt vmcnt(0)" ::: "memory"); SWRITE(0, 0); __syncthreads();
#define WAVE_ACT() (__any(dst_l[TZ() & 31] >= 0) != 0)
        if (WAVE_ACT()) {
        qkt(pA0, pA1, K_lds, qr, r32, hi); if (causal) causal_mask(pA0, pA1, 0, qrow_i, hi); partialSM(pA0, pA1, m_reg, mnA, alA);
        SLOAD(1, Kh, Vh, KVBLK); SLOAD(0, Kh, Vh, 2 * KVBLK);
        SWAIT(); SWRITE(1, 1); __syncthreads();
        {
            SBAR(); qkt(pB0, pB1, K_lds + SHM_K, qr, r32, hi); if (causal) causal_mask(pB0, pB1, 1, qrow_i, hi);
            finishSM(pA0, pA1, alA, l_reg, pa0, pa1, pa2, pa3); SBAR();
            SLOAD(1, Kh, Vh, 3 * KVBLK); SBAR();
            pv_d0(o, vb0, pa0, pa1, pa2, pa3); partialSM(pB0, pB1, m_reg, mnB, alB);
            __syncthreads(); SWAIT(); SWRITE(0, 0);
            RESC(alB); __syncthreads();
            SBAR(); qkt(pA0, pA1, K_lds, qr, r32, hi); if (causal) causal_mask(pA0, pA1, 2, qrow_i, hi);
            finishSM(pB0, pB1, alB, l_reg, pa0, pa1, pa2, pa3); SBAR();
            pv_d0(o, vb0 + SHM_V, pa0, pa1, pa2, pa3); partialSM(pA0, pA1, m_reg, mnA, alA);
            __syncthreads(); asm volatile("s_waitcnt vmcnt(0)" ::: "memory"); SWRITE(1, 1);
            RESC(alA); __syncthreads();
        }
        SBAR(); qkt(pB0, pB1, K_lds + SHM_K, qr, r32, hi); if (causal) causal_mask(pB0, pB1, 3, qrow_i, hi);
        finishSM(pA0, pA1, alA, l_reg, pa0, pa1, pa2, pa3); SBAR();
        pv_d0(o, vb0, pa0, pa1, pa2, pa3); partialSM(pB0, pB1, m_reg, mnB, alB);
        __syncthreads(); RESC(alB);
        finishSM(pB0, pB1, alB, l_reg, pa0, pa1, pa2, pa3); SBAR();
        pv_d0(o, vb0 + SHM_V, pa0, pa1, pa2, pa3);
        } else {
            SLOAD(1, Kh, Vh, KVBLK); SLOAD(0, Kh, Vh, 2 * KVBLK);
            SWAIT(); SWRITE(1, 1); __syncthreads();
            SLOAD(1, Kh, Vh, 3 * KVBLK);
            __syncthreads(); SWAIT(); SWRITE(0, 0); __syncthreads();
            __syncthreads(); asm volatile("s_waitcnt vmcnt(0)" ::: "memory"); SWRITE(1, 1); __syncthreads();
            __syncthreads();
        }
        SBAR();
        if (has_next) {
            SLOAD(0, K + nkv, V + nkv, 0);
        }
        SBAR();
        if (WAVE_ACT()) {
        if (hi == 0) li_l[r32] = l_reg; asm volatile("s_waitcnt lgkmcnt(0)" ::: "memory");
        { const int dst = dst_l[r32]; if (hi == 0 && dst >= 0) lse[dst] = m_reg * CL2 + __builtin_amdgcn_logf(l_reg); }
        char* ost = lds + 90112 + wid * 8704;
#pragma unroll
        for (int r = 0; r < 16; ++r) { const int orow = crow(r, hi); const float rl = __builtin_amdgcn_rcpf(li_l[orow]);
#pragma unroll
            for (int d0 = 0; d0 < 4; ++d0) *(bf16_t*)(ost + orow * 272 + (d0 * 32 + r32) * 2) = f2bf(o[d0][r] * rl); }
#pragma unroll
        for (int j = 0; j < 8; ++j) { const int cidx = lane + 64 * j, row = cidx >> 4, ch = cidx & 15; const int dd = dst_l[row];
            const u32x4 w = *(const u32x4*)(ost + row * 272 + ch * 16);
            u32x2 f; f.x = pack_fp8x4(bf_lo(w.x) * FP8_OSCALE, bf_hi(w.x) * FP8_OSCALE, bf_lo(w.y) * FP8_OSCALE, bf_hi(w.y) * FP8_OSCALE);
            f.y = pack_fp8x4(bf_lo(w.z) * FP8_OSCALE, bf_hi(w.z) * FP8_OSCALE, bf_lo(w.w) * FP8_OSCALE, bf_hi(w.w) * FP8_OSCALE);
            if (dd >= 0) *(u32x2*)(part + (size_t)dd * 128 + ch * 8) = f; }
        }
#undef WAVE_ACT
        if (!has_next) break;
        ckv = nkv; ccausal = ncausal;
    }
#undef SLOAD
#undef stash
#undef TZ
#undef qrow_i
#undef vb0
#undef SWRITE
#undef SWAIT
#undef RESC
}
#undef KSWZ
#undef SBAR
}

__device__ __forceinline__ void phase_attn(const Frame& F, const bf16_t* Q, const bf16_t* K, const bf16_t* V, unsigned char* part, float* lse, int wi, int wn) {
    LAS int* pre = (LAS int*)(F.lds + at::LDS_PRE);
    LAS int* wtot = pre + 520; LAS int* cntl = pre + 536;
    const unsigned* gcnt = (const unsigned*)(F.ws + ZB_ATTCNT);
    const int* alist = (const int*)(F.ws + WS_ALIST);
    {
        const int cntv = (int)gcnt[F.tid]; const int v = (cntv + 255) >> 8;
        cntl[F.tid] = cntv;
        int incl = v;
#pragma unroll
        for (int o = 1; o < 64; o <<= 1) { const int y = __shfl_up(incl, o, 64); if (F.lane >= o) incl += y; }
        if (F.lane == 63) wtot[F.wave] = incl;
        __syncthreads();
        int off = 0;
        for (int w = 0; w < F.wave; ++w) off += wtot[w];
        pre[F.tid + 1] = off + incl; if (F.tid == 0) pre[0] = 0;
        __syncthreads();
    }
    const int total = 512 + pre[512];
    at::attn_stream(Q, K, V, alist, pre, cntl, total, wi, wn, part, lse, (char*)F.lds);
}

__device__ __forceinline__ void phase_attn_combine(const Frame& F, const unsigned char* part, const float* lse, unsigned char* O) {
    const size_t stride = (size_t)F.G * NTHREADS;
    for (size_t idx0 = (size_t)F.c * NTHREADS + F.tid; idx0 < (size_t)T * 128; idx0 += 2 * stride) {
        size_t idx[2]; idx[0] = idx0; idx[1] = (idx0 + stride < (size_t)T * 128) ? idx0 + stride : idx0;
        f32x4 l4[2]; u32x2 pv[2][4];
#pragma unroll
        for (int q = 0; q < 2; ++q) { const int dc = (int)(idx[q] & 15), h = (int)((idx[q] >> 4) & 7); const size_t t = idx[q] >> 7, base = (t * 8 + h) * 4;
            l4[q] = *(const f32x4*)(lse + base);
#pragma unroll
            for (int k = 0; k < 4; ++k) pv[q][k] = *(const u32x2*)(part + (base + k) * 128 + dc * 8); }
#pragma unroll
        for (int q = 0; q < 2; ++q) {
            const int dc = (int)(idx[q] & 15), h = (int)((idx[q] >> 4) & 7); const size_t t = idx[q] >> 7;
            const int s = (int)(t & (SEQ - 1)), j = s >> 8, nsel = j < 3 ? j : 3;
            float lk[4]; lk[0] = nsel > 0 ? l4[q][0] : -INFINITY; lk[1] = nsel > 1 ? l4[q][1] : -INFINITY; lk[2] = nsel > 2 ? l4[q][2] : -INFINITY; lk[3] = l4[q][3];
            const float mx = fmaxf(fmaxf(lk[0], lk[1]), fmaxf(lk[2], lk[3]));
            float acc[8] = {0.f, 0.f, 0.f, 0.f, 0.f, 0.f, 0.f, 0.f}; float wsum = 0.f;
#pragma unroll
            for (int k = 0; k < 4; ++k) {
                const bool on = (k == 3) || (k < nsel);
                const float w = on ? __builtin_amdgcn_exp2f(lk[k] - mx) : 0.f; wsum += w;
                u32x2 p = pv[q][k]; if (!on) { p.x = 0u; p.y = 0u; }
                const f32x2 p0 = __builtin_amdgcn_cvt_pk_f32_fp8((int)p.x, false), p1 = __builtin_amdgcn_cvt_pk_f32_fp8((int)p.x, true);
                const f32x2 p2 = __builtin_amdgcn_cvt_pk_f32_fp8((int)p.y, false), p3 = __builtin_amdgcn_cvt_pk_f32_fp8((int)p.y, true);
                acc[0] = fmaf(w, p0[0], acc[0]); acc[1] = fmaf(w, p0[1], acc[1]); acc[2] = fmaf(w, p1[0], acc[2]); acc[3] = fmaf(w, p1[1], acc[3]);
                acc[4] = fmaf(w, p2[0], acc[4]); acc[5] = fmaf(w, p2[1], acc[5]); acc[6] = fmaf(w, p3[0], acc[6]); acc[7] = fmaf(w, p3[1], acc[7]); }
            const float inv = 1.f / wsum;
            u32x2 w; w.x = pack_fp8x4(acc[0] * inv, acc[1] * inv, acc[2] * inv, acc[3] * inv); w.y = pack_fp8x4(acc[4] * inv, acc[5] * inv, acc[6] * inv, acc[7] * inv);
            *(u32x2*)(O + t * DM + h * 128 + dc * 8) = w;
        }
    }
}

constexpr int N_PHASES = 22;
__global__ void __launch_bounds__(NTHREADS, 2) mk_fwd(Args a) {
    extern __shared__ __attribute__((aligned(16))) unsigned char lds_raw[];
    Frame F; F.lds = (LAS unsigned char*)lds_raw; F.tid = threadIdx.x; F.lane = F.tid & 63; F.wave = __builtin_amdgcn_readfirstlane(F.tid >> 6);
    F.G = gridDim.x; F.c = blockIdx.x; F.in = a.in; F.out = a.out; F.ws = a.ws;
    const int lo = a.ph_lo, hi = a.ph_hi;
    if (F.tid == 0) *(LAS u32x4*)(F.lds + LDS_BARW) = (u32x4){0u, 0u, 0u, 0u};
    __syncthreads();
    XcdBarrier bar; bar.bar = (unsigned*)(F.ws + ZB_BAR); bar.x = 0; bar.st = (volatile LAS unsigned*)(F.lds + LDS_BARW);
    if (hi - lo > 1) bar = xcd_barrier_post((unsigned*)(F.ws + ZB_BAR), (volatile LAS unsigned*)(F.lds + LDS_BARW));
#ifndef MK_ONLY
#define MK_ONLY -1
#endif
#define IN(k) ((MK_ONLY < 0 || MK_ONLY == (k)) && lo <= (k) && (k) < hi)
#define SEAM(k) do { if ((k) + 1 < hi) xcd_barrier(bar); { int _t = threadIdx.x; asm volatile("" : "+v"(_t)); F.tid = _t; F.lane = _t & 63; } } while (0)
#define PHASE_WS() unsigned char* ws; { unsigned long long w_ = (unsigned long long)a.ws; asm volatile("" : "+s"(w_)); ws = (unsigned char*)(__attribute__((address_space(1))) unsigned char*)w_; F.ws = ws; }     \
    bf16_t* actA = (bf16_t*)(ws + WS_ACTA); bf16_t* actB = (bf16_t*)(ws + WS_ACTB); bf16_t* actC = (bf16_t*)(ws + WS_ACTC); bf16_t* actD = (bf16_t*)(ws + WS_ACTD); \
    bf16_t* XB = (bf16_t*)(ws + WS_XB); bf16_t* actg = (bf16_t*)(ws + WS_ACTG); bf16_t* yk = (bf16_t*)(ws + WS_YK); \
    (void)actA; (void)actB; (void)actC; (void)actD; (void)XB; (void)actg; (void)yk;
    if (IN(0)) { PHASE_WS(); phase_prologue(F); { int _t = threadIdx.x; asm volatile("" : "+v"(_t)); F.tid = _t; F.lane = _t & 63; } }
    if (IN(1)) { PHASE_WS(); ada_flag_wait(F); phase_norm_mod<true>(F, F.in[IN_X], F.in[L0_NORM1], 0, 0, actA); SEAM(1); }
    if (IN(2)) { PHASE_WS(); pg::Dense<pg::EpiBf16, true> S{actA, ws + WS_WIN, T / 256, 4, F.G, F.c, pg::EpiBf16{actB, 1.f / FP8_WSCALE}}; pg::gemm_phase(F.lds, S); SEAM(2); }
    if (IN(3)) { PHASE_WS(); phase_s5<false>(F, actB, actA, nullptr, 0, MK_CVS3); SEAM(3); }
    if (IN(4)) { PHASE_WS(); phase_s5_carry(F); SEAM(4); }
    if (IN(5)) { PHASE_WS(); phase_s5<true>(F, actB, actA, (unsigned char*)actC, MK_CVS3, MK_CVS3 + MK_CVS5); SEAM(5); }
    if (IN(6)) { PHASE_WS(); pg::Dense<pg::EpiGlu, true> S{actC, ws + WS_WGLU, T / 256, 4, F.G, F.c, pg::EpiGlu{(const unsigned char*)actC, (unsigned char*)actB, 1.f / FP8_WSCALE}}; pg::gemm_phase(F.lds, S); SEAM(6); }
    if (IN(7)) { PHASE_WS(); pg::Dense<pg::EpiF8, true> S{actB, ws + WS_WOUT, T / 256, 4, F.G, F.c, pg::EpiF8{(unsigned char*)actC, FP8_MSCALE / (FP8_WSCALE * FP8_ZSCALE)}}; pg::gemm_phase(F.lds, S); SEAM(7); }
    if (IN(8)) { PHASE_WS(); phase_norm_router(F, F.in[IN_X], actC, F.in[L0_NORM2], 0, (unsigned char*)actA); SEAM(8); }
    const bool has_cv = (F.G == 256); const bool is_cv = has_cv && (F.c >> 3) >= 28; const int cvi = ((F.c >> 3) - 28) * 8 + (F.c & 7);
    const pg::MoeGeo geo0 = pg::moe_geo(F.G, F.c, has_cv ? 28 : 32), geo1 = pg::moe_geo(F.G, F.c, 32);
    if (IN(9)) { PHASE_WS(); if (is_cv) moe_conv_stream(F, CONV_L0DN_BEG + MK_CVD0, CONV_L1GU_BEG, cvi, 32);
        else { pg::MoeTabs M = pg::moe_setup<8>(F, 0, true, geo0);
            pg::MoeGateUp S{(const unsigned char*)actA, ws + WS_WGU0, F.in[L0_BGU], (unsigned char*)actg, M, geo0}; pg::gemm_phase(F.lds, S); }
        SEAM(9); }
    if (IN(10)) { PHASE_WS(); if (is_cv) moe_conv_stream(F, CONV_P10_BEG, CONV_P15_BEG, cvi, 32);
        else { pg::MoeTabs M = pg::moe_tabs_reuse(F, 0, geo0);
            pg::MoeDown S{(const unsigned char*)actg, ws + WS_WDN0, F.in[L0_BDN], (unsigned char*)yk, M, geo0}; pg::gemm_phase(F.lds, S); }
        SEAM(10); }
    if (IN(11)) { PHASE_WS(); phase_moe_combine<false, float>(F, 0, F.in[IN_X], actC, XB, F.in[L1_NORM1], (unsigned char*)actA, nullptr); SEAM(11); }
    if (IN(12)) { PHASE_WS(); pg::Dense<pg::EpiQkv, true> S{actA, ws + WS_WQKV, T / 256, 12, F.G, F.c,
                    pg::EpiQkv{actB, (const float*)(ws + WS_ROPE), (const float*)(ws + WS_ROPE) + (size_t)T * 64, 1.f / FP8_WSCALE, (float*)(ws + WS_KMEAN)}}; pg::gemm_phase(F.lds, S); SEAM(12); }
    if (IN(14)) { PHASE_WS(); phase_gating(F, actB); SEAM(14); }
    if (IN(15)) { PHASE_WS(); if (is_cv) { Frame Fc = F; int _t = threadIdx.x; asm volatile("" : "+v"(_t)); Fc.tid = _t; Fc.lane = _t & 63; moe_conv_stream(Fc, CONV_P15_BEG, CONV_L1DN_BEG, cvi, 32); }
        else phase_attn(F, actB, actC, actD, (unsigned char*)actg, (float*)(ws + WS_LSE), has_cv ? (F.c >> 3) * 8 + (F.c & 7) : F.c, has_cv ? 224 : F.G);
        SEAM(15); }
    if (IN(16)) { PHASE_WS(); phase_attn_combine(F, (const unsigned char*)actg, (const float*)(ws + WS_LSE), (unsigned char*)actA); SEAM(16); }
    if (IN(17)) { PHASE_WS(); pg::Dense<pg::EpiF8, true> S{actA, ws + WS_WO, T / 256, 4, F.G, F.c, pg::EpiF8{(unsigned char*)actC, FP8_MSCALE / (FP8_WSCALE * FP8_OSCALE)}}; pg::gemm_phase(F.lds, S); SEAM(17); }
    if (IN(18)) { PHASE_WS(); phase_norm_router(F, XB, actC, F.in[L1_NORM2], 1, (unsigned char*)actB); SEAM(18); }
    if (IN(19)) { PHASE_WS(); if (is_cv) moe_conv_stream(F, CONV_L1DN_BEG + MK_CVD1, CONV_END, cvi, 32);
        else { pg::MoeTabs M = pg::moe_setup<8>(F, 1, true, geo0);
            pg::MoeGateUp S{(const unsigned char*)actB, ws + WS_WGU1, F.in[L1_BGU], (unsigned char*)actg, M, geo0}; pg::gemm_phase(F.lds, S); }
        SEAM(19); }
    if (IN(20)) { PHASE_WS(); if (!is_cv) { pg::MoeTabs M = pg::moe_tabs_reuse(F, 1, geo0);
            pg::MoeDown S{(const unsigned char*)actg, ws + WS_WDN1, F.in[L1_BDN], (unsigned char*)yk, M, geo0}; pg::gemm_phase(F.lds, S); }
        SEAM(20); }
    if (IN(21)) { PHASE_WS(); phase_moe_combine<true, bf16_t>(F, 1, XB, actC, nullptr, F.in[IN_FNORM], nullptr, F.out); }
#undef IN
#undef SEAM
}

extern "C" void kernel_launch(void* const* d_in, const int* in_sizes, int n_in, void* d_out, int out_size, void* d_ws, size_t ws_size, hipStream_t stream) {
    static int grid = 0;
    if (grid == 0) {
        if (n_in != 37 || in_sizes[0] != T * DM || out_size != T * DM || ws_size < WS_END) {
            fprintf(stderr, "kernel_launch: built for 37 inputs, x/out of %d floats, >= %zu bytes of workspace; got n_in %d, in0 %d, out %d, ws %zu\n", T * DM, (size_t)WS_END, n_in, n_in > 0 ? in_sizes[0] : -1, out_size, ws_size);
            grid = -1; return; }
        int dev = 0, cus = 0, per_cu = 0;
        if (hipGetDevice(&dev) != hipSuccess || hipDeviceGetAttribute(&cus, hipDeviceAttributeMultiprocessorCount, dev) != hipSuccess) { grid = -1; return; }
        if (hipFuncSetAttribute((const void*)mk_fwd, hipFuncAttributeMaxDynamicSharedMemorySize, LDS_BYTES) != hipSuccess) { fprintf(stderr, "kernel_launch: hipFuncSetAttribute failed\n"); grid = -1; return; }
        if (hipOccupancyMaxActiveBlocksPerMultiprocessor(&per_cu, (const void*)mk_fwd, NTHREADS, LDS_BYTES) != hipSuccess || per_cu < 1)
            fprintf(stderr, "kernel_launch: occupancy query reports %d workgroups per CU\n", per_cu);
        (void)hipGetLastError();
        grid = cus;
    }
    if (grid < 0) return;
    if (hipMemsetAsync(d_ws, 0, ZERO_BYTES, stream) != hipSuccess) { fprintf(stderr, "kernel_launch: memset failed\n"); return; }
    Args a{};
    for (int i = 0; i < 37; ++i) a.in[i] = (const float*)d_in[i];
    a.out = (float*)d_out; a.ws = (unsigned char*)d_ws;
#if MK_MULTI
    for (int k = 0; k < MK_EMPTY; ++k) { a.ph_lo = N_PHASES; a.ph_hi = N_PHASES + 1; hipLaunchKernelGGL(mk_fwd, dim3(grid), dim3(NTHREADS), LDS_BYTES, stream, a); }
    for (int k = 0; k < N_PHASES; ++k) { a.ph_lo = k; a.ph_hi = k + 1;
        for (int rep = 0; rep < 1 + (int)((MK_DUP >> k) & 1u); ++rep) {
            if (rep && k == 8) hipMemsetAsync((char*)d_ws + ZB_MOECNT, 0, 256, stream);
            if (rep && k == 18) hipMemsetAsync((char*)d_ws + ZB_MOECNT + 256, 0, 256, stream);
            if (rep && k == 14) hipMemsetAsync((char*)d_ws + ZB_ATTCNT, 0, 2048, stream);
            hipLaunchKernelGGL(mk_fwd, dim3(grid), dim3(NTHREADS), LDS_BYTES, stream, a); } }
#else
    a.ph_lo = 0; a.ph_hi = N_PHASES;
    hipLaunchKernelGGL(mk_fwd, dim3(grid), dim3(NTHREADS), LDS_BYTES, stream, a);
#endif
    const hipError_t le = hipPeekAtLastError();
    if (le != hipSuccess) fprintf(stderr, "kernel_launch: launch failed: %s\n", hipGetErrorName(le));
}
```
